# Optimizing an MI355X kernel written in HIP

```python
import jax, jax.numpy as jnp
from jax import lax
import numpy as np


D_MODEL = 1024
BATCH = 16
SEQ = 2048
DEPTH = 1
DEC_BATCH = 128
DEC_SEQ = 4
PAST_LEN = 8192
PAGE_SIZE = 128

N_META = 16
MIX_WIDTH = D_MODEL
GLA_HEADS = 4
GLA_DV = MIX_WIDTH // 2 // GLA_HEADS
GLA_DK = GLA_DV // 2
GLA_GATE_RANK = 16
GLA_TAU = 16.0
GLA_CHUNK = 64
MLA_HEADS = 8
MLA_DV = MIX_WIDTH // 2 // MLA_HEADS
MLA_NOPE = 64
MLA_ROPE = 32
MLA_Q_LORA = 384
MLA_KV_LORA = 256
MLA_SCALE = (MLA_NOPE + MLA_ROPE) ** -0.5
ROPE_BASE = 10000.0
Q_BLOCK = 128
D_FF = 2816
CONV_W = 3
DN_ALPHA = (2.0 * DEPTH) ** 0.25
DN_BETA = (8.0 * DEPTH) ** -0.25
NORM_EPS = 1e-5
NEG_INF = -1e30

IN_SIZES = (GLA_HEADS * GLA_DK, GLA_HEADS * GLA_DK, GLA_HEADS * GLA_DV, GLA_HEADS * GLA_DV,
            GLA_GATE_RANK, MLA_Q_LORA, MLA_KV_LORA, MLA_ROPE)
IN_OFFSETS = tuple(int(o) for o in np.cumsum(IN_SIZES)[:-1])
IN_COLS = int(sum(IN_SIZES))
V_START = 2 * GLA_HEADS * GLA_DK
V_END = V_START + GLA_HEADS * GLA_DV

kernel_name = 'hymba_gla_mla_deepnorm_step'


def layer_norm(x, g, b):
    xf = x.astype(jnp.float32)
    mu = jnp.mean(xf, axis=-1, keepdims=True)
    var = jnp.mean(jnp.square(xf - mu), axis=-1, keepdims=True)
    return ((xf - mu) * lax.rsqrt(var + NORM_EPS) * g + b).astype(x.dtype)


def rms_norm(x, g):
    xf = x.astype(jnp.float32)
    ms = jnp.mean(jnp.square(xf), axis=-1, keepdims=True)
    return (xf * lax.rsqrt(ms + NORM_EPS) * g).astype(x.dtype)


def rope(x, pos):
    half = MLA_ROPE // 2
    inv = ROPE_BASE ** (-jnp.arange(half, dtype=jnp.float32) / half)
    ang = pos.astype(jnp.float32)[:, None] * inv[None, :]
    cos = jnp.cos(ang)[:, None, :]
    sin = jnp.sin(ang)[:, None, :]
    xf = x.astype(jnp.float32)
    x1, x2 = xf[..., :half], xf[..., half:]
    return jnp.concatenate([x1 * cos - x2 * sin, x2 * cos + x1 * sin], axis=-1).astype(x.dtype)


def mixer_inputs(h, pos, w_in, w_gate_up, b_gate, mla_q_norm_g, mla_kv_norm_g, w_uq, w_uk):
    B, T, _ = h.shape
    z = h @ w_in
    q_g, k_g, v_g, g_g, a_lr, c_q, c_kv, k_r = jnp.split(z, IN_OFFSETS, axis=-1)
    q_g = q_g.reshape(B, T, GLA_HEADS, GLA_DK) * (GLA_DK ** -0.5)
    k_g = k_g.reshape(B, T, GLA_HEADS, GLA_DK)
    v_g = v_g.reshape(B, T, GLA_HEADS, GLA_DV)
    log_a = jax.nn.log_sigmoid((a_lr @ w_gate_up + b_gate).astype(jnp.float32)) / GLA_TAU
    log_a = log_a.reshape(B, T, GLA_HEADS, GLA_DK)
    q = (rms_norm(c_q, mla_q_norm_g) @ w_uq).reshape(B, T, MLA_HEADS, MLA_NOPE + MLA_ROPE)
    q_nope, q_rope = q[..., :MLA_NOPE], rope(q[..., MLA_NOPE:], pos)
    q_lat = jnp.einsum('bthn,chn->bthc', q_nope, w_uk.reshape(MLA_KV_LORA, MLA_HEADS, MLA_NOPE))
    ckv = rms_norm(c_kv, mla_kv_norm_g)
    krope = rope(k_r[:, :, None, :], pos)[:, :, 0, :]
    return (q_g, k_g, v_g, log_a, g_g), (q_lat, q_rope, ckv, krope)


def gla_chunked(q, k, v, log_a, s0, chunk):
    B, T, H, _ = q.shape
    DV = v.shape[-1]
    n = T // chunk
    f32 = jnp.float32

    def blocks(a):
        return a.astype(f32).reshape(B, n, chunk, H, a.shape[-1]).transpose(1, 0, 3, 2, 4)

    qc, kc, vc, gc = blocks(q), blocks(k), blocks(v), blocks(log_a)
    causal = jnp.tril(jnp.ones((chunk, chunk), dtype=bool))
    mid = chunk // 2

    def step(s, inp):
        qi, ki, vi, gi = inp
        b = jnp.cumsum(gi, axis=2)
        b_last = b[:, :, -1:, :]
        b_mid = b[:, :, mid:mid + 1, :]
        o_inter = jnp.einsum('bhcd,bhde->bhce', qi * jnp.exp(b), s)
        att = jnp.einsum('bhid,bhjd->bhij', qi * jnp.exp(b - b_mid), ki * jnp.exp(b_mid - b))
        att = jnp.where(causal, att, 0.0)
        o_intra = jnp.einsum('bhij,bhje->bhie', att, vi)
        s_new = s * jnp.exp(b_last)[:, :, 0, :, None] + jnp.einsum(
            'bhcd,bhce->bhde', ki * jnp.exp(b_last - b), vi)
        return s_new, o_inter + o_intra

    s_fin, o = lax.scan(step, s0.astype(f32), (qc, kc, vc, gc))
    o = o.transpose(1, 0, 3, 2, 4).reshape(B, T, H, DV)
    return o, s_fin


def mla_prompt(q_lat, q_rope, ckv, krope):
    B, L = q_lat.shape[:2]
    nb = -(-L // Q_BLOCK)
    pad = nb * Q_BLOCK - L

    def qblocks(a):
        a = jnp.pad(a, ((0, 0), (0, pad), (0, 0), (0, 0)))
        return a.reshape(B, nb, Q_BLOCK, *a.shape[2:]).transpose(1, 0, 2, 3, 4)

    qpos = jnp.arange(nb * Q_BLOCK, dtype=jnp.int32).reshape(nb, Q_BLOCK)
    kpos = jnp.arange(L, dtype=jnp.int32)

    def blk(args):
        ql, qr, pq = args
        s = (jnp.einsum('bthc,bsc->bhts', ql, ckv) +
             jnp.einsum('bthr,bsr->bhts', qr, krope)).astype(jnp.float32) * MLA_SCALE
        s = jnp.where(kpos[None, None, None, :] <= pq[None, None, :, None], s, NEG_INF)
        p = jax.nn.softmax(s, axis=-1).astype(ckv.dtype)
        return jnp.einsum('bhts,bsc->bthc', p, ckv)

    o = lax.map(blk, (qblocks(q_lat), qblocks(q_rope), qpos))
    return o.transpose(1, 0, 2, 3, 4).reshape(B, nb * Q_BLOCK, MLA_HEADS, MLA_KV_LORA)[:, :L]


def mla_sample(q_lat, q_rope, ckv_new, krope_new, cache_ckv, cache_krope, page_table):
    Bd, T = q_lat.shape[:2]
    past_ckv = cache_ckv[page_table].reshape(Bd, -1, MLA_KV_LORA)
    past_kr = cache_krope[page_table].reshape(Bd, -1, MLA_ROPE)
    P = past_ckv.shape[1]
    s_past = jnp.einsum('bthc,bsc->bhts', q_lat, past_ckv) + jnp.einsum('bthr,bsr->bhts', q_rope, past_kr)
    s_new = jnp.einsum('bthc,bsc->bhts', q_lat, ckv_new) + jnp.einsum('bthr,bsr->bhts', q_rope, krope_new)
    causal = jnp.tril(jnp.ones((T, T), dtype=bool))
    s_new = jnp.where(causal, s_new.astype(jnp.float32) * MLA_SCALE, NEG_INF)
    s = jnp.concatenate([s_past.astype(jnp.float32) * MLA_SCALE, s_new], axis=-1)
    p = jax.nn.softmax(s, axis=-1).astype(ckv_new.dtype)
    return (jnp.einsum('bhts,bsc->bthc', p[..., :P], past_ckv) +
            jnp.einsum('bhts,bsc->bthc', p[..., P:], ckv_new))


def mixer_output(o_gla, g_g, o_lat, gla_norm_g, w_uv, w_o):
    B, T = o_gla.shape[:2]
    gate = jax.nn.silu(g_g.reshape(B, T, GLA_HEADS, GLA_DV))
    og = (rms_norm(o_gla, gla_norm_g) * gate).reshape(B, T, GLA_HEADS * GLA_DV)
    om = jnp.einsum('bthc,chv->bthv', o_lat, w_uv.reshape(MLA_KV_LORA, MLA_HEADS, MLA_DV))
    om = om.reshape(B, T, MLA_HEADS * MLA_DV)
    return jnp.concatenate([og, om], axis=-1) @ w_o


def conv_ffn(h, conv_prev, w_ffn_in, conv_w, conv_b, w_down):
    T = h.shape[1]
    a, up = jnp.split(h @ w_ffn_in, [D_FF], axis=-1)
    ext = jnp.concatenate([conv_prev.astype(a.dtype), a], axis=1)
    conv = conv_b + sum(conv_w[j] * ext[:, j:j + T] for j in range(CONV_W))
    return (jax.nn.silu(conv) * up) @ w_down, ext[:, T:]


def setup_inputs(seed: int = 0) -> dict:
    key = jax.random.key(seed)
    ks = jax.random.split(key, 32)
    n_pages = PAST_LEN // PAGE_SIZE
    n_used = DEC_BATCH * n_pages
    n_pool = n_used + n_used // 4
    f32 = jnp.float32
    nrm = lambda k, shape, s=1.0: jax.random.normal(k, shape, f32) * s
    page_table = jax.random.permutation(ks[0], n_pool)[:n_used].reshape(DEC_BATCH, n_pages).astype(jnp.int32)
    w_in = nrm(ks[8], (D_MODEL, IN_COLS), D_MODEL ** -0.5)
    w_in = w_in.at[:, V_START:V_END].multiply(DN_BETA)
    return {
        'x_prompt': nrm(ks[1], (BATCH, SEQ, D_MODEL)),
        'x_sample': nrm(ks[2], (DEC_BATCH, DEC_SEQ, D_MODEL)),
        'cache_ckv': nrm(ks[3], (n_pool, PAGE_SIZE, MLA_KV_LORA)),
        'cache_krope': nrm(ks[4], (n_pool, PAGE_SIZE, MLA_ROPE)),
        'page_table': page_table,
        'state_gla': nrm(ks[5], (DEC_BATCH, GLA_HEADS, GLA_DK, GLA_DV), 0.3),
        'state_conv': nrm(ks[6], (DEC_BATCH, CONV_W - 1, D_FF)),
        'meta_tokens': nrm(ks[7], (N_META, D_MODEL)),
        'ln_emb_g': 1.0 + nrm(ks[9], (D_MODEL,), 0.02),
        'ln_emb_b': nrm(ks[10], (D_MODEL,), 0.02),
        'w_in': w_in,
        'w_gate_up': nrm(ks[11], (GLA_GATE_RANK, GLA_HEADS * GLA_DK), GLA_GATE_RANK ** -0.5),
        'b_gate': nrm(ks[12], (GLA_HEADS * GLA_DK,), 0.1),
        'gla_norm_g': 1.0 + nrm(ks[13], (GLA_DV,), 0.02),
        'mla_q_norm_g': 1.0 + nrm(ks[14], (MLA_Q_LORA,), 0.02),
        'mla_kv_norm_g': 1.0 + nrm(ks[15], (MLA_KV_LORA,), 0.02),
        'w_uq': nrm(ks[16], (MLA_Q_LORA, MLA_HEADS * (MLA_NOPE + MLA_ROPE)), MLA_Q_LORA ** -0.5),
        'w_uk': nrm(ks[17], (MLA_KV_LORA, MLA_HEADS * MLA_NOPE), MLA_KV_LORA ** -0.5),
        'w_uv': nrm(ks[18], (MLA_KV_LORA, MLA_HEADS * MLA_DV), DN_BETA * MLA_KV_LORA ** -0.5),
        'w_o': nrm(ks[19], (MIX_WIDTH, D_MODEL), DN_BETA * MIX_WIDTH ** -0.5),
        'ln1_g': 1.0 + nrm(ks[20], (D_MODEL,), 0.02),
        'ln1_b': nrm(ks[21], (D_MODEL,), 0.02),
        'w_ffn_in': nrm(ks[22], (D_MODEL, 2 * D_FF), D_MODEL ** -0.5),
        'conv_w': nrm(ks[23], (CONV_W, D_FF), CONV_W ** -0.5),
        'conv_b': nrm(ks[24], (D_FF,), 0.02),
        'w_down': nrm(ks[25], (D_FF, D_MODEL), DN_BETA * D_FF ** -0.5),
        'ln2_g': 1.0 + nrm(ks[26], (D_MODEL,), 0.02),
        'ln2_b': nrm(ks[27], (D_MODEL,), 0.02),
    }


def reference(x_prompt, x_sample, cache_ckv, cache_krope, page_table, state_gla, state_conv,
              meta_tokens, ln_emb_g, ln_emb_b, w_in, w_gate_up, b_gate, gla_norm_g,
              mla_q_norm_g, mla_kv_norm_g, w_uq, w_uk, w_uv, w_o, ln1_g, ln1_b,
              w_ffn_in, conv_w, conv_b, w_down, ln2_g, ln2_b):
    proj = (w_in, w_gate_up, b_gate, mla_q_norm_g, mla_kv_norm_g, w_uq, w_uk)
    ffn_w = (w_ffn_in, conv_w, conv_b, w_down)

    L = N_META + SEQ
    meta = jnp.broadcast_to(meta_tokens.astype(x_prompt.dtype)[None], (BATCH, N_META, D_MODEL))
    h = layer_norm(jnp.concatenate([meta, x_prompt], axis=1), ln_emb_g, ln_emb_b)
    pos_p = jnp.arange(L, dtype=jnp.int32)
    gla_p = jnp.zeros((BATCH, GLA_HEADS, GLA_DK, GLA_DV), jnp.float32)
    ckv_prompt = None
    krope_prompt = None
    conv_prompt = None
    for _ in range(DEPTH):
        (q_g, k_g, v_g, log_a, g_g), (q_lat, q_rope, ckv, krope) = mixer_inputs(h, pos_p, *proj)
        o_meta, s_meta = gla_chunked(q_g[:, :N_META], k_g[:, :N_META], v_g[:, :N_META],
                                     log_a[:, :N_META], gla_p, N_META)
        o_tok, gla_p = gla_chunked(q_g[:, N_META:], k_g[:, N_META:], v_g[:, N_META:],
                                   log_a[:, N_META:], s_meta, GLA_CHUNK)
        o_gla = jnp.concatenate([o_meta, o_tok], axis=1).astype(h.dtype)
        o_lat = mla_prompt(q_lat, q_rope, ckv, krope)
        mix = mixer_output(o_gla, g_g, o_lat, gla_norm_g, w_uv, w_o)
        h1 = layer_norm(DN_ALPHA * h + mix, ln1_g, ln1_b)
        ffn, conv_prompt = conv_ffn(h1, jnp.zeros((BATCH, CONV_W - 1, D_FF), h1.dtype), *ffn_w)
        h = layer_norm(DN_ALPHA * h1 + ffn, ln2_g, ln2_b)
        ckv_prompt, krope_prompt = ckv, krope
    y_prompt = h[:, N_META:]

    hs = layer_norm(x_sample, ln_emb_g, ln_emb_b)
    pos_s = PAST_LEN + jnp.arange(DEC_SEQ, dtype=jnp.int32)
    gla_sample = state_gla
    conv_sample = state_conv
    ckv_sample = None
    krope_sample = None
    for _ in range(DEPTH):
        (q_g, k_g, v_g, log_a, g_g), (q_lat, q_rope, ckv, krope) = mixer_inputs(hs, pos_s, *proj)
        o_gla, gla_sample = gla_chunked(q_g, k_g, v_g, log_a, gla_sample, DEC_SEQ)
        o_lat = mla_sample(q_lat, q_rope, ckv, krope, cache_ckv, cache_krope, page_table)
        mix = mixer_output(o_gla.astype(hs.dtype), g_g, o_lat, gla_norm_g, w_uv, w_o)
        h1 = layer_norm(DN_ALPHA * hs + mix, ln1_g, ln1_b)
        ffn, conv_sample = conv_ffn(h1, conv_sample, *ffn_w)
        hs = layer_norm(DN_ALPHA * h1 + ffn, ln2_g, ln2_b)
        ckv_sample, krope_sample = ckv, krope
    y_sample = hs

    return (y_prompt, y_sample, ckv_prompt, krope_prompt, gla_p, conv_prompt,
            ckv_sample, krope_sample, gla_sample, conv_sample)
```

```cpp
#include <hip/hip_runtime.h>
#include <cstdio>
#include <cstdint>
namespace pg8 {
#define PG8_LAS __attribute__((address_space(3)))
typedef unsigned short bf16_t;
typedef short bf16x8 __attribute__((ext_vector_type(8)));
typedef float f32x4 __attribute__((ext_vector_type(4)));
typedef unsigned u32x4 __attribute__((ext_vector_type(4)));
constexpr int BM = 256, BK = 64, HALF = 128, HTB = HALF * BK * 2  , STAGE_BYTES = 8 * HTB, NXCD = 8, WGM = 8;

__host__ __device__ __forceinline__ int lds_byte(int r, int c) { const int st = (r >> 4) * 2 + (c >> 5), rr = r & 15, cc = c & 31, ob = rr * 64 + cc * 2; return st * 1024 + (ob ^ (((ob >> 9) & 1) << 5)); }
__host__ __device__ __forceinline__ void stage_rc(int b, int& R, int& C) { const int st = b / 1024, sb = b % 1024, swz = sb ^ (((sb >> 9) & 1) << 5); R = (st >> 1) * 16 + swz / 64; C = (st & 1) * 32 + (swz % 64) / 2; }
__host__ __device__ __forceinline__ int perm32(int rho) { const int n = rho >> 4, i = rho & 15; return 8 * (i >> 2) + 4 * n + (i & 3); }

struct Unit { int pm, pn; };
struct Gemm { const bf16_t* A; const bf16_t* Bt; int M, N, K; };

struct StaticOrder {
    int nM, nN, nwg, G, c;
    __host__ __device__ void init(int M, int N, int G_, int c_) { nM = M / BM; nN = N / BM; nwg = nM * nN; G = G_; c = c_; }
    __host__ __device__ bool next(int i, Unit& u) const {
        const long L = (long)i * G + c; if (L >= nwg) return false;
        int wgid = (int)L; { const int q = nwg / NXCD, r = nwg % NXCD, xcd = wgid % NXCD, off = wgid / NXCD; wgid = (xcd < r ? xcd * (q + 1) : r * (q + 1) + (xcd - r) * q) + off; }
        const int nig = WGM * nN, gid = wgid / nig, fm = gid * WGM, gsz = (nM - fm) < WGM ? (nM - fm) : WGM;
        u.pm = fm + ((wgid % nig) % gsz); u.pn = (wgid % nig) / gsz; return true;
    }
    __device__ __forceinline__ void a_ready(const Unit&) const {}
    __device__ __forceinline__ void done(const Unit&) const {}
};

__device__ __forceinline__ unsigned cvt_pk_bf16(float lo, float hi) { unsigned r; asm volatile("v_cvt_pk_bf16_f32 %0, %1, %2" : "=v"(r) : "v"(lo), "v"(hi)); return r; }
typedef float f32x2 __attribute__((ext_vector_type(2)));
__device__ __forceinline__ f32x2 gelu_pk(f32x2 v) {
    const f32x2 av = __builtin_elementwise_abs(v), d = av * 0.2316418882f + 1.0f;
    f32x2 t; t.x = __builtin_amdgcn_rcpf(d.x); t.y = __builtin_amdgcn_rcpf(d.y);
    f32x2 q = t * 0.5307027145f + (-0.7265760135f); q = q * t + 0.7107068705f; q = q * t + (-0.142248368f); q = q * t + 0.127414796f; q = q * t;
    const f32x2 s = (v * v) * (-0.72134752044f);
    f32x2 e; e.x = __builtin_amdgcn_exp2f(s.x); e.y = __builtin_amdgcn_exp2f(s.y);
    const f32x2 m = v * (q * e), r = v - m;
    f32x2 o; o.x = v.x < 0.f ? m.x : r.x; o.y = v.y < 0.f ? m.y : r.y; return o;
}

template <int ACT  > struct EpiBf16 {
    static constexpr bool PERM = true, AFTER_DRAIN = false; static_assert(ACT == 0 || ACT == 1, "EpiBf16: ACT is 0 (none) or 1 (gelu_pk)");
    bf16_t* O; int ldc; const float* bias; int split_cols; size_t split_stride; float scale0;
    __device__ __forceinline__ void operator()(const f32x4 (&acc)[2][2][4][2], const Unit& u, int wr, int wc, int fr, int fq) const {
        const int row0 = u.pm * BM + wr * 64 + fr; int colt = u.pn * BM; bf16_t* base = O;
        float sc = 1.f; if (split_cols) { const int t = colt / split_cols; base += (size_t)t * split_stride; colt -= t * split_cols; if (t == 0) sc = scale0; }
        const int col0 = colt + wc * 32 + 8 * fq, bcol0 = u.pn * BM + wc * 32 + 8 * fq;
        f32x4 bv[2][2];
#pragma unroll
        for (int bj = 0; bj < 2; ++bj)
#pragma unroll
            for (int n = 0; n < 2; ++n) bv[bj][n] = bias ? *(const f32x4*)(bias + bcol0 + bj * HALF + 4 * n) : (f32x4){0.f, 0.f, 0.f, 0.f};
#pragma unroll
        for (int ai = 0; ai < 2; ++ai)
#pragma unroll
            for (int m = 0; m < 4; ++m) { bf16_t* rowp = base + (size_t)(row0 + ai * HALF + m * 16) * ldc + col0;
#pragma unroll
                for (int bj = 0; bj < 2; ++bj) { f32x4 v0 = acc[ai][bj][m][0] + bv[bj][0], v1 = acc[ai][bj][m][1] + bv[bj][1];
                    if (ACT == 1) { f32x2 a = gelu_pk((f32x2){v0[0], v0[1]}), b = gelu_pk((f32x2){v0[2], v0[3]}), c = gelu_pk((f32x2){v1[0], v1[1]}), d = gelu_pk((f32x2){v1[2], v1[3]});
                        v0 = (f32x4){a.x, a.y, b.x, b.y}; v1 = (f32x4){c.x, c.y, d.x, d.y}; }
                    v0 = v0 * sc; v1 = v1 * sc; u32x4 w; w.x = cvt_pk_bf16(v0[0], v0[1]); w.y = cvt_pk_bf16(v0[2], v0[3]); w.z = cvt_pk_bf16(v1[0], v1[1]); w.w = cvt_pk_bf16(v1[2], v1[3]);
                    *(u32x4*)(rowp + bj * HALF) = w; } }
    }
};
struct EpiResF32 {
    static constexpr bool PERM = false, AFTER_DRAIN = false;
    float* O; const bf16_t* res; int ldc; float alpha;
    __device__ __forceinline__ void operator()(const f32x4 (&acc)[2][2][4][2], const Unit& u, int wr, int wc, int fr, int fq) const {
        typedef unsigned u32x2v __attribute__((ext_vector_type(2)));
        const int row0 = u.pm * BM + wr * 64 + fr, col0 = u.pn * BM + wc * 32 + 4 * fq;
#pragma unroll
        for (int ai = 0; ai < 2; ++ai)
#pragma unroll
            for (int m = 0; m < 4; ++m) { const size_t off = (size_t)(row0 + ai * HALF + m * 16) * ldc + col0;
#pragma unroll
                for (int bj = 0; bj < 2; ++bj)
#pragma unroll
                    for (int n = 0; n < 2; ++n) { const u32x2v rb = *(const u32x2v*)(res + off + bj * HALF + n * 16);
                        f32x4 r; r[0] = __uint_as_float(rb.x << 16); r[1] = __uint_as_float(rb.x & 0xffff0000u); r[2] = __uint_as_float(rb.y << 16); r[3] = __uint_as_float(rb.y & 0xffff0000u);
                        *(f32x4*)(O + off + bj * HALF + n * 16) = acc[ai][bj][m][n] + r * alpha; } }
    }
};
__device__ __forceinline__ float dpp_ror1(float v) { return __builtin_bit_cast(float, __builtin_amdgcn_update_dpp(0, __builtin_bit_cast(int, v), 0x121, 0xF, 0xF, false)); }
__device__ __forceinline__ float dpp_ror2(float v) { return __builtin_bit_cast(float, __builtin_amdgcn_update_dpp(0, __builtin_bit_cast(int, v), 0x122, 0xF, 0xF, false)); }
__device__ __forceinline__ float silu_f(float x) { return x * __builtin_amdgcn_rcpf(1.0f + __builtin_amdgcn_exp2f(-1.4426950408889634f * x)); }
struct EpiFfn {
    static constexpr bool PERM = true, AFTER_DRAIN = false;
    bf16_t* G; const float* halo; const float* conv_w; const float* conv_b; const float* state_conv; float* conv_prompt; float* conv_sample; PG8_LAS float* bnd;
    __device__ __forceinline__ void operator()(const f32x4 (&acc)[2][2][4][2], const Unit& u, int wr, int wc, int fr, int fq) const {
        constexpr int FF = 2816;
        const int pm = u.pm, pn = u.pn; const bool sample = pm >= 128;
        const int chl = wc * 32 + 8 * fq, chg = pn * 128 + chl;
#pragma unroll
        for (int ai = 0; ai < 2; ++ai) { const int blk = 2 * ai + wr;
            if (fr >= 14) {
                if (blk < 3) {
#pragma unroll
                    for (int n = 0; n < 2; ++n) *(PG8_LAS f32x4*)(bnd + ((blk + 1) * 2 + (fr - 14)) * 128 + chl + 4 * n) = acc[ai][0][3][n]; }
                else if (!sample && (pm & 7) == 7) {
#pragma unroll
                    for (int n = 0; n < 2; ++n) *(f32x4*)(conv_prompt + ((size_t)(pm >> 3) * 2 + (fr - 14)) * FF + chg + 4 * n) = acc[ai][0][3][n]; }
            } }
        asm volatile("s_waitcnt lgkmcnt(0)" ::: "memory"); __builtin_amdgcn_s_barrier(); asm volatile("" ::: "memory");
        f32x4 w0[2], w1[2], w2[2], cb[2];
#pragma unroll
        for (int n = 0; n < 2; ++n) { w0[n] = *(const f32x4*)(conv_w + chg + 4 * n); w1[n] = *(const f32x4*)(conv_w + FF + chg + 4 * n); w2[n] = *(const f32x4*)(conv_w + 2 * FF + chg + 4 * n); cb[n] = *(const f32x4*)(conv_b + chg + 4 * n); }
#pragma unroll
        for (int ai = 0; ai < 2; ++ai) { const int blk = 2 * ai + wr;
            f32x4 pv[2]; pv[0] = (f32x4){0.f, 0.f, 0.f, 0.f}; pv[1] = pv[0];
            if (fr >= 14) {
                if (blk == 0) { if (!sample) {
#pragma unroll
                    for (int n = 0; n < 2; ++n) pv[n] = *(const f32x4*)(halo + ((size_t)pm * 2 + (fr - 14)) * FF + chg + 4 * n); } }
                else {
#pragma unroll
                    for (int n = 0; n < 2; ++n) pv[n] = *(const PG8_LAS f32x4*)(bnd + (blk * 2 + (fr - 14)) * 128 + chl + 4 * n); }
            }
#pragma unroll
            for (int m = 0; m < 4; ++m) { const int row = pm * BM + ai * HALF + wr * 64 + m * 16 + fr;
                u32x4 wv;
#pragma unroll
                for (int n = 0; n < 2; ++n) { const f32x4 cur = acc[ai][0][m][n], up = acc[ai][1][m][n], pr = (m == 0) ? pv[n] : acc[ai][0][m > 0 ? m - 1 : 0][n];
                    f32x4 p1, p2;
#pragma unroll
                    for (int j = 0; j < 4; ++j) { const float a1 = dpp_ror1(cur[j]), b1 = dpp_ror1(pr[j]), a2 = dpp_ror2(cur[j]), b2 = dpp_ror2(pr[j]); p1[j] = fr == 0 ? b1 : a1; p2[j] = fr < 2 ? b2 : a2; }
                    if (sample) { const int t = fr & 3, sb = (row - 32768) >> 2;
                        if (t < 2) { const f32x4 s1 = *(const f32x4*)(state_conv + ((size_t)sb * 2 + 1) * FF + chg + 4 * n);
                            if (t == 0) { p1 = s1; p2 = *(const f32x4*)(state_conv + ((size_t)sb * 2) * FF + chg + 4 * n); } else p2 = s1; }
                        else *(f32x4*)(conv_sample + ((size_t)sb * 2 + (t - 2)) * FF + chg + 4 * n) = cur; }
                    const f32x4 cv = cb[n] + w0[n] * p2 + w1[n] * p1 + w2[n] * cur;
                    const float g0 = silu_f(cv[0]) * up[0], g1 = silu_f(cv[1]) * up[1], g2 = silu_f(cv[2]) * up[2], g3 = silu_f(cv[3]) * up[3];
                    if (n == 0) { wv.x = cvt_pk_bf16(g0, g1); wv.y = cvt_pk_bf16(g2, g3); } else { wv.z = cvt_pk_bf16(g0, g1); wv.w = cvt_pk_bf16(g2, g3); } }
                *(u32x4*)(G + (size_t)row * FF + chg) = wv; }
        }
        asm volatile("s_waitcnt lgkmcnt(0)" ::: "memory"); __builtin_amdgcn_s_barrier(); asm volatile("" ::: "memory");
    }
};
template <class Epi, class Sched, bool ALIGN_EPI = false, bool SP2 = false>
__device__ __forceinline__ void gemm_phase(PG8_LAS unsigned char* lds, const Gemm g, const Sched& S, const Epi& E) {
    const int tid = threadIdx.x, wid = __builtin_amdgcn_readfirstlane(tid >> 6), lane = tid & 63, wr = wid >> 2, wc = wid & 3, fr = lane & 15, fq = lane >> 4;
    const int K = g.K, nt = K / BK;
    unsigned voffA[2], voffB[2];
#pragma unroll
    for (int i = 0; i < 2; ++i) { int R, C; stage_rc(tid * 16 + i * 8192, R, C); const int Rb = Epi::PERM ? ((R & ~31) + perm32(R & 31)) : R;
        voffA[i] = (unsigned)(R * K + C) * 2u; voffB[i] = (unsigned)(Rb * K + C) * 2u; }
    const size_t kstep = (size_t)(BK * 2);
    const size_t hstep = (size_t)HALF * K * 2;
    const size_t tstep = 2 * hstep;
    const unsigned ldsw = (unsigned)wid * 1024u;
    const int aoff = lds_byte(wr * 64 + fr, fq * 8), boff = lds_byte(wc * 32 + fr, fq * 8);
#define PG8_SA(b, h) (((b) * 2 + (h)) * HTB)
#define PG8_SB(b, h) ((4 + (b) * 2 + (h)) * HTB)
#define PG8_STAGE(bufoff, gbase, voff) do { _Pragma("unroll") for (int _i = 0; _i < 2; ++_i) \
        __builtin_amdgcn_global_load_lds((const unsigned*)((const char*)(gbase) + (voff)[_i]), (PG8_LAS unsigned*)(lds + (bufoff) + ldsw + _i * 8192), 16, 0, 0); } while (0)
#define PG8_LDA(dst, b, h) do { _Pragma("unroll") for (int m = 0; m < 4; ++m) _Pragma("unroll") for (int k = 0; k < 2; ++k) dst[m][k] = *(const PG8_LAS bf16x8*)(lds + PG8_SA(b, h) + aoff + m * 2048 + k * 1024); } while (0)
#define PG8_LDB(dst, b, h) do { _Pragma("unroll") for (int n = 0; n < 2; ++n) _Pragma("unroll") for (int k = 0; k < 2; ++k) dst[n][k] = *(const PG8_LAS bf16x8*)(lds + PG8_SB(b, h) + boff + n * 2048 + k * 1024); } while (0)
#define PG8_MMA(ai, bj, At, Bt) do { __builtin_amdgcn_s_setprio(1); _Pragma("unroll") for (int m = 0; m < 4; ++m) _Pragma("unroll") for (int n = 0; n < 2; ++n) _Pragma("unroll") for (int k = 0; k < 2; ++k) \
        acc[ai][bj][m][n] = __builtin_amdgcn_mfma_f32_16x16x32_bf16(Bt[n][k], At[m][k], acc[ai][bj][m][n], 0, 0, 0); __builtin_amdgcn_s_setprio(0); } while (0)
#define PG8_WAIT_V(n) asm volatile("s_waitcnt vmcnt(" #n ")" ::: "memory")
#define PG8_WAIT_L(n) asm volatile("s_waitcnt lgkmcnt(" #n ")" ::: "memory")
#define PG8_BAR __builtin_amdgcn_s_barrier()
#define PG8_SCHED __builtin_amdgcn_sched_barrier(0)
    Unit cur, nxt; int ui = 0;
    if (!S.next(0, cur)) return;
    f32x4 acc[2][2][4][2];
#pragma unroll
    for (int a = 0; a < 2; ++a)
#pragma unroll
        for (int b = 0; b < 2; ++b)
#pragma unroll
            for (int m = 0; m < 4; ++m)
#pragma unroll
                for (int n = 0; n < 2; ++n) acc[a][b][m][n] = (f32x4){0.f, 0.f, 0.f, 0.f};
    bf16x8 At[4][2], B0[2][2], B1[2][2];
    const char* cA = (const char*)g.A + (size_t)cur.pm * tstep; const char* cB = (const char*)g.Bt + (size_t)cur.pn * tstep;
    S.a_ready(cur);
    if constexpr (SP2) {
        PG8_STAGE(PG8_SB(0, 0), cB, voffB); PG8_STAGE(PG8_SB(0, 1), cB + hstep, voffB); PG8_STAGE(PG8_SA(0, 0), cA, voffA); PG8_STAGE(PG8_SA(0, 1), cA + hstep, voffA);
        if (wr == 1) PG8_BAR;
        PG8_WAIT_V(2); PG8_BAR;
        PG8_STAGE(PG8_SB(1, 0), cB + kstep, voffB); PG8_STAGE(PG8_SA(1, 0), cA + kstep, voffA); PG8_STAGE(PG8_SB(1, 1), cB + hstep + kstep, voffB);
        PG8_WAIT_V(6); PG8_BAR;
    } else {
        PG8_STAGE(PG8_SB(0, 0), cB, voffB); PG8_STAGE(PG8_SA(0, 0), cA, voffA); PG8_STAGE(PG8_SB(0, 1), cB + hstep, voffB); PG8_STAGE(PG8_SA(0, 1), cA + hstep, voffA);
        if (wr == 1) PG8_BAR;
        PG8_WAIT_V(4); PG8_BAR;
        PG8_STAGE(PG8_SB(1, 0), cB + kstep, voffB); PG8_STAGE(PG8_SA(1, 0), cA + kstep, voffA); PG8_STAGE(PG8_SB(1, 1), cB + hstep + kstep, voffB);
        PG8_WAIT_V(6); PG8_BAR;
    }
    for (;;) {
        const bool has_next = S.next(ui + 1, nxt);
        const char* nA = has_next ? (const char*)g.A + (size_t)nxt.pm * tstep : cA; const char* nB = has_next ? (const char*)g.Bt + (size_t)nxt.pn * tstep : cB;
        for (int t = 0; t < nt; t += 2) {
            const bool last = (t == nt - 2);
            const char* a1 = cA + (size_t)(t + 1) * kstep;
            const char* a2 = last ? nA : cA + (size_t)(t + 2) * kstep; const char* b2 = last ? nB : cB + (size_t)(t + 2) * kstep;
            const char* a3 = a2 + kstep; const char* b3 = b2 + kstep;
            if (last && has_next) S.a_ready(nxt);
            if constexpr (SP2) {
            PG8_LDB(B0, 0, 0); PG8_LDB(B1, 0, 1); PG8_SCHED; PG8_LDA(At, 0, 0); PG8_STAGE(PG8_SA(1, 1), a1 + hstep, voffA);
            PG8_WAIT_V(8); PG8_WAIT_L(0); PG8_BAR; PG8_MMA(0, 0, At, B0); PG8_MMA(0, 1, At, B1); PG8_BAR; PG8_SCHED;
            PG8_LDA(At, 0, 1); PG8_STAGE(PG8_SB(0, 0), b2, voffB); PG8_STAGE(PG8_SB(0, 1), b2 + hstep, voffB); PG8_STAGE(PG8_SA(0, 0), a2, voffA);
            PG8_WAIT_V(8); PG8_WAIT_L(0); PG8_BAR; PG8_MMA(1, 0, At, B0); PG8_MMA(1, 1, At, B1); PG8_BAR; PG8_SCHED;
            PG8_LDB(B0, 1, 0); PG8_LDB(B1, 1, 1); PG8_SCHED; PG8_LDA(At, 1, 0); PG8_STAGE(PG8_SA(0, 1), a2 + hstep, voffA);
            PG8_WAIT_V(8); PG8_WAIT_L(0); PG8_BAR; PG8_MMA(0, 0, At, B0); PG8_MMA(0, 1, At, B1); PG8_BAR; PG8_SCHED;
            PG8_LDA(At, 1, 1); PG8_STAGE(PG8_SB(1, 0), b3, voffB); PG8_STAGE(PG8_SB(1, 1), b3 + hstep, voffB); PG8_STAGE(PG8_SA(1, 0), a3, voffA);
            PG8_WAIT_V(8); PG8_WAIT_L(0); PG8_BAR; PG8_MMA(1, 0, At, B0); PG8_MMA(1, 1, At, B1); PG8_BAR; PG8_SCHED;
            } else {
            PG8_LDB(B0, 0, 0); PG8_SCHED; PG8_LDA(At, 0, 0); PG8_STAGE(PG8_SA(1, 1), a1 + hstep, voffA);
            PG8_WAIT_L(8); PG8_BAR; PG8_WAIT_L(0); PG8_MMA(0, 0, At, B0); PG8_BAR; PG8_SCHED;
            PG8_LDB(B1, 0, 1); PG8_STAGE(PG8_SB(0, 0), b2, voffB);
            PG8_BAR; PG8_WAIT_L(0); PG8_MMA(0, 1, At, B1); PG8_BAR;
            PG8_LDA(At, 0, 1); PG8_STAGE(PG8_SA(0, 0), a2, voffA);
            PG8_BAR; PG8_WAIT_L(0); PG8_MMA(1, 0, At, B0); PG8_BAR; PG8_SCHED;
            PG8_STAGE(PG8_SB(0, 1), b2 + hstep, voffB);
            PG8_WAIT_V(6); PG8_BAR; PG8_MMA(1, 1, At, B1); PG8_BAR;
            PG8_LDB(B0, 1, 0); PG8_SCHED; PG8_LDA(At, 1, 0); PG8_STAGE(PG8_SA(0, 1), a2 + hstep, voffA);
            PG8_WAIT_L(8); PG8_BAR; PG8_WAIT_L(0); PG8_MMA(0, 0, At, B0); PG8_BAR; PG8_SCHED;
            PG8_LDB(B1, 1, 1); PG8_STAGE(PG8_SB(1, 0), b3, voffB);
            PG8_BAR; PG8_WAIT_L(0); PG8_MMA(0, 1, At, B1); PG8_BAR;
            PG8_LDA(At, 1, 1); PG8_STAGE(PG8_SA(1, 0), a3, voffA);
            PG8_BAR; PG8_WAIT_L(0); PG8_MMA(1, 0, At, B0); PG8_BAR; PG8_SCHED;
            PG8_STAGE(PG8_SB(1, 1), b3 + hstep, voffB);
            PG8_WAIT_V(6); PG8_BAR; PG8_MMA(1, 1, At, B1); PG8_BAR;
            }
        }
        if constexpr (ALIGN_EPI) { if (wr == 0) PG8_BAR; }
        if constexpr (!Epi::AFTER_DRAIN) { E(acc, cur, wr, wc, fr, fq); S.done(cur); }
        if (!has_next) break;
#pragma unroll
        for (int a = 0; a < 2; ++a)
#pragma unroll
            for (int b = 0; b < 2; ++b)
#pragma unroll
                for (int m = 0; m < 4; ++m)
#pragma unroll
                    for (int n = 0; n < 2; ++n) acc[a][b][m][n] = (f32x4){0.f, 0.f, 0.f, 0.f};
        cur = nxt; cA = nA; cB = nB; ++ui;
        if constexpr (ALIGN_EPI) { if (wr == 1) PG8_BAR; }
    }
    PG8_WAIT_V(0);
    if constexpr (!ALIGN_EPI) { if (wr == 0) PG8_BAR; }
    PG8_BAR;
    if constexpr (Epi::AFTER_DRAIN) { E.fused(acc, cur, wr, wc, fr, fq, lds, wid, lane); S.done(cur); }
#undef PG8_SA
#undef PG8_SB
#undef PG8_STAGE
#undef PG8_LDA
#undef PG8_LDB
#undef PG8_MMA
#undef PG8_WAIT_V
#undef PG8_WAIT_L
#undef PG8_BAR
#undef PG8_SCHED
}
}
#define GAS __attribute__((address_space(1)))
#define LAS __attribute__((address_space(3)))
typedef unsigned short bf16;
typedef unsigned v4u __attribute__((ext_vector_type(4)));
typedef float f32x4 __attribute__((ext_vector_type(4)));
typedef short bf16x8 __attribute__((ext_vector_type(8)));
typedef GAS unsigned gu32;
typedef GAS unsigned long long gu64;
#define RLX_AGENT __ATOMIC_RELAXED, __HIP_MEMORY_SCOPE_AGENT
#define LDS_WAIT() asm volatile("s_waitcnt lgkmcnt(0)" ::: "memory")
#define VM_WAIT() asm volatile("s_waitcnt vmcnt(0)" ::: "memory")
__device__ __forceinline__ unsigned long long rt() { return __builtin_amdgcn_s_memrealtime(); }
__device__ __forceinline__ unsigned f2bf(float f) { unsigned u = __builtin_bit_cast(unsigned, f); return (u + 0x7fffu + ((u >> 16) & 1u)) >> 16; }
__device__ __forceinline__ unsigned pk2(float lo, float hi) { return f2bf(lo) | (f2bf(hi) << 16); }

#define XB_TMO      128
#define XB_XCNT(j)  (256  + 64 * (j))
#define XB_XSUB(j)  (1280 + 64 * (j))
#define XB_XGEN(j)  (2304 + 64 * (j))
#define XB_TOP      3328
#define XB_TOPGEN   3392
#define XCD_BAR_WORDS 3456
#define XB_SPIN_CAP (1u << 18)

__device__ __forceinline__ unsigned xb_ld(unsigned* p)              { return __hip_atomic_load(p, __ATOMIC_RELAXED, __HIP_MEMORY_SCOPE_AGENT); }
__device__ __forceinline__ unsigned xb_add(unsigned* p, unsigned v) { return __hip_atomic_fetch_add(p, v, __ATOMIC_RELAXED, __HIP_MEMORY_SCOPE_AGENT); }
__device__ __forceinline__ unsigned xb_xcc_id() { return (unsigned)__builtin_amdgcn_s_getreg((3 << 11) | 20) & 0xFu; }
#define XB_SPIN(cond, bar) do { unsigned _sp = 0; while (cond) { __builtin_amdgcn_s_sleep(1); \
    if ((++_sp & 255u) == 0u) { if (xb_ld(&(bar)[XB_TMO])) break; if (_sp > XB_SPIN_CAP) { atomicAdd(&(bar)[XB_TMO], 1u); break; } } } } while (0)

struct XcdBarrier {
    unsigned* bar; unsigned x;
    volatile LAS unsigned* st;
};

__device__ __forceinline__ XcdBarrier xcd_barrier_post(unsigned* bar, volatile LAS unsigned* st) {
    XcdBarrier b; b.bar = bar; b.x = xb_xcc_id(); b.st = st;
    if (threadIdx.x == 0) (void)xb_add(&bar[XB_XCNT(b.x)], 1u);
    return b;
}
__device__ __forceinline__ void xcd_barrier_complete(unsigned* bar, unsigned x, unsigned& nloc, unsigned& nx) {
    const unsigned G = gridDim.x * gridDim.y * gridDim.z;
    unsigned sum, cnt, mine, sp = 0u;
    for (;;) {
        sum = 0u; cnt = 0u; mine = 0u;
#pragma unroll
        for (unsigned j = 0; j < 16; ++j) { const unsigned c = xb_ld(&bar[XB_XCNT(j)]); sum += c; cnt += (c > 0u) ? 1u : 0u; mine = (j == x) ? c : mine; }
        if (sum == G) break;
        __builtin_amdgcn_s_sleep(1);
        if ((++sp & 255u) == 0u) { if (xb_ld(&bar[XB_TMO])) break; if (sp > XB_SPIN_CAP) { atomicAdd(&bar[XB_TMO], 1u); break; } }
    }
    nloc = mine > 0u ? mine : 1u; nx = cnt > 0u ? cnt : 1u;
}

__device__ __forceinline__ void xcd_barrier(const XcdBarrier& b) {
    asm volatile("s_waitcnt vmcnt(0)" ::: "memory");
    __syncthreads();
    if (threadIdx.x == 0) {
        unsigned* bar = b.bar;
        __builtin_amdgcn_s_waitcnt(0);
        unsigned nloc = b.st[0], nx = b.st[1];
        if (nloc == 0u) { xcd_barrier_complete(bar, b.x, nloc, nx); b.st[0] = nloc; b.st[1] = nx; }
        const unsigned old = xb_add(&bar[XB_XSUB(b.x)], 1u);
        const unsigned gen = old / nloc;
        if (old + 1u == (gen + 1u) * nloc) {
            __builtin_amdgcn_fence(__ATOMIC_RELEASE, "agent");
            asm volatile("s_waitcnt vmcnt(0)" ::: "memory");
            const unsigned og = xb_add(&bar[XB_TOP], 1u);
            const unsigned tg = og / nx;
            if (og + 1u == (tg + 1u) * nx) xb_add(&bar[XB_TOPGEN], 1u);
            else XB_SPIN(xb_ld(&bar[XB_TOPGEN]) == tg, bar);
            __builtin_amdgcn_fence(__ATOMIC_ACQUIRE, "agent");
            xb_add(&bar[XB_XGEN(b.x)], 1u);
            asm volatile("s_waitcnt vmcnt(0)" ::: "memory");
        } else {
            XB_SPIN(xb_ld(&bar[XB_XGEN(b.x)]) == gen, bar);
            __builtin_amdgcn_fence(__ATOMIC_ACQUIRE, "agent");
            asm volatile("s_waitcnt vmcnt(0)" ::: "memory");
        }
    }
    __syncthreads();
}
constexpr int NWAVES = 8, NTHR = 512;
constexpr int DM = 1024, NB = 16, SEQ = 2048, NMETA = 16, LTOT = NMETA + SEQ, DB = 128, DS = 4, NPAGES = 64, PAGE = 128;
constexpr int R_PROMPT = NB * SEQ, R_SAMPLE0 = R_PROMPT, R_META0 = R_PROMPT + DB * DS, R_VALID = R_META0 + NMETA, RTOT = 33536;
constexpr int R_FFN = R_META0;
static_assert(R_PROMPT == 32768 && R_META0 == 33280 && R_VALID == 33296 && RTOT % 256 == 0 && RTOT >= R_META0 + 256, "row map");
constexpr int ZC = 2304;
constexpr int ZQ = 0, ZK = 256, ZV = 512, ZG = 1024, ZA = 1536, ZCQ = 1552, ZCKV = 1936, ZKR = 2192, ZEND = 2224;
constexpr int QL = 384, KVL = 256, ROPE = 32, QW = 768, FF = 2816;
constexpr float NORM_EPS = 1e-5f, DN_ALPHA = 1.189207115002721f;
constexpr float ATT_SC = 0.10206207261596575f * 1.4426950408889634f;
constexpr size_t O_YP = 0, O_YS = 33554432, O_CKVP = 34078720, O_KRP = 42532864, O_GLAP = 43589632, O_CONVP = 44113920, O_CKVS = 44204032, O_KRS = 44335104, O_GLAS = 44351488, O_CONVS = 48545792, O_END = 49266688;
constexpr size_t MiB = 1u << 20;
constexpr size_t WS_CTL = 0, CTL_ZERO_BYTES = 1 * MiB, WS_ROPE = 1 * MiB, WS_WIN = 2 * MiB, WS_WUQ = 7 * MiB, WS_WKV = 8 * MiB, WS_WO = 9 * MiB, WS_WFFN = 11 * MiB, WS_WDOWN = 22 * MiB;
constexpr size_t WS_XN = 32 * MiB, WS_Z = 98 * MiB, WS_CQN = 246 * MiB, WS_CKV = 271 * MiB, WS_KR = 288 * MiB, WS_Q = 291 * MiB, WS_KV = 341 * MiB, WS_AO = 407 * MiB, WS_Y1 = 473 * MiB, WS_H1 = 604 * MiB;
constexpr size_t WS_G = 670 * MiB, WS_Y2 = 851 * MiB, WS_KVC = 982 * MiB, WS_DEC = 1047 * MiB, WS_ST = 1048 * MiB, WS_HALO = 1081 * MiB, WS_END = 1084 * MiB;
static_assert(WS_WIN + (size_t)ZC * DM * 2 <= WS_WUQ && WS_WFFN + (size_t)2 * FF * DM * 2 <= WS_WDOWN && WS_WDOWN + (size_t)DM * FF * 2 <= WS_XN, "weights map");
static_assert(WS_XN + (size_t)RTOT * DM * 2 <= WS_Z && WS_Z + (size_t)RTOT * ZC * 2 <= WS_CQN && WS_CQN + (size_t)RTOT * QL * 2 <= WS_CKV && WS_CKV + (size_t)RTOT * KVL * 2 <= WS_KR && WS_KR + (size_t)RTOT * ROPE * 2 <= WS_Q, "act map 1");
static_assert(WS_Q + (size_t)RTOT * QW * 2 <= WS_KV && WS_KV + (size_t)RTOT * 1024 * 2 <= WS_AO && WS_AO + (size_t)RTOT * DM * 2 <= WS_Y1 && WS_Y1 + (size_t)RTOT * DM * 4 <= WS_H1 && WS_H1 + (size_t)RTOT * DM * 2 <= WS_G, "act map 2");
static_assert(WS_G + (size_t)RTOT * FF * 2 <= WS_Y2 && WS_Y2 + (size_t)RTOT * DM * 4 <= WS_KVC && WS_KVC + (size_t)2052 * 32768 <= WS_DEC && WS_DEC + (size_t)2052 * 256 <= WS_ST && WS_ST + (size_t)2048 * 16384 <= WS_HALO && WS_HALO + (size_t)128 * 2 * FF * 4 <= WS_END, "act map 3");
constexpr int CW_TMO = 0, CW_QUEUE = 64, CW_BAR = 4096;
constexpr int RING_OFF = 0, RING_BYTES = 131072, XTRA_OFF = RING_BYTES, XTRA_BYTES = 4096, LDSCTL_OFF = XTRA_OFF + XTRA_BYTES, MISC_OFF = LDSCTL_OFF + 320, LDS_BYTES = 147456;
static_assert(MISC_OFF + 128 <= LDS_BYTES, "LDS map");
constexpr int NPH = 11;
#ifndef MK_N_LAUNCHES
#define MK_N_LAUNCHES 1
#endif
constexpr int N_LAUNCHES = MK_N_LAUNCHES;

typedef float f32x16 __attribute__((ext_vector_type(16)));
typedef unsigned u32x2 __attribute__((ext_vector_type(2)));
typedef short s16x4 __attribute__((ext_vector_type(4)));
typedef LAS unsigned char* ldsp;
__device__ __forceinline__ float bf2f(unsigned short x) { return __uint_as_float((unsigned)x << 16); }
__device__ __forceinline__ float bflo(unsigned x) { return __uint_as_float(x << 16); }
__device__ __forceinline__ float bfhi(unsigned x) { return __uint_as_float(x & 0xffff0000u); }
__device__ __forceinline__ int crow(int r, int hi) { return (r & 3) + 8 * (r >> 2) + 4 * hi; }
__device__ __forceinline__ float wave_sum(float v) {
#pragma unroll
    for (int o = 1; o < 64; o <<= 1) v += __shfl_xor(v, o);
    return v;
}
__device__ __forceinline__ s16x4 tr_read(const LAS unsigned char* p) { return __builtin_bit_cast(s16x4, __builtin_amdgcn_ds_read_tr16_b64_v4i16((LAS s16x4*)p)); }
__device__ __forceinline__ bf16x8 cat4(s16x4 a, s16x4 b) { return (bf16x8){a[0], a[1], a[2], a[3], b[0], b[1], b[2], b[3]}; }
__device__ __forceinline__ unsigned pkbf(float lo, float hi) { unsigned r; asm("v_cvt_pk_bf16_f32 %0, %1, %2" : "=v"(r) : "v"(lo), "v"(hi)); return r; }
__device__ __forceinline__ bf16x8 pack8(float a, float b, float c, float d, float e, float f, float g, float h) { v4u w; w.x = pkbf(a, b); w.y = pkbf(c, d); w.z = pkbf(e, f); w.w = pkbf(g, h); return __builtin_bit_cast(bf16x8, w); }
__device__ __forceinline__ void lds_mma32(f32x16& acc, const LAS unsigned char* a, int sa, const LAS unsigned char* bt, int sb, int m0, int n0, int K, int lane) {
    const int r = lane & 31, h = lane >> 5;
    const LAS unsigned char* pa = a + (m0 + r) * sa + h * 16; const LAS unsigned char* pb = bt + (n0 + r) * sb + h * 16;
#pragma unroll 4
    for (int k = 0; k < K; k += 16) acc = __builtin_amdgcn_mfma_f32_32x32x16_bf16(*(const LAS bf16x8*)(pa + k * 2), *(const LAS bf16x8*)(pb + k * 2), acc, 0, 0, 0);
}

struct Frame {
    ldsp lds; volatile LAS unsigned* MISC; gu32* ctl;
    int tid, lane, wave, G, bid;
    const float *x_prompt, *x_sample, *cache_ckv, *cache_krope, *state_gla, *state_conv, *meta, *ln_emb_g, *ln_emb_b, *w_in, *w_gate_up, *b_gate, *gla_norm_g, *q_norm_g, *kv_norm_g, *w_uq, *w_uk, *w_uv, *w_o,
        *ln1_g, *ln1_b, *w_ffn_in, *conv_w, *conv_b, *w_down, *ln2_g, *ln2_b;
    const int* page_table;
    float* out; unsigned char* ws;
    bf16 *Win_t, *Wuq_t, *Wkv_t, *Wo_t, *Wffn_t, *Wdown_t, *XN, *Z, *CQN, *CKV, *KR, *Q, *KV, *AO, *H1, *Gb, *ST;
    float *ROPE_T, *Y1, *Y2, *KVC, *DEC, *HALO;
};

__device__ __forceinline__ void p0_transpose_item(const float* W, int K, int N, bf16* WT, int k0, int n0, int drow0, LAS float* scr, int lane) {
#pragma unroll 8
    for (int i = 0; i < 32; ++i) { const int kk = 2 * i + (lane >> 5), n = n0 + (lane & 31); scr[kk * 33 + (lane & 31)] = (n < N) ? W[(size_t)(k0 + kk) * N + n] : 0.f; }
    LDS_WAIT(); asm volatile("" ::: "memory");
    const int c = lane & 7;
#pragma unroll
    for (int j = 0; j < 4; ++j) { const int n = (lane >> 3) + 8 * j; const LAS float* s = scr + (8 * c) * 33 + n;
        v4u o; o.x = pk2(s[0 * 33], s[1 * 33]); o.y = pk2(s[2 * 33], s[3 * 33]); o.z = pk2(s[4 * 33], s[5 * 33]); o.w = pk2(s[6 * 33], s[7 * 33]);
        *(GAS v4u*)(WT + (size_t)(drow0 + n) * K + k0 + 8 * c) = o; }
    LDS_WAIT(); asm volatile("" ::: "memory");
}
__device__ __forceinline__ void ln_row_bf16(const float* xrow, const float* g, const float* b, bf16* orow, int lane) {
    GAS unsigned long long* o8 = (GAS unsigned long long*)orow + lane;
    if (!xrow) {
#pragma unroll
        for (int j = 0; j < 4; ++j) o8[64 * j] = 0ull;
        return; }
    const GAS f32x4* xr = (const GAS f32x4*)xrow + lane;
    f32x4 v[4]; float s = 0.f;
#pragma unroll
    for (int j = 0; j < 4; ++j) { v[j] = xr[64 * j]; s += (v[j].x + v[j].y) + (v[j].z + v[j].w); }
    const float mean = wave_sum(s) * (1.f / DM); float s2 = 0.f;
#pragma unroll
    for (int j = 0; j < 4; ++j) { v[j] = v[j] - mean; s2 += (v[j].x * v[j].x + v[j].y * v[j].y) + (v[j].z * v[j].z + v[j].w * v[j].w); }
    const float rstd = 1.f / sqrtf(wave_sum(s2) * (1.f / DM) + NORM_EPS);
#pragma unroll
    for (int j = 0; j < 4; ++j) { const f32x4 gg = *((const GAS f32x4*)g + lane + 64 * j), bb = *((const GAS f32x4*)b + lane + 64 * j); const f32x4 y = v[j] * rstd * gg + bb;
        o8[64 * j] = (unsigned long long)pk2(y.x, y.y) | ((unsigned long long)pk2(y.z, y.w) << 32); }
}
__device__ __forceinline__ void p0_prologue(Frame& F) {
    LAS float* scr = (LAS float*)(F.lds + RING_OFF + F.wave * 16384);
    const int gw = F.bid * NWAVES + F.wave, NGW = F.G * NWAVES;
    constexpr int I_IN = 16 * 72, I_UQ = 6 * 24, I_UK = 4 * 16, I_UV = 4 * 16, I_O = 16 * 32, I_FF = 16 * 176, I_DN = 44 * 32;
    constexpr int NITEMS = I_IN + I_UQ + I_UK + I_UV + I_O + I_FF + I_DN;
    for (int it = gw; it < NITEMS; it += NGW) {
        int r = it;
        if (r < I_IN) { const int kb = r / 72, nb = r % 72; p0_transpose_item(F.w_in, DM, ZEND, F.Win_t, 64 * kb, 32 * nb, 32 * nb, scr, F.lane); continue; } r -= I_IN;
        if (r < I_UQ) { const int kb = r / 24, nb = r % 24; p0_transpose_item(F.w_uq, QL, QW, F.Wuq_t, 64 * kb, 32 * nb, 32 * nb, scr, F.lane); continue; } r -= I_UQ;
        if (r < I_UK) { const int kb = r / 16, nb = r % 16; p0_transpose_item(F.w_uk, KVL, 512, F.Wkv_t, 64 * kb, 32 * nb, 32 * nb, scr, F.lane); continue; } r -= I_UK;
        if (r < I_UV) { const int kb = r / 16, nb = r % 16; p0_transpose_item(F.w_uv, KVL, 512, F.Wkv_t, 64 * kb, 32 * nb, 512 + 32 * nb, scr, F.lane); continue; } r -= I_UV;
        if (r < I_O) { const int kb = r / 32, nb = r % 32; p0_transpose_item(F.w_o, DM, DM, F.Wo_t, 64 * kb, 32 * nb, 32 * nb, scr, F.lane); continue; } r -= I_O;
        if (r < I_FF) { const int kb = r / 176, nb = r % 176; const int n0 = 32 * nb, half = n0 >= FF ? 1 : 0, ch = n0 - half * FF;
            p0_transpose_item(F.w_ffn_in, DM, 2 * FF, F.Wffn_t, 64 * kb, n0, 256 * (ch >> 7) + 128 * half + (ch & 127), scr, F.lane); continue; } r -= I_FF;
        { const int kb = r / 32, nb = r % 32; p0_transpose_item(F.w_down, FF, DM, F.Wdown_t, 64 * kb, 32 * nb, 32 * nb, scr, F.lane); }
    }
    for (int m = gw; m < RTOT; m += NGW) {
        const float* src = m < R_PROMPT ? F.x_prompt + (size_t)m * DM : m < R_META0 ? F.x_sample + (size_t)(m - R_SAMPLE0) * DM : m < R_VALID ? F.meta + (size_t)(m - R_META0) * DM : nullptr;
        ln_row_bf16(src, F.ln_emb_g, F.ln_emb_b, F.XN + (size_t)m * DM, F.lane);
    }
    for (int i = F.bid * NTHR + F.tid; i < (LTOT + DS) * 16; i += F.G * NTHR) { const int p = i >> 4, k = i & 15; const float pos = (float)(p < LTOT ? p : 8192 + (p - LTOT));
        const float inv = exp2f(-(float)k * (13.287712379549449f / 16.0f)); const float ang = pos * inv;
        const double tw = 6.283185307179586476925; const double n = rint((double)ang / tw); const float rr = (float)((double)ang - n * tw);
        F.ROPE_T[p * 32 + k] = cosf(rr); F.ROPE_T[p * 32 + 16 + k] = sinf(rr); }
}

__device__ __forceinline__ void p2_row(Frame& F, int m) {
    const int lane = F.lane; const bf16* z = F.Z + (size_t)m * ZC;
    int ridx, nout = 1; size_t oc, ok;
    if (m < R_PROMPT) { const int b = m >> 11, t = m & 2047; ridx = NMETA + t; oc = O_CKVP + ((size_t)b * LTOT + NMETA + t) * KVL; ok = O_KRP + ((size_t)b * LTOT + NMETA + t) * ROPE; }
    else if (m < R_META0) { const int i = m - R_SAMPLE0; ridx = LTOT + (i & 3); oc = O_CKVS + (size_t)i * KVL; ok = O_KRS + (size_t)i * ROPE; }
    else if (m < R_VALID) { const int p = m - R_META0; ridx = p; nout = NB; oc = O_CKVP + (size_t)p * KVL; ok = O_KRP + (size_t)p * ROPE; }
    else { ridx = 0; nout = 0; oc = 0; ok = 0; }
    { float v[8]; float ss = 0.f;
      if (lane < 48) { const v4u w = *(const GAS v4u*)(z + ZCQ + 8 * lane); v[0] = bflo(w.x); v[1] = bfhi(w.x); v[2] = bflo(w.y); v[3] = bfhi(w.y); v[4] = bflo(w.z); v[5] = bfhi(w.z); v[6] = bflo(w.w); v[7] = bfhi(w.w); }
      else {
#pragma unroll
          for (int j = 0; j < 8; ++j) v[j] = 0.f; }
#pragma unroll
      for (int j = 0; j < 8; ++j) ss += v[j] * v[j];
      const float rs = 1.f / sqrtf(wave_sum(ss) * (1.f / QL) + NORM_EPS);
      if (lane < 48) { const f32x4 g0 = *(const GAS f32x4*)(F.q_norm_g + 8 * lane), g1 = *(const GAS f32x4*)(F.q_norm_g + 8 * lane + 4);
          v4u o; o.x = pk2(v[0] * rs * g0.x, v[1] * rs * g0.y); o.y = pk2(v[2] * rs * g0.z, v[3] * rs * g0.w); o.z = pk2(v[4] * rs * g1.x, v[5] * rs * g1.y); o.w = pk2(v[6] * rs * g1.z, v[7] * rs * g1.w);
          *(GAS v4u*)(F.CQN + (size_t)m * QL + 8 * lane) = o; } }
    { float v[8]; float ss = 0.f;
      if (lane < 32) { const v4u w = *(const GAS v4u*)(z + ZCKV + 8 * lane); v[0] = bflo(w.x); v[1] = bfhi(w.x); v[2] = bflo(w.y); v[3] = bfhi(w.y); v[4] = bflo(w.z); v[5] = bfhi(w.z); v[6] = bflo(w.w); v[7] = bfhi(w.w); }
      else {
#pragma unroll
          for (int j = 0; j < 8; ++j) v[j] = 0.f; }
#pragma unroll
      for (int j = 0; j < 8; ++j) ss += v[j] * v[j];
      const float rs = 1.f / sqrtf(wave_sum(ss) * (1.f / KVL) + NORM_EPS);
      if (lane < 32) { const f32x4 g0 = *(const GAS f32x4*)(F.kv_norm_g + 8 * lane), g1 = *(const GAS f32x4*)(F.kv_norm_g + 8 * lane + 4);
          const f32x4 y0 = (f32x4){v[0] * rs * g0.x, v[1] * rs * g0.y, v[2] * rs * g0.z, v[3] * rs * g0.w}, y1 = (f32x4){v[4] * rs * g1.x, v[5] * rs * g1.y, v[6] * rs * g1.z, v[7] * rs * g1.w};
          v4u o; o.x = pk2(y0.x, y0.y); o.y = pk2(y0.z, y0.w); o.z = pk2(y1.x, y1.y); o.w = pk2(y1.z, y1.w);
          *(GAS v4u*)(F.CKV + (size_t)m * KVL + 8 * lane) = o;
          for (int c = 0; c < nout; ++c) { float* dst = F.out + oc + (size_t)c * LTOT * KVL + 8 * lane; *(GAS f32x4*)dst = y0; *(GAS f32x4*)(dst + 4) = y1; } } }
    if (lane < 16) { const float x1 = bf2f(z[ZKR + lane]), x2 = bf2f(z[ZKR + 16 + lane]); const float c = F.ROPE_T[ridx * 32 + lane], s = F.ROPE_T[ridx * 32 + 16 + lane];
        const float y1 = x1 * c - x2 * s, y2 = x2 * c + x1 * s;
        F.KR[(size_t)m * ROPE + lane] = (bf16)f2bf(y1); F.KR[(size_t)m * ROPE + 16 + lane] = (bf16)f2bf(y2);
        for (int c2 = 0; c2 < nout; ++c2) { float* dst = F.out + ok + (size_t)c2 * LTOT * ROPE; dst[lane] = y1; dst[16 + lane] = y2; } }
}
constexpr int GL_ALR = 0, GL_GSUM = 4096, GL_BMID = 6144, GL_BLAST = 6400, GL_A0 = 8192;
constexpr int GL_S64 = 144, GL_S128 = 272;
constexpr int GL1_KDT = GL_A0, GL1_VT = GL1_KDT + 64 * GL_S64;
constexpr int GL3_QD = GL_A0, GL3_QM = GL3_QD + 64 * GL_S64, GL3_KM = GL3_QM + 64 * GL_S64, GL3_VT = GL3_KM + 64 * GL_S64, GL3_ST = GL3_VT + 128 * GL_S64, GL3_ATT = GL3_ST + 128 * GL_S64,
              GL3_OL = GL3_ATT + 64 * GL_S64, GL3_END = GL3_OL + 64 * 132 * 4;
static_assert(GL3_END <= RING_BYTES, "GLA LDS map");
__device__ __forceinline__ float logsigmoid_f(float x) { return fminf(x, 0.f) - log1pf(expf(-fabsf(x))); }
__device__ __forceinline__ void gla_decay(Frame& F, ldsp L, int row0, int nvalid, int h, int mid, float (&bv)[8]) {
    const int tid = F.tid, d = tid & 63, ig = tid >> 6;
    LAS float* ALR = (LAS float*)(L + GL_ALR); LAS float* GSUM = (LAS float*)(L + GL_GSUM); LAS float* BMID = (LAS float*)(L + GL_BMID); LAS float* BLAST = (LAS float*)(L + GL_BLAST);
    if (tid < 128) { const int i = tid >> 1, hf = tid & 1; v4u w = (v4u){0u, 0u, 0u, 0u};
        if (i < nvalid) w = *(const GAS v4u*)(F.Z + (size_t)(row0 + i) * ZC + ZA + 8 * hf);
        LAS float* a = ALR + i * 16 + 8 * hf; a[0] = bflo(w.x); a[1] = bfhi(w.x); a[2] = bflo(w.y); a[3] = bfhi(w.y); a[4] = bflo(w.z); a[5] = bfhi(w.z); a[6] = bflo(w.w); a[7] = bfhi(w.w); }
    float wg[16];
#pragma unroll
    for (int r = 0; r < 16; ++r) wg[r] = F.w_gate_up[r * 256 + h * 64 + d];
    const float bg = F.b_gate[h * 64 + d];
    __syncthreads();
    float run = 0.f;
#pragma unroll
    for (int ii = 0; ii < 8; ++ii) { const int i = 8 * ig + ii; float x = bg;
#pragma unroll
        for (int r = 0; r < 16; ++r) x += ALR[i * 16 + r] * wg[r];
        const float g = (i < nvalid) ? logsigmoid_f(x) * (1.f / 16.f) : 0.f; run += g; bv[ii] = run; }
    GSUM[ig * 64 + d] = run;
    __syncthreads();
    float pre = 0.f, tot = 0.f;
#pragma unroll
    for (int g2 = 0; g2 < 8; ++g2) { const float s = GSUM[g2 * 64 + d]; pre += (g2 < ig) ? s : 0.f; tot += s; }
#pragma unroll
    for (int ii = 0; ii < 8; ++ii) bv[ii] += pre;
    if (ig == (mid >> 3)) {
#pragma unroll
        for (int ii = 0; ii < 8; ++ii) if (ii == (mid & 7)) BMID[d] = bv[ii]; }
    if (ig == 0) BLAST[d] = tot;
    __syncthreads();
}
__device__ __forceinline__ void gla_stage_vt(Frame& F, ldsp VT, int row0, int nvalid, int h) {
    const int e = F.tid & 127, jg = F.tid >> 7; const bf16* src = F.Z + (size_t)row0 * ZC + ZV + h * 128 + e;
    unsigned short v[16];
#pragma unroll
    for (int jj = 0; jj < 16; ++jj) { const int j = 16 * jg + jj; v[jj] = (j < nvalid) ? src[(size_t)j * ZC] : (unsigned short)0; }
    v4u a, b; a.x = v[0] | ((unsigned)v[1] << 16); a.y = v[2] | ((unsigned)v[3] << 16); a.z = v[4] | ((unsigned)v[5] << 16); a.w = v[6] | ((unsigned)v[7] << 16);
    b.x = v[8] | ((unsigned)v[9] << 16); b.y = v[10] | ((unsigned)v[11] << 16); b.z = v[12] | ((unsigned)v[13] << 16); b.w = v[14] | ((unsigned)v[15] << 16);
    *(LAS v4u*)(VT + e * GL_S64 + 32 * jg) = a; *(LAS v4u*)(VT + e * GL_S64 + 32 * jg + 16) = b;
}
__device__ __forceinline__ void gla_pass1_unit(Frame& F, ldsp L, int unit) {
    const int tid = F.tid, lane = F.lane, wave = F.wave, d = tid & 63, ig = tid >> 6;
    int row0, nvalid, h, mid;
    if (unit < 2048) { const int bh = unit >> 5, c = unit & 31; row0 = (bh >> 2) * SEQ + 64 * c; h = bh & 3; nvalid = 64; mid = 32; } else { row0 = R_META0; h = unit - 2048; nvalid = NMETA; mid = 8; }
    float bv[8]; gla_decay(F, L, row0, nvalid, h, mid, bv);
    const float bl = ((LAS float*)(L + GL_BLAST))[d];
    { float kd[8];
#pragma unroll
      for (int ii = 0; ii < 8; ++ii) { const int i = 8 * ig + ii; const float k = (i < nvalid) ? bf2f(F.Z[(size_t)(row0 + i) * ZC + ZK + h * 64 + d]) : 0.f; kd[ii] = k * expf(bl - bv[ii]); }
      *(LAS bf16x8*)(L + GL1_KDT + d * GL_S64 + 16 * ig) = pack8(kd[0], kd[1], kd[2], kd[3], kd[4], kd[5], kd[6], kd[7]); }
    gla_stage_vt(F, L + GL1_VT, row0, nvalid, h);
    if (tid < 64) F.DEC[(size_t)unit * 64 + tid] = expf(bl);
    __syncthreads();
    f32x16 acc = {}; const int m0 = 32 * (wave >> 1), n0 = 32 * (wave & 1);
    lds_mma32(acc, L + GL1_VT, GL_S64, L + GL1_KDT, GL_S64, m0, n0, 64, lane);
    float* dst = F.KVC + (size_t)unit * 8192 + n0 + (lane & 31);
#pragma unroll
    for (int r = 0; r < 16; ++r) dst[(m0 + crow(r, lane >> 5)) * 64] = acc[r];
    __syncthreads();
}
__device__ __forceinline__ void gla_pass2(Frame& F) {
    for (int it = F.bid * NTHR + F.tid; it < 64 * 2048; it += F.G * NTHR) {
        const int bh = it >> 11, q = it & 2047, e = q >> 4, d0 = (q & 15) * 4, h = bh & 3, b = bh >> 2;
        f32x4 S = *(const GAS f32x4*)(F.KVC + (size_t)(2048 + h) * 8192 + e * 64 + d0);
        for (int c = 0; c < 32; ++c) { const size_t u = (size_t)bh * 32 + c;
            const f32x4 kv = *(const GAS f32x4*)(F.KVC + u * 8192 + e * 64 + d0), dc = *(const GAS f32x4*)(F.DEC + u * 64 + d0);
            u32x2 w; w.x = pk2(S.x, S.y); w.y = pk2(S.z, S.w); *(GAS u32x2*)(F.ST + u * 8192 + e * 64 + d0) = w;
            S = dc * S + kv; }
        float* o = F.out + O_GLAP + ((size_t)(b * 4 + h) * 64 + d0) * 128 + e; o[0] = S.x; o[128] = S.y; o[256] = S.z; o[384] = S.w;
    }
}
__device__ __forceinline__ void gla_norm_gate_store(Frame& F, const LAS float* OL, int row0, int nvalid, int h) {
    const int i = F.tid >> 3, seg = F.tid & 7; const LAS float* o = OL + i * 132 + 16 * seg;
    float v[16]; float ss = 0.f;
#pragma unroll
    for (int j = 0; j < 16; ++j) { v[j] = o[j]; ss += v[j] * v[j]; }
    ss += __shfl_xor(ss, 1); ss += __shfl_xor(ss, 2); ss += __shfl_xor(ss, 4);
    const float rs = 1.f / sqrtf(ss * (1.f / 128.f) + NORM_EPS);
    if (i < nvalid) { const size_t row = (size_t)(row0 + i);
        const v4u g0 = *(const GAS v4u*)(F.Z + row * ZC + ZG + h * 128 + 16 * seg), g1 = *(const GAS v4u*)(F.Z + row * ZC + ZG + h * 128 + 16 * seg + 8);
        float gt[16]; gt[0] = bflo(g0.x); gt[1] = bfhi(g0.x); gt[2] = bflo(g0.y); gt[3] = bfhi(g0.y); gt[4] = bflo(g0.z); gt[5] = bfhi(g0.z); gt[6] = bflo(g0.w); gt[7] = bfhi(g0.w);
        gt[8] = bflo(g1.x); gt[9] = bfhi(g1.x); gt[10] = bflo(g1.y); gt[11] = bfhi(g1.y); gt[12] = bflo(g1.z); gt[13] = bfhi(g1.z); gt[14] = bflo(g1.w); gt[15] = bfhi(g1.w);
        float y[16];
#pragma unroll
        for (int j = 0; j < 16; ++j) { const float x = gt[j]; y[j] = v[j] * rs * F.gla_norm_g[16 * seg + j] * (x / (1.f + expf(-x))); }
        v4u a, b2; a.x = pk2(y[0], y[1]); a.y = pk2(y[2], y[3]); a.z = pk2(y[4], y[5]); a.w = pk2(y[6], y[7]); b2.x = pk2(y[8], y[9]); b2.y = pk2(y[10], y[11]); b2.z = pk2(y[12], y[13]); b2.w = pk2(y[14], y[15]);
        *(GAS v4u*)(F.AO + row * DM + h * 128 + 16 * seg) = a; *(GAS v4u*)(F.AO + row * DM + h * 128 + 16 * seg + 8) = b2; }
}
__device__ __forceinline__ void gla_pass3_unit(Frame& F, ldsp L, int unit) {
    const int tid = F.tid, lane = F.lane, wave = F.wave, d = tid & 63, ig = tid >> 6;
    int row0, nvalid, h, mid; bool has_state;
    if (unit < 2048) { const int bh = unit >> 5, c = unit & 31; row0 = (bh >> 2) * SEQ + 64 * c; h = bh & 3; nvalid = 64; mid = 32; has_state = true; } else { row0 = R_META0; h = unit - 2048; nvalid = NMETA; mid = 8; has_state = false; }
    float bv[8]; gla_decay(F, L, row0, nvalid, h, mid, bv);
    const float bm = ((LAS float*)(L + GL_BMID))[d];
#pragma unroll
    for (int ii = 0; ii < 8; ++ii) { const int i = 8 * ig + ii; float q = 0.f, k = 0.f;
        if (i < nvalid) { q = bf2f(F.Z[(size_t)(row0 + i) * ZC + ZQ + h * 64 + d]) * 0.125f; k = bf2f(F.Z[(size_t)(row0 + i) * ZC + ZK + h * 64 + d]); }
        *(LAS unsigned short*)(L + GL3_QD + i * GL_S64 + 2 * d) = (unsigned short)f2bf(q * expf(bv[ii]));
        *(LAS unsigned short*)(L + GL3_QM + i * GL_S64 + 2 * d) = (unsigned short)f2bf(q * expf(bv[ii] - bm));
        *(LAS unsigned short*)(L + GL3_KM + i * GL_S64 + 2 * d) = (unsigned short)f2bf(k * expf(bm - bv[ii])); }
    gla_stage_vt(F, L + GL3_VT, row0, nvalid, h);
    if (has_state) { const bf16* st = F.ST + (size_t)unit * 8192;
#pragma unroll
        for (int k2 = 0; k2 < 2; ++k2) { const int ch = tid + 512 * k2, e = ch >> 3, c8 = ch & 7; *(LAS v4u*)(L + GL3_ST + e * GL_S64 + 16 * c8) = *(const GAS v4u*)(st + e * 64 + 8 * c8); } }
    __syncthreads();
    if (wave < 4) { f32x16 at = {}; const int m0 = 32 * (wave >> 1), n0 = 32 * (wave & 1);
        lds_mma32(at, L + GL3_QM, GL_S64, L + GL3_KM, GL_S64, m0, n0, 64, lane);
        const int j = n0 + (lane & 31);
#pragma unroll
        for (int r = 0; r < 16; ++r) { const int i = m0 + crow(r, lane >> 5); *(LAS unsigned short*)(L + GL3_ATT + i * GL_S64 + 2 * j) = (unsigned short)f2bf(j <= i ? at[r] : 0.f); } }
    f32x16 acc = {}; const int m0 = 32 * (wave >> 2), n0 = 32 * (wave & 3);
    if (has_state) lds_mma32(acc, L + GL3_QD, GL_S64, L + GL3_ST, GL_S64, m0, n0, 64, lane);
    __syncthreads();
    lds_mma32(acc, L + GL3_ATT, GL_S64, L + GL3_VT, GL_S64, m0, n0, 64, lane);
    { LAS float* OL = (LAS float*)(L + GL3_OL);
#pragma unroll
      for (int r = 0; r < 16; ++r) OL[(m0 + crow(r, lane >> 5)) * 132 + n0 + (lane & 31)] = acc[r]; }
    __syncthreads();
    gla_norm_gate_store(F, (const LAS float*)(L + GL3_OL), row0, nvalid, h);
    __syncthreads();
}
constexpr int GS_G = 0, GS_QD = 1024, GS_KD = 2048, GS_DEC = 3072, GS_ATT = 3328, GS_V = 3584, GS_Q = 5632, GS_K = 6656, GS_PART = 8192, GS_OL = 16384;
__device__ __forceinline__ void gla_sample_unit(Frame& F, ldsp L, int unit) {
    const int tid = F.tid, sb = unit >> 2, h = unit & 3, row0 = R_SAMPLE0 + 4 * sb;
    LAS float* G4 = (LAS float*)(L + GS_G); LAS float* QD = (LAS float*)(L + GS_QD); LAS float* KD = (LAS float*)(L + GS_KD); LAS float* DEC = (LAS float*)(L + GS_DEC); LAS float* ATT = (LAS float*)(L + GS_ATT);
    LAS float* V4 = (LAS float*)(L + GS_V); LAS float* Q4 = (LAS float*)(L + GS_Q); LAS float* K4 = (LAS float*)(L + GS_K); LAS float* PART = (LAS float*)(L + GS_PART); LAS float* OL = (LAS float*)(L + GS_OL);
    const int e = tid & 127, dg = tid >> 7;
    float S[16];
    { const float* sp = F.state_gla + ((size_t)(sb * 4 + h) * 64 + 16 * dg) * 128 + e;
#pragma unroll
      for (int dd = 0; dd < 16; ++dd) S[dd] = sp[dd * 128]; }
    if (tid < 256) { const int t = tid >> 6, d = tid & 63; const bf16* z = F.Z + (size_t)(row0 + t) * ZC; float x = F.b_gate[h * 64 + d];
#pragma unroll
        for (int r = 0; r < 16; ++r) x += bf2f(z[ZA + r]) * F.w_gate_up[r * 256 + h * 64 + d];
        G4[t * 64 + d] = logsigmoid_f(x) * (1.f / 16.f); Q4[t * 64 + d] = bf2f(z[ZQ + h * 64 + d]) * 0.125f; K4[t * 64 + d] = bf2f(z[ZK + h * 64 + d]); }
    { const int t = tid >> 7; V4[t * 128 + e] = bf2f(F.Z[(size_t)(row0 + t) * ZC + ZV + h * 128 + e]); }
    __syncthreads();
    if (tid < 64) { const int d = tid; float b[4]; float run = 0.f;
#pragma unroll
        for (int t = 0; t < 4; ++t) { run += G4[t * 64 + d]; b[t] = run; }
        const float bm = b[2], bl = b[3];
#pragma unroll
        for (int t = 0; t < 4; ++t) { const float q = Q4[t * 64 + d], k = K4[t * 64 + d]; QD[t * 64 + d] = q * expf(b[t]); KD[t * 64 + d] = k * expf(bl - b[t]); Q4[t * 64 + d] = q * expf(b[t] - bm); K4[t * 64 + d] = k * expf(bm - b[t]); }
        DEC[d] = expf(bl); }
    __syncthreads();
    if (tid < 16) { const int t = tid >> 2, j = tid & 3; float a = 0.f;
        for (int d = 0; d < 64; ++d) a += Q4[t * 64 + d] * K4[j * 64 + d];
        ATT[tid] = (j <= t) ? a : 0.f; }
    float po[4] = {0.f, 0.f, 0.f, 0.f};
#pragma unroll
    for (int dd = 0; dd < 16; ++dd) { const int d = 16 * dg + dd;
#pragma unroll
        for (int t = 0; t < 4; ++t) po[t] += QD[t * 64 + d] * S[dd]; }
#pragma unroll
    for (int t = 0; t < 4; ++t) PART[(dg * 4 + t) * 128 + e] = po[t];
    { float* op = F.out + O_GLAS + ((size_t)(sb * 4 + h) * 64 + 16 * dg) * 128 + e;
#pragma unroll
      for (int dd = 0; dd < 16; ++dd) { const int d = 16 * dg + dd; float s = S[dd] * DEC[d];
#pragma unroll
          for (int j = 0; j < 4; ++j) s += KD[j * 64 + d] * V4[j * 128 + e];
          op[dd * 128] = s; } }
    __syncthreads();
    { const int t = tid >> 7; float o = PART[(0 * 4 + t) * 128 + e] + PART[(1 * 4 + t) * 128 + e] + PART[(2 * 4 + t) * 128 + e] + PART[(3 * 4 + t) * 128 + e];
#pragma unroll
      for (int j = 0; j < 4; ++j) o += ATT[t * 4 + j] * V4[j * 128 + e];
      OL[t * 132 + e] = o; }
    __syncthreads();
    gla_norm_gate_store(F, OL, row0, 4, h);
    __syncthreads();
}
constexpr int AT_KS = 208, AT_VS = 192;
constexpr int AT_K0 = 0, AT_KB = 64 * AT_KS, AT_V0 = 2 * AT_KB, AT_VB = 64 * AT_VS, AT_F = AT_V0 + 2 * AT_VB, AT_END = AT_F + 8 * 128;
static_assert(AT_END <= RING_BYTES, "attention LDS map");
__device__ __forceinline__ void attn_prompt_unit(Frame& F, ldsp L, int qrow0, int kvrow0, int qb, int h) {
    const int tid = F.tid, lane = F.lane, wave = F.wave, r32 = lane & 31, hi = lane >> 5;
    const bool metau = qb < 0; const int NT = metau ? 1 : 4 * qb + 5;
    const int qi = (metau ? 0 : 256 * qb) + 32 * wave + r32;
    const int ridx = metau ? qi : NMETA + qi;
    bf16x8 qf[6];
    { const bf16* qp = F.Q + (size_t)(qrow0 + 32 * wave + r32) * QW + 96 * h + 8 * hi; v4u raw[6];
#pragma unroll
      for (int s = 0; s < 6; ++s) raw[s] = *(const GAS v4u*)(qp + 16 * s);
#pragma unroll
      for (int s = 0; s < 4; ++s) qf[s] = pack8(bflo(raw[s].x) * ATT_SC, bfhi(raw[s].x) * ATT_SC, bflo(raw[s].y) * ATT_SC, bfhi(raw[s].y) * ATT_SC, bflo(raw[s].z) * ATT_SC, bfhi(raw[s].z) * ATT_SC, bflo(raw[s].w) * ATT_SC, bfhi(raw[s].w) * ATT_SC);
      const float* rt_ = F.ROPE_T + ridx * 32 + 8 * hi; const f32x4 c0 = *(const GAS f32x4*)rt_, c1 = *(const GAS f32x4*)(rt_ + 4), s0 = *(const GAS f32x4*)(rt_ + 16), s1 = *(const GAS f32x4*)(rt_ + 20);
      float x1[8], x2[8], cs[8], sn[8], y1[8], y2[8];
      x1[0] = bflo(raw[4].x); x1[1] = bfhi(raw[4].x); x1[2] = bflo(raw[4].y); x1[3] = bfhi(raw[4].y); x1[4] = bflo(raw[4].z); x1[5] = bfhi(raw[4].z); x1[6] = bflo(raw[4].w); x1[7] = bfhi(raw[4].w);
      x2[0] = bflo(raw[5].x); x2[1] = bfhi(raw[5].x); x2[2] = bflo(raw[5].y); x2[3] = bfhi(raw[5].y); x2[4] = bflo(raw[5].z); x2[5] = bfhi(raw[5].z); x2[6] = bflo(raw[5].w); x2[7] = bfhi(raw[5].w);
      cs[0] = c0.x; cs[1] = c0.y; cs[2] = c0.z; cs[3] = c0.w; cs[4] = c1.x; cs[5] = c1.y; cs[6] = c1.z; cs[7] = c1.w; sn[0] = s0.x; sn[1] = s0.y; sn[2] = s0.z; sn[3] = s0.w; sn[4] = s1.x; sn[5] = s1.y; sn[6] = s1.z; sn[7] = s1.w;
#pragma unroll
      for (int j = 0; j < 8; ++j) { y1[j] = (x1[j] * cs[j] - x2[j] * sn[j]) * ATT_SC; y2[j] = (x2[j] * cs[j] + x1[j] * sn[j]) * ATT_SC; }
      qf[4] = pack8(y1[0], y1[1], y1[2], y1[3], y1[4], y1[5], y1[6], y1[7]); qf[5] = pack8(y2[0], y2[1], y2[2], y2[3], y2[4], y2[5], y2[6], y2[7]); }
    const int srow = tid >> 3, sch = tid & 7, rrow = tid >> 2, rch = tid & 3;
    v4u kn, vv, kr = (v4u){0u, 0u, 0u, 0u};
#define AT_LOAD(t) do { const size_t rb_ = (size_t)((t) == 0 ? R_META0 : kvrow0 + 64 * ((t) - 1)); \
        kn = *(const GAS v4u*)(F.KV + (rb_ + srow) * 1024 + 64 * h + 8 * sch); vv = *(const GAS v4u*)(F.KV + (rb_ + srow) * 1024 + 512 + 64 * h + 8 * sch); \
        if (tid < 256) kr = *(const GAS v4u*)(F.KR + (rb_ + rrow) * ROPE + 8 * rch); } while (0)
#define AT_STORE(buf) do { *(LAS v4u*)(L + AT_K0 + (buf) * AT_KB + srow * AT_KS + 16 * sch) = kn; *(LAS v4u*)(L + AT_V0 + (buf) * AT_VB + srow * AT_VS + 16 * sch) = vv; \
        if (tid < 256) *(LAS v4u*)(L + AT_K0 + (buf) * AT_KB + rrow * AT_KS + 128 + 16 * rch) = kr; } while (0)
    LAS float* FS = (LAS float*)(L + AT_F + wave * 128);
    float m = -INFINITY, l = 0.f; f32x16 o0 = {}, o1 = {};
    const int qq = (lane & 15) >> 2, pp = lane & 3, blk = (lane >> 4) & 1;
    const int vlane = (4 * hi + qq) * AT_VS + (16 * blk + 4 * pp) * 2;
    AT_LOAD(0); AT_STORE(0); __syncthreads();
    for (int t = 0; t < NT; ++t) {
        const int buf = t & 1; if (t + 1 < NT) AT_LOAD(t + 1);
        const LAS unsigned char* Kb = L + AT_K0 + buf * AT_KB + r32 * AT_KS + 16 * hi; const LAS unsigned char* Vb = L + AT_V0 + buf * AT_VB + vlane;
        f32x16 p0 = {}, p1 = {};
#pragma unroll
        for (int s = 0; s < 6; ++s) { p0 = __builtin_amdgcn_mfma_f32_32x32x16_bf16(*(const LAS bf16x8*)(Kb + 32 * s), qf[s], p0, 0, 0, 0);
                                      p1 = __builtin_amdgcn_mfma_f32_32x32x16_bf16(*(const LAS bf16x8*)(Kb + 32 * AT_KS + 32 * s), qf[s], p1, 0, 0, 0); }
        if (t == 0) {
#pragma unroll
            for (int r = 0; r < 16; ++r) { const int key = crow(r, hi); if (key >= NMETA || (metau && key > qi)) p0[r] = -INFINITY; p1[r] = -INFINITY; }
        } else if (t >= NT - 4) { const int kb0 = 64 * (t - 1);
#pragma unroll
            for (int r = 0; r < 16; ++r) { const int key = kb0 + crow(r, hi); if (key > qi) p0[r] = -INFINITY; if (key + 32 > qi) p1[r] = -INFINITY; }
        }
        float mx = fmaxf(p0[0], p1[0]);
#pragma unroll
        for (int r = 1; r < 16; ++r) mx = fmaxf(mx, fmaxf(p0[r], p1[r]));
        mx = fmaxf(mx, __shfl_xor(mx, 32));
        const float mn = fmaxf(m, mx), alpha = __builtin_amdgcn_exp2f(m - mn); m = mn;
        float ps = 0.f;
#pragma unroll
        for (int r = 0; r < 16; ++r) { p0[r] = __builtin_amdgcn_exp2f(p0[r] - mn); p1[r] = __builtin_amdgcn_exp2f(p1[r] - mn); ps += p0[r] + p1[r]; }
        l = l * alpha + ps;
        if (__any(alpha != 1.f)) { if (hi == 0) FS[r32] = alpha;
#pragma unroll
            for (int g = 0; g < 4; ++g) { const f32x4 f = *(const LAS f32x4*)(FS + 8 * g + 4 * hi);
#pragma unroll
                for (int j = 0; j < 4; ++j) { o0[4 * g + j] *= f[j]; o1[4 * g + j] *= f[j]; } } }
        const bf16x8 pa00 = pack8(p0[0], p0[1], p0[2], p0[3], p0[4], p0[5], p0[6], p0[7]), pa01 = pack8(p0[8], p0[9], p0[10], p0[11], p0[12], p0[13], p0[14], p0[15]);
        const bf16x8 pa10 = pack8(p1[0], p1[1], p1[2], p1[3], p1[4], p1[5], p1[6], p1[7]), pa11 = pack8(p1[8], p1[9], p1[10], p1[11], p1[12], p1[13], p1[14], p1[15]);
#define AT_VF(kb, s, c) cat4(tr_read(Vb + (32 * (kb) + 16 * (s)) * AT_VS + 64 * (c)), tr_read(Vb + (32 * (kb) + 16 * (s) + 8) * AT_VS + 64 * (c)))
        o0 = __builtin_amdgcn_mfma_f32_32x32x16_bf16(pa00, AT_VF(0, 0, 0), o0, 0, 0, 0); o1 = __builtin_amdgcn_mfma_f32_32x32x16_bf16(pa00, AT_VF(0, 0, 1), o1, 0, 0, 0);
        o0 = __builtin_amdgcn_mfma_f32_32x32x16_bf16(pa01, AT_VF(0, 1, 0), o0, 0, 0, 0); o1 = __builtin_amdgcn_mfma_f32_32x32x16_bf16(pa01, AT_VF(0, 1, 1), o1, 0, 0, 0);
        o0 = __builtin_amdgcn_mfma_f32_32x32x16_bf16(pa10, AT_VF(1, 0, 0), o0, 0, 0, 0); o1 = __builtin_amdgcn_mfma_f32_32x32x16_bf16(pa10, AT_VF(1, 0, 1), o1, 0, 0, 0);
        o0 = __builtin_amdgcn_mfma_f32_32x32x16_bf16(pa11, AT_VF(1, 1, 0), o0, 0, 0, 0); o1 = __builtin_amdgcn_mfma_f32_32x32x16_bf16(pa11, AT_VF(1, 1, 1), o1, 0, 0, 0);
#undef AT_VF
        if (t + 1 < NT) AT_STORE(buf ^ 1);
        __syncthreads();
    }
#undef AT_LOAD
#undef AT_STORE
    { const float lt = l + __shfl_xor(l, 32); if (hi == 0) FS[r32] = 1.f / lt;
      bf16* op = F.AO + (size_t)(qrow0 + 32 * wave) * DM + 512 + 64 * h + r32;
#pragma unroll
      for (int g = 0; g < 4; ++g) { const f32x4 f = *(const LAS f32x4*)(FS + 8 * g + 4 * hi);
#pragma unroll
          for (int j = 0; j < 4; ++j) { const int row = 8 * g + 4 * hi + j; op[(size_t)row * DM] = (bf16)f2bf(o0[4 * g + j] * f[j]); op[(size_t)row * DM + 32] = (bf16)f2bf(o1[4 * g + j] * f[j]); } } }
    __syncthreads();
}

constexpr int DC_QS = 592, DC_Q = 0, DC_IMG = 19456, DC_IMGB = 2 * 16384 + 64 * 80, DC_QN = DC_IMG + 2 * DC_IMGB, DC_F = DC_QN + 8192, DC_END = DC_F + 8 * 128;
constexpr int DC_OL = DC_IMG, DC_XO = DC_IMG + DC_IMGB, DC_XM = DC_XO + 32768;
static_assert(DC_END <= RING_BYTES && 32 * 260 * 4 <= DC_IMGB && 32768 + 4 * 2 * 32 * 4 <= DC_IMGB, "decode LDS map");
__device__ __forceinline__ int dc_off(int row, int ch) { return 256 * row + 16 * (ch ^ (((row & 3) << 2) | ((row >> 2) & 3))); }
__device__ __forceinline__ bf16x8 cvt8(f32x4 a, f32x4 b) { return pack8(a.x, a.y, a.z, a.w, b.x, b.y, b.z, b.w); }
__device__ __forceinline__ void dc_tile(const LAS unsigned char* Ib, const LAS unsigned char* Qb, LAS float* FS, int lane, int kb, int cg, bool newt, float& m, float& l, f32x16& o0, f32x16& o1) {
    const int r32 = lane & 31, hi = lane >> 5, krow = 32 * kb + r32;
    f32x16 p = {};
#pragma unroll
    for (int s = 0; s < 16; ++s) p = __builtin_amdgcn_mfma_f32_32x32x16_bf16(*(const LAS bf16x8*)(Ib + (s >> 3) * 16384 + dc_off(krow, 2 * (s & 7) + hi)), *(const LAS bf16x8*)(Qb + 32 * s), p, 0, 0, 0);
#pragma unroll
    for (int s = 16; s < 18; ++s) p = __builtin_amdgcn_mfma_f32_32x32x16_bf16(*(const LAS bf16x8*)(Ib + 32768 + krow * 80 + (2 * (s - 16) + hi) * 16), *(const LAS bf16x8*)(Qb + 32 * s), p, 0, 0, 0);
    if (newt) { const int tq = r32 >> 3;
#pragma unroll
        for (int r = 0; r < 16; ++r) { const int key = 32 * kb + crow(r, hi); if (key >= DS || key > tq) p[r] = -INFINITY; } }
    float mx = p[0];
#pragma unroll
    for (int r = 1; r < 16; ++r) mx = fmaxf(mx, p[r]);
    mx = fmaxf(mx, __shfl_xor(mx, 32));
    const float mn = fmaxf(m, mx), alpha = __builtin_amdgcn_exp2f(m - mn); m = mn;
    float ps = 0.f;
#pragma unroll
    for (int r = 0; r < 16; ++r) { p[r] = __builtin_amdgcn_exp2f(p[r] - mn); ps += p[r]; }
    l = l * alpha + ps;
    if (__any(alpha != 1.f)) { if (hi == 0) FS[r32] = alpha;
#pragma unroll
        for (int g = 0; g < 4; ++g) { const f32x4 f = *(const LAS f32x4*)(FS + 8 * g + 4 * hi);
#pragma unroll
            for (int j = 0; j < 4; ++j) { o0[4 * g + j] *= f[j]; o1[4 * g + j] *= f[j]; } } }
    const bf16x8 pa0 = pack8(p[0], p[1], p[2], p[3], p[4], p[5], p[6], p[7]), pa1 = pack8(p[8], p[9], p[10], p[11], p[12], p[13], p[14], p[15]);
    const int qq = (lane & 15) >> 2, pp = lane & 3, blk = (lane >> 4) & 1;
#define DC_VADDR(s, tt, cc) (Ib + ((2 * cg + (cc)) >> 2) * 16384 + dc_off(32 * kb + 16 * (s) + 8 * (tt) + 4 * hi + qq, 4 * ((2 * cg + (cc)) & 3) + 2 * blk + (pp >> 1)) + 8 * (pp & 1))
#define DC_VF(s, cc) cat4(tr_read(DC_VADDR(s, 0, cc)), tr_read(DC_VADDR(s, 1, cc)))
    o0 = __builtin_amdgcn_mfma_f32_32x32x16_bf16(pa0, DC_VF(0, 0), o0, 0, 0, 0); o1 = __builtin_amdgcn_mfma_f32_32x32x16_bf16(pa0, DC_VF(0, 1), o1, 0, 0, 0);
    o0 = __builtin_amdgcn_mfma_f32_32x32x16_bf16(pa1, DC_VF(1, 0), o0, 0, 0, 0); o1 = __builtin_amdgcn_mfma_f32_32x32x16_bf16(pa1, DC_VF(1, 1), o1, 0, 0, 0);
#undef DC_VF
#undef DC_VADDR
}
__device__ __forceinline__ void attn_decode_unit(Frame& F, ldsp L, int sb) {
    const int tid = F.tid, lane = F.lane, wave = F.wave, r32 = lane & 31, hi = lane >> 5, kb = wave & 1, cg = wave >> 1;
    const int row0 = R_SAMPLE0 + 4 * sb;
    { LAS float* QN = (LAS float*)(L + DC_QN);
#pragma unroll
      for (int k = 0; k < 4; ++k) { const int i = tid + 512 * k, t = i >> 9, hh = (i >> 6) & 7, n = i & 63; QN[i] = bf2f(F.Q[(size_t)(row0 + t) * QW + 96 * hh + n]); }
      { const int t = tid >> 7, hh = (tid >> 4) & 7, i = tid & 15; const bf16* qp = F.Q + (size_t)(row0 + t) * QW + 96 * hh + 64;
        const float x1 = bf2f(qp[i]), x2 = bf2f(qp[16 + i]), c = F.ROPE_T[(LTOT + t) * 32 + i], s = F.ROPE_T[(LTOT + t) * 32 + 16 + i];
        LAS unsigned short* qd = (LAS unsigned short*)(L + DC_Q + (t * 8 + hh) * DC_QS + 512);
        qd[i] = (unsigned short)f2bf((x1 * c - x2 * s) * ATT_SC); qd[16 + i] = (unsigned short)f2bf((x2 * c + x1 * s) * ATT_SC); }
      __syncthreads();
      const int c = tid & 255, hg = tid >> 8;
#pragma unroll 1
      for (int h4 = 0; h4 < 4; ++h4) { const int hh = 4 * hg + h4; float a0 = 0.f, a1 = 0.f, a2 = 0.f, a3 = 0.f; const bf16* wp = F.Wkv_t + (size_t)(64 * hh) * 256 + c;
#pragma unroll 16
          for (int n = 0; n < 64; ++n) { const float w = bf2f(wp[(size_t)n * 256]); a0 += QN[(0 * 8 + hh) * 64 + n] * w; a1 += QN[(1 * 8 + hh) * 64 + n] * w; a2 += QN[(2 * 8 + hh) * 64 + n] * w; a3 += QN[(3 * 8 + hh) * 64 + n] * w; }
          *(LAS unsigned short*)(L + DC_Q + (0 * 8 + hh) * DC_QS + 2 * c) = (unsigned short)f2bf(a0 * ATT_SC); *(LAS unsigned short*)(L + DC_Q + (1 * 8 + hh) * DC_QS + 2 * c) = (unsigned short)f2bf(a1 * ATT_SC);
          *(LAS unsigned short*)(L + DC_Q + (2 * 8 + hh) * DC_QS + 2 * c) = (unsigned short)f2bf(a2 * ATT_SC); *(LAS unsigned short*)(L + DC_Q + (3 * 8 + hh) * DC_QS + 2 * c) = (unsigned short)f2bf(a3 * ATT_SC); }
      __syncthreads(); }
    const LAS unsigned char* Qb = L + DC_Q + r32 * DC_QS + 16 * hi;
    LAS float* FS = (LAS float*)(L + DC_F + wave * 128);
    float m = -INFINITY, l = 0.f; f32x16 o0 = {}, o1 = {};
    f32x4 ck[8], ckr[2];
    const int* pt = F.page_table + sb * NPAGES;
#define DC_LOAD(tile) do { const int pg_ = pt[(tile) >> 1]; const float* sc_ = F.cache_ckv + ((size_t)pg_ * PAGE + 64 * ((tile) & 1)) * KVL; const float* sr_ = F.cache_krope + ((size_t)pg_ * PAGE + 64 * ((tile) & 1)) * ROPE; \
        _Pragma("unroll") for (int i_ = 0; i_ < 4; ++i_) { const int ix_ = tid + 512 * i_; const float* p_ = sc_ + (size_t)(ix_ >> 5) * KVL + 8 * (ix_ & 31); ck[2 * i_] = *(const GAS f32x4*)p_; ck[2 * i_ + 1] = *(const GAS f32x4*)(p_ + 4); } \
        if (tid < 256) { const float* p_ = sr_ + (size_t)(tid >> 2) * ROPE + 8 * (tid & 3); ckr[0] = *(const GAS f32x4*)p_; ckr[1] = *(const GAS f32x4*)(p_ + 4); } } while (0)
#define DC_STORE(buf) do { ldsp ib_ = L + DC_IMG + (buf) * DC_IMGB; \
        _Pragma("unroll") for (int i_ = 0; i_ < 4; ++i_) { const int ix_ = tid + 512 * i_, row_ = ix_ >> 5, ch_ = ix_ & 31; *(LAS bf16x8*)(ib_ + (ch_ >> 4) * 16384 + dc_off(row_, ch_ & 15)) = cvt8(ck[2 * i_], ck[2 * i_ + 1]); } \
        if (tid < 256) *(LAS bf16x8*)(ib_ + 32768 + (tid >> 2) * 80 + 16 * (tid & 3)) = cvt8(ckr[0], ckr[1]); } while (0)
    DC_LOAD(0); DC_STORE(0); __syncthreads();
    constexpr int NTILE = 2 * NPAGES;
    for (int t = 0; t < NTILE; ++t) {
        const int buf = t & 1;
        if (t + 1 < NTILE) DC_LOAD(t + 1);
        dc_tile(L + DC_IMG + buf * DC_IMGB, Qb, FS, lane, kb, cg, false, m, l, o0, o1);
        if (t + 1 < NTILE) DC_STORE(buf ^ 1);
        else {
            ldsp ib = L + DC_IMG + (buf ^ 1) * DC_IMGB;
#pragma unroll
            for (int i = 0; i < 4; ++i) { const int ix = tid + 512 * i, row = ix >> 5, ch = ix & 31; v4u w = (v4u){0u, 0u, 0u, 0u}; if (row < DS) w = *(const GAS v4u*)(F.CKV + (size_t)(row0 + row) * KVL + 8 * ch);
                *(LAS v4u*)(ib + (ch >> 4) * 16384 + dc_off(row, ch & 15)) = w; }
            if (tid < 256) { const int row = tid >> 2; v4u w = (v4u){0u, 0u, 0u, 0u}; if (row < DS) w = *(const GAS v4u*)(F.KR + (size_t)(row0 + row) * ROPE + 8 * (tid & 3)); *(LAS v4u*)(ib + 32768 + row * 80 + 16 * (tid & 3)) = w; }
        }
        __syncthreads();
    }
#undef DC_LOAD
#undef DC_STORE
    dc_tile(L + DC_IMG + (NTILE & 1) * DC_IMGB, Qb, FS, lane, kb, cg, true, m, l, o0, o1);
    __syncthreads();
    const float lt = l + __shfl_xor(l, 32);
    { LAS float* XO = (LAS float*)(L + DC_XO) + cg * 2048; LAS float* XM = (LAS float*)(L + DC_XM) + cg * 64;
      if (kb == 1) {
#pragma unroll
          for (int r = 0; r < 16; ++r) { XO[r * 64 + lane] = o0[r]; XO[(16 + r) * 64 + lane] = o1[r]; }
          if (hi == 0) { XM[r32] = m; XM[32 + r32] = lt; } }
      __syncthreads();
      if (kb == 0) { const float m1 = XM[r32], l1 = XM[32 + r32], M = fmaxf(m, m1), a0 = __builtin_amdgcn_exp2f(m - M), a1 = __builtin_amdgcn_exp2f(m1 - M), inv = 1.f / (lt * a0 + l1 * a1);
          if (hi == 0) { FS[r32] = a0 * inv; FS[32 + r32] = a1 * inv; }
          LAS float* OL = (LAS float*)(L + DC_OL);
#pragma unroll
          for (int g = 0; g < 4; ++g) { const f32x4 f0 = *(const LAS f32x4*)(FS + 8 * g + 4 * hi), f1 = *(const LAS f32x4*)(FS + 32 + 8 * g + 4 * hi);
#pragma unroll
              for (int j = 0; j < 4; ++j) { const int r = 4 * g + j, q = 8 * g + 4 * hi + j;
                  OL[q * 260 + 64 * cg + r32] = o0[r] * f0[j] + XO[r * 64 + lane] * f1[j]; OL[q * 260 + 64 * cg + 32 + r32] = o1[r] * f0[j] + XO[(16 + r) * 64 + lane] * f1[j]; } } }
      __syncthreads(); }
    { const int t = tid >> 7, hh = (tid >> 4) & 7, v0 = 4 * (tid & 15); const LAS float* ol = (const LAS float*)(L + DC_OL) + (t * 8 + hh) * 260; const float* wp = F.w_uv + 64 * hh + v0;
      f32x4 a = (f32x4){0.f, 0.f, 0.f, 0.f};
#pragma unroll 8
      for (int c = 0; c < KVL; ++c) a += *(const GAS f32x4*)(wp + (size_t)c * 512) * ol[c];
      u32x2 w; w.x = pk2(a.x, a.y); w.y = pk2(a.z, a.w); *(GAS u32x2*)(F.AO + (size_t)(row0 + t) * DM + 512 + 64 * hh + v0) = w; }
    __syncthreads();
}
__device__ __forceinline__ void ln_row_f32(const float* xrow, const float* g, const float* b, float* orow, int lane) {
    const GAS f32x4* xr = (const GAS f32x4*)xrow + lane;
    f32x4 v[4]; float s = 0.f;
#pragma unroll
    for (int j = 0; j < 4; ++j) { v[j] = xr[64 * j]; s += (v[j].x + v[j].y) + (v[j].z + v[j].w); }
    const float mean = wave_sum(s) * (1.f / DM); float s2 = 0.f;
#pragma unroll
    for (int j = 0; j < 4; ++j) { v[j] = v[j] - mean; s2 += (v[j].x * v[j].x + v[j].y * v[j].y) + (v[j].z * v[j].z + v[j].w * v[j].w); }
    const float rstd = 1.f / sqrtf(wave_sum(s2) * (1.f / DM) + NORM_EPS);
#pragma unroll
    for (int j = 0; j < 4; ++j) { const f32x4 gg = *((const GAS f32x4*)g + lane + 64 * j), bb = *((const GAS f32x4*)b + lane + 64 * j); *((GAS f32x4*)orow + lane + 64 * j) = v[j] * rstd * gg + bb; }
}
__device__ __forceinline__ void halo_phase(Frame& F) {
    const int lane = F.lane, gw = F.bid * NWAVES + F.wave, NGW = F.G * NWAVES, i16 = lane & 15, kq = lane >> 4;
    for (int j = gw; j < 16 * 176; j += NGW) { const int rt_ = j / 176, cgp = j % 176;
        const int pa = i16 >> 1, wh = i16 & 1, srow = (pa == 0) ? (R_META0 + 14 + wh) : (256 * (8 * rt_ + pa) - 2 + wh);
        const int ch = 16 * cgp + i16, brow = 256 * (ch >> 7) + (ch & 127);
        const bf16* ap = F.H1 + (size_t)srow * DM + 8 * kq; const bf16* bp = F.Wffn_t + (size_t)brow * DM + 8 * kq;
        f32x4 acc = (f32x4){0.f, 0.f, 0.f, 0.f};
#pragma unroll 8
        for (int s = 0; s < 32; ++s) acc = __builtin_amdgcn_mfma_f32_16x16x32_bf16(*(const GAS bf16x8*)(ap + 32 * s), *(const GAS bf16x8*)(bp + 32 * s), acc, 0, 0, 0);
#pragma unroll
        for (int r = 0; r < 4; ++r) { const int i = 4 * kq + r; F.HALO[((size_t)(8 * rt_ + (i >> 1)) * 2 + (i & 1)) * FF + ch] = acc[r]; }
    }
}

struct Args { const void* in[28]; float* out; unsigned char* ws; int ph_lo, ph_hi; };
__global__ void __launch_bounds__(NTHR, 2) hymba_fwd(Args args) {
    extern __shared__ __attribute__((aligned(16))) unsigned char lds[];
    Frame F;
    F.lds = (ldsp)lds; F.MISC = (volatile LAS unsigned*)(F.lds + MISC_OFF);
    F.tid = threadIdx.x; F.lane = F.tid & 63; F.wave = __builtin_amdgcn_readfirstlane(F.tid >> 6); F.G = gridDim.x; F.bid = blockIdx.x;
    unsigned char* ws = args.ws; F.ws = ws; F.out = args.out; F.ctl = (gu32*)(ws + WS_CTL);
    F.x_prompt = (const float*)args.in[0]; F.x_sample = (const float*)args.in[1]; F.cache_ckv = (const float*)args.in[2]; F.cache_krope = (const float*)args.in[3]; F.page_table = (const int*)args.in[4];
    F.state_gla = (const float*)args.in[5]; F.state_conv = (const float*)args.in[6]; F.meta = (const float*)args.in[7]; F.ln_emb_g = (const float*)args.in[8]; F.ln_emb_b = (const float*)args.in[9];
    F.w_in = (const float*)args.in[10]; F.w_gate_up = (const float*)args.in[11]; F.b_gate = (const float*)args.in[12]; F.gla_norm_g = (const float*)args.in[13]; F.q_norm_g = (const float*)args.in[14];
    F.kv_norm_g = (const float*)args.in[15]; F.w_uq = (const float*)args.in[16]; F.w_uk = (const float*)args.in[17]; F.w_uv = (const float*)args.in[18]; F.w_o = (const float*)args.in[19];
    F.ln1_g = (const float*)args.in[20]; F.ln1_b = (const float*)args.in[21]; F.w_ffn_in = (const float*)args.in[22]; F.conv_w = (const float*)args.in[23]; F.conv_b = (const float*)args.in[24];
    F.w_down = (const float*)args.in[25]; F.ln2_g = (const float*)args.in[26]; F.ln2_b = (const float*)args.in[27];
    F.ROPE_T = (float*)(ws + WS_ROPE); F.Win_t = (bf16*)(ws + WS_WIN); F.Wuq_t = (bf16*)(ws + WS_WUQ); F.Wkv_t = (bf16*)(ws + WS_WKV); F.Wo_t = (bf16*)(ws + WS_WO); F.Wffn_t = (bf16*)(ws + WS_WFFN); F.Wdown_t = (bf16*)(ws + WS_WDOWN);
    F.XN = (bf16*)(ws + WS_XN); F.Z = (bf16*)(ws + WS_Z); F.CQN = (bf16*)(ws + WS_CQN); F.CKV = (bf16*)(ws + WS_CKV); F.KR = (bf16*)(ws + WS_KR); F.Q = (bf16*)(ws + WS_Q); F.KV = (bf16*)(ws + WS_KV); F.AO = (bf16*)(ws + WS_AO);
    F.Y1 = (float*)(ws + WS_Y1); F.H1 = (bf16*)(ws + WS_H1); F.Gb = (bf16*)(ws + WS_G); F.Y2 = (float*)(ws + WS_Y2); F.KVC = (float*)(ws + WS_KVC); F.DEC = (float*)(ws + WS_DEC); F.ST = (bf16*)(ws + WS_ST); F.HALO = (float*)(ws + WS_HALO);
    for (int u = F.tid; u < (LDS_BYTES - LDSCTL_OFF) / 4; u += NTHR) ((LAS unsigned*)(F.lds + LDSCTL_OFF))[u] = 0u;
    __syncthreads();
    XcdBarrier bar; bar.bar = (unsigned*)(F.ctl + CW_BAR); bar.x = 0; bar.st = nullptr;
    if (N_LAUNCHES == 1) bar = xcd_barrier_post((unsigned*)(F.ctl + CW_BAR), F.MISC + 8);
    const int lo = args.ph_lo, hi = args.ph_hi;
#ifndef P4_MASK
#define P4_MASK 15
#endif
#ifndef PHASE_MASK
#define PHASE_MASK 0x7ff
#endif
#define IN(k) ((((PHASE_MASK) >> (k)) & 1) && lo <= (k) && (k) < hi)
#define BOTH(k) (IN(k) && IN((k) + 1))
#define SEAM(k) do { if (BOTH(k)) xcd_barrier(bar); } while (0)
    const int gw = F.bid * NWAVES + F.wave, NGW = F.G * NWAVES;
    ldsp L = F.lds + RING_OFF;

    if (IN(0)) { p0_prologue(F); SEAM(0); }
    if (IN(1)) { pg8::Gemm g{F.XN, F.Win_t, RTOT, ZC, DM}; pg8::StaticOrder S; S.init(RTOT, ZC, F.G, F.bid);
        pg8::EpiBf16<0> E{F.Z, ZC, nullptr, 0, 0, 1.f};
        pg8::gemm_phase<pg8::EpiBf16<0>, pg8::StaticOrder, true, true>(L, g, S, E); SEAM(1); }
    if (IN(2)) {
        for (int m = gw; m < RTOT; m += NGW) p2_row(F, m);
        for (int u = F.bid; u < 2052; u += F.G) gla_pass1_unit(F, L, u);
        for (int u = F.bid; u < DB * 4; u += F.G) gla_sample_unit(F, L, u);
        SEAM(2); }
    if (IN(3)) {
        gla_pass2(F);
        { pg8::Gemm g{F.CQN, F.Wuq_t, RTOT, QW, QL}; pg8::StaticOrder S; S.init(RTOT, QW, F.G, F.bid); pg8::EpiBf16<0> E{F.Q, QW, nullptr, 0, 0, 1.f};
          pg8::gemm_phase<pg8::EpiBf16<0>, pg8::StaticOrder, true, true>(L, g, S, E); }
        { pg8::Gemm g{F.CKV, F.Wkv_t, RTOT, 1024, KVL}; pg8::StaticOrder S; S.init(RTOT, 1024, F.G, F.bid); pg8::EpiBf16<0> E{F.KV, 1024, nullptr, 0, 0, 1.f};
          pg8::gemm_phase<pg8::EpiBf16<0>, pg8::StaticOrder, true, true>(L, g, S, E); }
        SEAM(3); }
    if (IN(4)) {
#define DEQ(word) ({ if (F.tid == 0) F.MISC[0] = __hip_atomic_fetch_add(F.ctl + CW_QUEUE + 64 * (word), 1u, RLX_AGENT); __syncthreads(); const int id_ = (int)F.MISC[0]; __syncthreads(); id_; })
        if (P4_MASK & 1) for (;;) { const int id = DEQ(0); if (id >= DB) break; attn_decode_unit(F, L, id); }
        if (P4_MASK & 2) for (;;) { const int id = DEQ(1); if (id >= NB * 64 + 8) break;
            int qrow0, kvrow0, qb, h;
            if (id < NB * 64) { const int bh = id & 127, b = bh >> 3; qb = 7 - (id >> 7); h = bh & 7; qrow0 = b * SEQ + 256 * qb; kvrow0 = b * SEQ; } else { qb = -1; h = id - NB * 64; qrow0 = R_META0; kvrow0 = 0; }
            attn_prompt_unit(F, L, qrow0, kvrow0, qb, h); }
        if (P4_MASK & 8) for (;;) { const int id = DEQ(2); if (id >= 513) break;
            for (int u = 4 * id; u < 4 * id + 4 && u < 2052; ++u) gla_pass3_unit(F, L, u); }
#undef DEQ
        SEAM(4); }
    if (IN(5)) { pg8::Gemm g{F.AO, F.Wo_t, RTOT, DM, DM}; pg8::StaticOrder S; S.init(RTOT, DM, F.G, F.bid); pg8::EpiResF32 E{F.Y1, F.XN, DM, DN_ALPHA};
        pg8::gemm_phase<pg8::EpiResF32, pg8::StaticOrder, true, true>(L, g, S, E); SEAM(5); }
    if (IN(6)) { for (int m = gw; m < R_VALID; m += NGW) ln_row_bf16(F.Y1 + (size_t)m * DM, F.ln1_g, F.ln1_b, F.H1 + (size_t)m * DM, F.lane); SEAM(6); }
    if (IN(7)) { halo_phase(F); SEAM(7); }
    if (IN(8)) { pg8::Gemm g{F.H1, F.Wffn_t, R_FFN, 2 * FF, DM}; pg8::StaticOrder S; S.init(R_FFN, 2 * FF, F.G, F.bid);
        pg8::EpiFfn E{F.Gb, F.HALO, F.conv_w, F.conv_b, F.state_conv, F.out + O_CONVP, F.out + O_CONVS, (LAS float*)(F.lds + XTRA_OFF)};
        pg8::gemm_phase<pg8::EpiFfn, pg8::StaticOrder, true, true>(L, g, S, E); SEAM(8); }
    if (IN(9)) { pg8::Gemm g{F.Gb, F.Wdown_t, R_FFN, DM, FF}; pg8::StaticOrder S; S.init(R_FFN, DM, F.G, F.bid); pg8::EpiResF32 E{F.Y2, F.H1, DM, DN_ALPHA};
        pg8::gemm_phase<pg8::EpiResF32, pg8::StaticOrder, true, true>(L, g, S, E); SEAM(9); }
    if (IN(10)) { for (int m = gw; m < R_FFN; m += NGW) ln_row_f32(F.Y2 + (size_t)m * DM, F.ln2_g, F.ln2_b, F.out + O_YP + (size_t)m * DM, F.lane); }
#undef IN
#undef BOTH
#undef SEAM
}

extern "C" void kernel_launch(void* const* d_in, const int* in_sizes, int n_in, void* d_out, int out_size, void* d_ws, size_t ws_size, hipStream_t stream) {
    static int grid = 0;
    if (grid == 0) {
        if (n_in != 28 || out_size != (int)O_END || ws_size < WS_END) { fprintf(stderr, "kernel_launch: unexpected problem shape (n_in %d, out %d, ws %zu); nothing launched\n", n_in, out_size, ws_size); grid = -1; return; }
        int dev = 0, cus = 0, per_cu = 0;
        if (hipGetDevice(&dev) != hipSuccess || hipDeviceGetAttribute(&cus, hipDeviceAttributeMultiprocessorCount, dev) != hipSuccess) { grid = -1; return; }
        if (hipFuncSetAttribute((const void*)hymba_fwd, hipFuncAttributeMaxDynamicSharedMemorySize, LDS_BYTES) != hipSuccess) { fprintf(stderr, "kernel_launch: hipFuncSetAttribute failed\n"); grid = -1; return; }
        if (hipOccupancyMaxActiveBlocksPerMultiprocessor(&per_cu, (const void*)hymba_fwd, NTHR, LDS_BYTES) != hipSuccess || per_cu < 1) { fprintf(stderr, "kernel_launch: occupancy query reports %d workgroups per CU\n", per_cu); }
        (void)hipGetLastError();
        grid = cus;
    }
    if (grid < 0) return;
    if (hipMemsetAsync((char*)d_ws + WS_CTL, 0, CTL_ZERO_BYTES, stream) != hipSuccess) { fprintf(stderr, "kernel_launch: memset failed\n"); return; }
    Args a{};
    for (int i = 0; i < 28; ++i) a.in[i] = d_in[i];
    a.out = (float*)d_out; a.ws = (unsigned char*)d_ws;
    for (int li = 0; li < N_LAUNCHES; ++li) {
        a.ph_lo = (N_LAUNCHES == 1) ? 0 : li; a.ph_hi = (N_LAUNCHES == 1) ? NPH : li + 1;
        hipLaunchKernelGGL(hymba_fwd, dim3(grid), dim3(NTHR), LDS_BYTES, stream, a);
        const hipError_t le = hipPeekAtLastError();
        if (le != hipSuccess) { fprintf(stderr, "kernel_launch: launch %d failed: %s\n", li, hipGetErrorName(le)); break; }
    }
}
```

```cpp
#include <hip/hip_runtime.h>
#include <cstdio>
#include <cstdint>
namespace pg8 {
#define PG8_LAS __attribute__((address_space(3)))
typedef unsigned short bf16_t;
typedef short bf16x8 __attribute__((ext_vector_type(8)));
typedef float f32x4 __attribute__((ext_vector_type(4)));
typedef unsigned u32x4 __attribute__((ext_vector_type(4)));
constexpr int BM = 256, BK = 64, HALF = 128, HTB = HALF * BK * 2  , STAGE_BYTES = 8 * HTB, NXCD = 8, WGM = 8;

__host__ __device__ __forceinline__ int lds_byte(int r, int c) { const int st = (r >> 4) * 2 + (c >> 5), rr = r & 15, cc = c & 31, ob = rr * 64 + cc * 2; return st * 1024 + (ob ^ (((ob >> 9) & 1) << 5)); }
__host__ __device__ __forceinline__ void stage_rc(int b, int& R, int& C) { const int st = b / 1024, sb = b % 1024, swz = sb ^ (((sb >> 9) & 1) << 5); R = (st >> 1) * 16 + swz / 64; C = (st & 1) * 32 + (swz % 64) / 2; }
__host__ __device__ __forceinline__ int perm32(int rho) { const int n = rho >> 4, i = rho & 15; return 8 * (i >> 2) + 4 * n + (i & 3); }

struct Unit { int pm, pn, ko; };
struct Gemm { const bf16_t* A; const bf16_t* Bt; int M, N, K, Ku; };

struct StaticOrder {
    int nM, nN, nwg, G, c;
    __host__ __device__ void init(int M, int N, int G_, int c_) { nM = M / BM; nN = N / BM; nwg = nM * nN; G = G_; c = c_; }
    __host__ __device__ bool next(int i, Unit& u) const {
        const long L = (long)i * G + c; if (L >= nwg) return false;
        int wgid = (int)L; { const int q = nwg / NXCD, r = nwg % NXCD, xcd = wgid % NXCD, off = wgid / NXCD; wgid = (xcd < r ? xcd * (q + 1) : r * (q + 1) + (xcd - r) * q) + off; }
        const int nig = WGM * nN, gid = wgid / nig, fm = gid * WGM, gsz = (nM - fm) < WGM ? (nM - fm) : WGM;
        u.pm = fm + ((wgid % nig) % gsz); u.pn = (wgid % nig) / gsz; u.ko = 0; return true;
    }
    __device__ __forceinline__ void a_ready(const Unit&) const {}
    __device__ __forceinline__ void done(const Unit&) const {}
};

__device__ __forceinline__ unsigned cvt_pk_bf16(float lo, float hi) { unsigned r; asm volatile("v_cvt_pk_bf16_f32 %0, %1, %2" : "=v"(r) : "v"(lo), "v"(hi)); return r; }
typedef float f32x2 __attribute__((ext_vector_type(2)));
__device__ __forceinline__ f32x2 gelu_pk(f32x2 v) {
    const f32x2 av = __builtin_elementwise_abs(v), d = av * 0.2316418882f + 1.0f;
    f32x2 t; t.x = __builtin_amdgcn_rcpf(d.x); t.y = __builtin_amdgcn_rcpf(d.y);
    f32x2 q = t * 0.5307027145f + (-0.7265760135f); q = q * t + 0.7107068705f; q = q * t + (-0.142248368f); q = q * t + 0.127414796f; q = q * t;
    const f32x2 s = (v * v) * (-0.72134752044f);
    f32x2 e; e.x = __builtin_amdgcn_exp2f(s.x); e.y = __builtin_amdgcn_exp2f(s.y);
    const f32x2 m = v * (q * e), r = v - m;
    f32x2 o; o.x = v.x < 0.f ? m.x : r.x; o.y = v.y < 0.f ? m.y : r.y; return o;
}

template <int ACT  > struct EpiBf16 {
    static constexpr bool PERM = true, AFTER_DRAIN = false; static_assert(ACT == 0 || ACT == 1, "EpiBf16: ACT is 0 (none) or 1 (gelu_pk)");
    bf16_t* O; int ldc; const float* bias; int split_cols; size_t split_stride; float scale0;
    __device__ __forceinline__ void operator()(const f32x4 (&acc)[2][2][4][2], const Unit& u, int wr, int wc, int fr, int fq) const {
        const int row0 = u.pm * BM + wr * 64 + fr; int colt = u.pn * BM; bf16_t* base = O;
        float sc = 1.f; if (split_cols) { const int t = colt / split_cols; base += (size_t)t * split_stride; colt -= t * split_cols; if (t == 0) sc = scale0; }
        const int col0 = colt + wc * 32 + 8 * fq, bcol0 = u.pn * BM + wc * 32 + 8 * fq;
        f32x4 bv[2][2];
#pragma unroll
        for (int bj = 0; bj < 2; ++bj)
#pragma unroll
            for (int n = 0; n < 2; ++n) bv[bj][n] = bias ? *(const f32x4*)(bias + bcol0 + bj * HALF + 4 * n) : (f32x4){0.f, 0.f, 0.f, 0.f};
#pragma unroll
        for (int ai = 0; ai < 2; ++ai)
#pragma unroll
            for (int m = 0; m < 4; ++m) { bf16_t* rowp = base + (size_t)(row0 + ai * HALF + m * 16) * ldc + col0;
#pragma unroll
                for (int bj = 0; bj < 2; ++bj) { f32x4 v0 = acc[ai][bj][m][0] + bv[bj][0], v1 = acc[ai][bj][m][1] + bv[bj][1];
                    if (ACT == 1) { f32x2 a = gelu_pk((f32x2){v0[0], v0[1]}), b = gelu_pk((f32x2){v0[2], v0[3]}), c = gelu_pk((f32x2){v1[0], v1[1]}), d = gelu_pk((f32x2){v1[2], v1[3]});
                        v0 = (f32x4){a.x, a.y, b.x, b.y}; v1 = (f32x4){c.x, c.y, d.x, d.y}; }
                    v0 = v0 * sc; v1 = v1 * sc; u32x4 w; w.x = cvt_pk_bf16(v0[0], v0[1]); w.y = cvt_pk_bf16(v0[2], v0[3]); w.z = cvt_pk_bf16(v1[0], v1[1]); w.w = cvt_pk_bf16(v1[2], v1[3]);
                    *(u32x4*)(rowp + bj * HALF) = w; } }
    }
};
struct EpiResF32 {
    static constexpr bool PERM = false, AFTER_DRAIN = false;
    float* O; const bf16_t* res; int ldc; float alpha;
    __device__ __forceinline__ void operator()(const f32x4 (&acc)[2][2][4][2], const Unit& u, int wr, int wc, int fr, int fq) const {
        typedef unsigned u32x2v __attribute__((ext_vector_type(2)));
        const int row0 = u.pm * BM + wr * 64 + fr, col0 = u.pn * BM + wc * 32 + 4 * fq;
#pragma unroll
        for (int ai = 0; ai < 2; ++ai)
#pragma unroll
            for (int m = 0; m < 4; ++m) { const size_t off = (size_t)(row0 + ai * HALF + m * 16) * ldc + col0;
#pragma unroll
                for (int bj = 0; bj < 2; ++bj)
#pragma unroll
                    for (int n = 0; n < 2; ++n) { const u32x2v rb = *(const u32x2v*)(res + off + bj * HALF + n * 16);
                        f32x4 r; r[0] = __uint_as_float(rb.x << 16); r[1] = __uint_as_float(rb.x & 0xffff0000u); r[2] = __uint_as_float(rb.y << 16); r[3] = __uint_as_float(rb.y & 0xffff0000u);
                        *(f32x4*)(O + off + bj * HALF + n * 16) = acc[ai][bj][m][n] + r * alpha; } }
    }
};
struct EpiResBf16 {
    static constexpr bool PERM = true, AFTER_DRAIN = false;
    bf16_t* O; const bf16_t* res; int ldc; float alpha;
    __device__ __forceinline__ void operator()(const f32x4 (&acc)[2][2][4][2], const Unit& u, int wr, int wc, int fr, int fq) const {
        const int row0 = u.pm * BM + wr * 64 + fr, col0 = u.pn * BM + wc * 32 + 8 * fq;
#pragma unroll
        for (int ai = 0; ai < 2; ++ai)
#pragma unroll
            for (int m = 0; m < 4; ++m) { const size_t off = (size_t)(row0 + ai * HALF + m * 16) * ldc + col0;
#pragma unroll
                for (int bj = 0; bj < 2; ++bj) { const u32x4 rb = *(const u32x4*)(res + off + bj * HALF);
                    const f32x4 a0 = acc[ai][bj][m][0], a1 = acc[ai][bj][m][1]; u32x4 w;
                    w.x = cvt_pk_bf16(a0[0] + alpha * __uint_as_float(rb.x << 16), a0[1] + alpha * __uint_as_float(rb.x & 0xffff0000u)); w.y = cvt_pk_bf16(a0[2] + alpha * __uint_as_float(rb.y << 16), a0[3] + alpha * __uint_as_float(rb.y & 0xffff0000u));
                    w.z = cvt_pk_bf16(a1[0] + alpha * __uint_as_float(rb.z << 16), a1[1] + alpha * __uint_as_float(rb.z & 0xffff0000u)); w.w = cvt_pk_bf16(a1[2] + alpha * __uint_as_float(rb.w << 16), a1[3] + alpha * __uint_as_float(rb.w & 0xffff0000u));
                    *(u32x4*)(O + off + bj * HALF) = w; } }
    }
};
struct EpiSlabBf16 {
    static constexpr bool PERM = true, AFTER_DRAIN = false;
    bf16_t* O; int ldc, pm0, Ku; size_t slab_stride;
    __device__ __forceinline__ void operator()(const f32x4 (&acc)[2][2][4][2], const Unit& u, int wr, int wc, int fr, int fq) const {
        bf16_t* base = O + (size_t)(u.ko / Ku) * slab_stride; const int row0 = (u.pm - pm0) * BM + wr * 64 + fr, col0 = u.pn * BM + wc * 32 + 8 * fq;
#pragma unroll
        for (int ai = 0; ai < 2; ++ai)
#pragma unroll
            for (int m = 0; m < 4; ++m) { const size_t off = (size_t)(row0 + ai * HALF + m * 16) * ldc + col0;
#pragma unroll
                for (int bj = 0; bj < 2; ++bj) { const f32x4 a0 = acc[ai][bj][m][0], a1 = acc[ai][bj][m][1]; u32x4 w;
                    w.x = cvt_pk_bf16(a0[0], a0[1]); w.y = cvt_pk_bf16(a0[2], a0[3]); w.z = cvt_pk_bf16(a1[0], a1[1]); w.w = cvt_pk_bf16(a1[2], a1[3]);
                    *(u32x4*)(base + off + bj * HALF) = w; } }
    }
};
struct SplitOrder {
    int pm0, npm, nN, nks, Ku, G, c;
    __device__ __forceinline__ bool next(int i, Unit& u) const { const int L = i * G + c; if (L >= npm * nN * nks) return false; const int ks = L % nks, r = L / nks; u.pn = r % nN; u.pm = pm0 + r / nN; u.ko = ks * Ku; return true; }
    __device__ __forceinline__ void a_ready(const Unit&) const {}
    __device__ __forceinline__ void done(const Unit&) const {}
};
struct EpiInProj {
    static constexpr bool PERM = true, AFTER_DRAIN = false, TWICE = false;
    bf16_t* Z; bf16_t* CKV; bf16_t* KR; float* out; const float* kvg; const float* rope; PG8_LAS float* red;
    __device__ static __forceinline__ void rowmap(int r, int& ridx, int& nout, size_t& oc, size_t& ok) {
        if (r < 32768) { const int b = r >> 11, t = r & 2047; ridx = 16 + t; nout = 1; oc = 34078720 + ((size_t)b * 2064 + 16 + t) * 256; ok = 42532864 + ((size_t)b * 2064 + 16 + t) * 32; }
        else if (r < 33280) { const int i = r - 32768; ridx = 2064 + (i & 3); nout = 1; oc = 44204032 + (size_t)i * 256; ok = 44335104 + (size_t)i * 32; }
        else if (r < 33296) { const int p = r - 33280; ridx = p; nout = 16; oc = 34078720 + (size_t)p * 256; ok = 42532864 + (size_t)p * 32; }
        else { ridx = 0; nout = 0; oc = 0; ok = 0; } }
    __device__ __forceinline__ void operator()(const f32x4 (&acc)[2][2][4][2], const Unit& u, int wr, int wc, int fr, int fq) const {
        const int pn = u.pn, row0 = u.pm * BM + wr * 64 + fr;
        if (pn < 8) {
            const int col0 = pn * BM + wc * 32 + 8 * fq;
#pragma unroll
            for (int ai = 0; ai < 2; ++ai)
#pragma unroll
                for (int m = 0; m < 4; ++m) { bf16_t* rowp = Z + (size_t)(row0 + ai * HALF + m * 16) * 2304 + col0;
#pragma unroll
                    for (int bj = 0; bj < 2; ++bj) { const f32x4 v0 = acc[ai][bj][m][0], v1 = acc[ai][bj][m][1]; u32x4 w; w.x = cvt_pk_bf16(v0[0], v0[1]); w.y = cvt_pk_bf16(v0[2], v0[3]); w.z = cvt_pk_bf16(v1[0], v1[1]); w.w = cvt_pk_bf16(v1[2], v1[3]);
                        *(u32x4*)(rowp + bj * HALF) = w; } }
            if (pn == 7 && wc == 0) {
                const int ci = 8 * (fq & 1);
#pragma unroll
                for (int ai = 0; ai < 2; ++ai)
#pragma unroll
                    for (int m = 0; m < 4; ++m) { const int row = row0 + ai * HALF + m * 16; int ridx, nout; size_t oc, ok; rowmap(row, ridx, nout, oc, ok);
                        const f32x4 x0 = acc[ai][1][m][0], x1 = acc[ai][1][m][1]; f32x4 p0, p1;
#pragma unroll
                        for (int j = 0; j < 4; ++j) { p0[j] = __shfl_xor(x0[j], 32); p1[j] = __shfl_xor(x1[j], 32); }
                        const f32x4 c0 = *(const f32x4*)(rope + ridx * 32 + ci), c1 = *(const f32x4*)(rope + ridx * 32 + ci + 4), s0 = *(const f32x4*)(rope + ridx * 32 + 16 + ci), s1 = *(const f32x4*)(rope + ridx * 32 + 16 + ci + 4);
                        const float sg = fq < 2 ? -1.f : 1.f;
                        const f32x4 y0 = x0 * c0 + p0 * s0 * sg, y1 = x1 * c1 + p1 * s1 * sg;
                        u32x4 w; w.x = cvt_pk_bf16(y0[0], y0[1]); w.y = cvt_pk_bf16(y0[2], y0[3]); w.z = cvt_pk_bf16(y1[0], y1[1]); w.w = cvt_pk_bf16(y1[2], y1[3]);
                        *(u32x4*)(KR + (size_t)row * 32 + 8 * fq) = w;
                        for (int c = 0; c < nout; ++c) { float* dst = out + ok + (size_t)c * 2064 * 32 + 8 * fq; __builtin_nontemporal_store(y0, (f32x4*)dst); __builtin_nontemporal_store(y1, (f32x4*)(dst + 4)); } }
            }
        } else {
#pragma unroll
            for (int ai = 0; ai < 2; ++ai)
#pragma unroll
                for (int m = 0; m < 4; ++m) { float ss = 0.f;
#pragma unroll
                    for (int bj = 0; bj < 2; ++bj)
#pragma unroll
                        for (int n = 0; n < 2; ++n) { const f32x4 x = acc[ai][bj][m][n]; ss += (x[0] * x[0] + x[1] * x[1]) + (x[2] * x[2] + x[3] * x[3]); }
                    ss += __shfl_xor(ss, 16); ss += __shfl_xor(ss, 32);
                    if (fq == 0) red[(ai * HALF + wr * 64 + m * 16 + fr) * 4 + wc] = ss; }
            asm volatile("s_waitcnt lgkmcnt(0)" ::: "memory"); __builtin_amdgcn_s_barrier(); asm volatile("" ::: "memory");
            f32x4 g0[2], g1[2];
#pragma unroll
            for (int bj = 0; bj < 2; ++bj) { g0[bj] = *(const f32x4*)(kvg + bj * HALF + wc * 32 + 8 * fq); g1[bj] = *(const f32x4*)(kvg + bj * HALF + wc * 32 + 8 * fq + 4); }
#pragma unroll
            for (int ai = 0; ai < 2; ++ai)
#pragma unroll
                for (int m = 0; m < 4; ++m) { const int rl = ai * HALF + wr * 64 + m * 16 + fr, row = u.pm * BM + rl; int ridx, nout; size_t oc, ok; rowmap(row, ridx, nout, oc, ok);
                    const f32x4 pr = *(const PG8_LAS f32x4*)(red + rl * 4); const float rs = 1.0f / sqrtf(((pr[0] + pr[1]) + (pr[2] + pr[3])) * (1.0f / 256.0f) + 1e-5f);
#pragma unroll
                    for (int bj = 0; bj < 2; ++bj) { const int cb = bj * HALF + wc * 32 + 8 * fq; const f32x4 y0 = acc[ai][bj][m][0] * rs * g0[bj], y1 = acc[ai][bj][m][1] * rs * g1[bj];
                        u32x4 w; w.x = cvt_pk_bf16(y0[0], y0[1]); w.y = cvt_pk_bf16(y0[2], y0[3]); w.z = cvt_pk_bf16(y1[0], y1[1]); w.w = cvt_pk_bf16(y1[2], y1[3]);
                        *(u32x4*)(CKV + (size_t)row * 256 + cb) = w;
                        for (int c = 0; c < nout; ++c) { float* dst = out + oc + (size_t)c * 2064 * 256 + cb; __builtin_nontemporal_store(y0, (f32x4*)dst); __builtin_nontemporal_store(y1, (f32x4*)(dst + 4)); } } }
            asm volatile("s_waitcnt lgkmcnt(0)" ::: "memory"); __builtin_amdgcn_s_barrier(); asm volatile("" ::: "memory");
        }
    }
};
__device__ __forceinline__ float dpp_ror1(float v) { return __builtin_bit_cast(float, __builtin_amdgcn_update_dpp(0, __builtin_bit_cast(int, v), 0x121, 0xF, 0xF, false)); }
__device__ __forceinline__ float dpp_ror2(float v) { return __builtin_bit_cast(float, __builtin_amdgcn_update_dpp(0, __builtin_bit_cast(int, v), 0x122, 0xF, 0xF, false)); }
__device__ __forceinline__ float dpp_shr1(float old, float v) { return __builtin_bit_cast(float, __builtin_amdgcn_update_dpp(__builtin_bit_cast(int, old), __builtin_bit_cast(int, v), 0x111, 0xF, 0xF, false)); }
__device__ __forceinline__ float dpp_shr2(float old, float v) { return __builtin_bit_cast(float, __builtin_amdgcn_update_dpp(__builtin_bit_cast(int, old), __builtin_bit_cast(int, v), 0x112, 0xF, 0xF, false)); }
__device__ __forceinline__ float silu_f(float x) { return x * __builtin_amdgcn_rcpf(1.0f + __builtin_amdgcn_exp2f(-1.4426950408889634f * x)); }
template <bool SAMPLE  > struct EpiFfn {
    static constexpr bool PERM = true, AFTER_DRAIN = false;
    bf16_t* G; const float* halo; const float* conv_w; const float* conv_b; const float* state_conv; float* conv_prompt; float* conv_sample; PG8_LAS float* bnd;
    __device__ __forceinline__ void operator()(const f32x4 (&acc)[2][2][4][2], const Unit& u, int wr, int wc, int fr, int fq) const {
        constexpr int FF = 2816;
        const int pm = u.pm, pn = u.pn; constexpr bool sample = SAMPLE;
        const int chl = wc * 32 + 8 * fq, chg = pn * 128 + chl;
#pragma unroll
        for (int ai = 0; ai < 2; ++ai) { const int blk = 2 * ai + wr;
            if (fr >= 14) {
                if (blk < 3) {
#pragma unroll
                    for (int n = 0; n < 2; ++n) *(PG8_LAS f32x4*)(bnd + ((blk + 1) * 2 + (fr - 14)) * 128 + chl + 4 * n) = acc[ai][0][3][n]; }
                else if (!sample && (pm & 7) == 7) {
#pragma unroll
                    for (int n = 0; n < 2; ++n) *(f32x4*)(conv_prompt + ((size_t)(pm >> 3) * 2 + (fr - 14)) * FF + chg + 4 * n) = acc[ai][0][3][n]; }
            } }
        asm volatile("s_waitcnt lgkmcnt(0)" ::: "memory"); __builtin_amdgcn_s_barrier(); asm volatile("" ::: "memory");
        f32x4 w0[2], w1[2], w2[2], cb[2];
#pragma unroll
        for (int n = 0; n < 2; ++n) { w0[n] = *(const f32x4*)(conv_w + chg + 4 * n); w1[n] = *(const f32x4*)(conv_w + FF + chg + 4 * n); w2[n] = *(const f32x4*)(conv_w + 2 * FF + chg + 4 * n); cb[n] = *(const f32x4*)(conv_b + chg + 4 * n); }
#pragma unroll
        for (int ai = 0; ai < 2; ++ai) { const int blk = 2 * ai + wr;
            f32x4 pv[2]; pv[0] = (f32x4){0.f, 0.f, 0.f, 0.f}; pv[1] = pv[0];
            if (fr >= 14) {
                if (blk == 0) { if (!sample) {
#pragma unroll
                    for (int n = 0; n < 2; ++n) pv[n] = *(const f32x4*)(halo + ((size_t)pm * 2 + (fr - 14)) * FF + chg + 4 * n); } }
                else {
#pragma unroll
                    for (int n = 0; n < 2; ++n) pv[n] = *(const PG8_LAS f32x4*)(bnd + (blk * 2 + (fr - 14)) * 128 + chl + 4 * n); }
            }
#pragma unroll
            for (int m = 0; m < 4; ++m) { const int row = pm * BM + ai * HALF + wr * 64 + m * 16 + fr;
                u32x4 wv;
#pragma unroll
                for (int n = 0; n < 2; ++n) { const f32x4 cur = acc[ai][0][m][n], up = acc[ai][1][m][n], pr = (m == 0) ? pv[n] : acc[ai][0][m > 0 ? m - 1 : 0][n];
                    f32x4 p1, p2;
#pragma unroll
                    for (int j = 0; j < 4; ++j) { p1[j] = dpp_shr1(dpp_ror1(pr[j]), cur[j]); p2[j] = dpp_shr2(dpp_ror2(pr[j]), cur[j]); }
                    if (sample) { const int t = fr & 3, sb = (row - 32768) >> 2;
                        if (t < 2) { const f32x4 s1 = *(const f32x4*)(state_conv + ((size_t)sb * 2 + 1) * FF + chg + 4 * n);
                            if (t == 0) { p1 = s1; p2 = *(const f32x4*)(state_conv + ((size_t)sb * 2) * FF + chg + 4 * n); } else p2 = s1; }
                        else *(f32x4*)(conv_sample + ((size_t)sb * 2 + (t - 2)) * FF + chg + 4 * n) = cur; }
                    const f32x4 cv = cb[n] + w0[n] * p2 + w1[n] * p1 + w2[n] * cur;
                    const float g0 = silu_f(cv[0]) * up[0], g1 = silu_f(cv[1]) * up[1], g2 = silu_f(cv[2]) * up[2], g3 = silu_f(cv[3]) * up[3];
                    if (n == 0) { wv.x = cvt_pk_bf16(g0, g1); wv.y = cvt_pk_bf16(g2, g3); } else { wv.z = cvt_pk_bf16(g0, g1); wv.w = cvt_pk_bf16(g2, g3); } }
                *(u32x4*)(G + (size_t)row * FF + chg) = wv; }
        }
        asm volatile("s_waitcnt lgkmcnt(0)" ::: "memory"); __builtin_amdgcn_s_barrier(); asm volatile("" ::: "memory");
    }
};
template <class Epi, class Sched, bool ALIGN_EPI = false, bool SP2 = false>
__device__ __forceinline__ void gemm_phase(PG8_LAS unsigned char* lds, const Gemm g, const Sched& S, const Epi& E, const int tid_in) {
    int tid_ = tid_in; asm volatile("" : "+v"(tid_));
    const int tid = tid_, wid = __builtin_amdgcn_readfirstlane(tid >> 6), lane = tid & 63, wr = wid >> 2, wc = wid & 3, fr = lane & 15, fq = lane >> 4;
    const int K = g.K, nt = (g.Ku ? g.Ku : K) / BK;
    unsigned voffA[2], voffB[2];
#pragma unroll
    for (int i = 0; i < 2; ++i) { int R, C; stage_rc(tid * 16 + i * 8192, R, C); const int Rb = Epi::PERM ? ((R & ~31) + perm32(R & 31)) : R;
        voffA[i] = (unsigned)(R * K + C) * 2u; voffB[i] = (unsigned)(Rb * K + C) * 2u; }
    const size_t kstep = (size_t)(BK * 2);
    const size_t hstep = (size_t)HALF * K * 2;
    const size_t tstep = 2 * hstep;
    const unsigned ldsw = (unsigned)wid * 1024u;
    const int aoff = lds_byte(wr * 64 + fr, fq * 8), boff = lds_byte(wc * 32 + fr, fq * 8);
#define PG8_SA(b, h) (((b) * 2 + (h)) * HTB)
#define PG8_SB(b, h) ((4 + (b) * 2 + (h)) * HTB)
#define PG8_STAGE(bufoff, gbase, voff) do { _Pragma("unroll") for (int _i = 0; _i < 2; ++_i) \
        __builtin_amdgcn_global_load_lds((const unsigned*)((const char*)(gbase) + (voff)[_i]), (PG8_LAS unsigned*)(lds + (bufoff) + ldsw + _i * 8192), 16, 0, 0); } while (0)
#define PG8_LDA(dst, b, h) do { _Pragma("unroll") for (int m = 0; m < 4; ++m) _Pragma("unroll") for (int k = 0; k < 2; ++k) dst[m][k] = *(const PG8_LAS bf16x8*)(lds + PG8_SA(b, h) + aoff + m * 2048 + k * 1024); } while (0)
#define PG8_LDB(dst, b, h) do { _Pragma("unroll") for (int n = 0; n < 2; ++n) _Pragma("unroll") for (int k = 0; k < 2; ++k) dst[n][k] = *(const PG8_LAS bf16x8*)(lds + PG8_SB(b, h) + boff + n * 2048 + k * 1024); } while (0)
#define PG8_MMA(ai, bj, At, Bt) do { __builtin_amdgcn_s_setprio(1); _Pragma("unroll") for (int m = 0; m < 4; ++m) _Pragma("unroll") for (int n = 0; n < 2; ++n) _Pragma("unroll") for (int k = 0; k < 2; ++k) \
        acc[ai][bj][m][n] = __builtin_amdgcn_mfma_f32_16x16x32_bf16(Bt[n][k], At[m][k], acc[ai][bj][m][n], 0, 0, 0); __builtin_amdgcn_s_setprio(0); } while (0)
#define PG8_WAIT_V(n) asm volatile("s_waitcnt vmcnt(" #n ")" ::: "memory")
#define PG8_WAIT_L(n) asm volatile("s_waitcnt lgkmcnt(" #n ")" ::: "memory")
#define PG8_BAR __builtin_amdgcn_s_barrier()
#define PG8_SCHED __builtin_amdgcn_sched_barrier(0)
    Unit cur, nxt; int ui = 0;
    if (!S.next(0, cur)) return;
    f32x4 acc[2][2][4][2];
#pragma unroll
    for (int a = 0; a < 2; ++a)
#pragma unroll
        for (int b = 0; b < 2; ++b)
#pragma unroll
            for (int m = 0; m < 4; ++m)
#pragma unroll
                for (int n = 0; n < 2; ++n) acc[a][b][m][n] = (f32x4){0.f, 0.f, 0.f, 0.f};
    bf16x8 At[4][2], B0[2][2], B1[2][2];
    const char* cA = (const char*)g.A + (size_t)cur.pm * tstep + (size_t)cur.ko * 2; const char* cB = (const char*)g.Bt + (size_t)cur.pn * tstep + (size_t)cur.ko * 2;
    S.a_ready(cur);
    if constexpr (SP2) {
        PG8_STAGE(PG8_SB(0, 0), cB, voffB); PG8_STAGE(PG8_SB(0, 1), cB + hstep, voffB); PG8_STAGE(PG8_SA(0, 0), cA, voffA); PG8_STAGE(PG8_SA(0, 1), cA + hstep, voffA);
        if (wr == 1) PG8_BAR;
        PG8_WAIT_V(2); PG8_BAR;
        PG8_STAGE(PG8_SB(1, 0), cB + kstep, voffB); PG8_STAGE(PG8_SA(1, 0), cA + kstep, voffA); PG8_STAGE(PG8_SB(1, 1), cB + hstep + kstep, voffB);
        PG8_WAIT_V(6); PG8_BAR;
    } else {
        PG8_STAGE(PG8_SB(0, 0), cB, voffB); PG8_STAGE(PG8_SA(0, 0), cA, voffA); PG8_STAGE(PG8_SB(0, 1), cB + hstep, voffB); PG8_STAGE(PG8_SA(0, 1), cA + hstep, voffA);
        if (wr == 1) PG8_BAR;
        PG8_WAIT_V(4); PG8_BAR;
        PG8_STAGE(PG8_SB(1, 0), cB + kstep, voffB); PG8_STAGE(PG8_SA(1, 0), cA + kstep, voffA); PG8_STAGE(PG8_SB(1, 1), cB + hstep + kstep, voffB);
        PG8_WAIT_V(6); PG8_BAR;
    }
    for (;;) {
        const bool has_next = S.next(ui + 1, nxt);
        const char* nA = has_next ? (const char*)g.A + (size_t)nxt.pm * tstep + (size_t)nxt.ko * 2 : cA; const char* nB = has_next ? (const char*)g.Bt + (size_t)nxt.pn * tstep + (size_t)nxt.ko * 2 : cB;
        for (int t = 0; t < nt; t += 2) {
            const bool last = (t == nt - 2);
            const char* a1 = cA + (size_t)(t + 1) * kstep;
            const char* a2 = last ? nA : cA + (size_t)(t + 2) * kstep; const char* b2 = last ? nB : cB + (size_t)(t + 2) * kstep;
            const char* a3 = a2 + kstep; const char* b3 = b2 + kstep;
            if (last && has_next) S.a_ready(nxt);
            if constexpr (SP2) {
            PG8_LDB(B0, 0, 0); PG8_LDB(B1, 0, 1); PG8_SCHED; PG8_LDA(At, 0, 0); PG8_STAGE(PG8_SA(1, 1), a1 + hstep, voffA);
            PG8_WAIT_V(8); PG8_WAIT_L(0); PG8_BAR; PG8_MMA(0, 0, At, B0); PG8_MMA(0, 1, At, B1); PG8_BAR; PG8_SCHED;
            PG8_LDA(At, 0, 1); PG8_STAGE(PG8_SB(0, 0), b2, voffB); PG8_STAGE(PG8_SB(0, 1), b2 + hstep, voffB); PG8_STAGE(PG8_SA(0, 0), a2, voffA);
            PG8_WAIT_V(8); PG8_WAIT_L(0); PG8_BAR; PG8_MMA(1, 0, At, B0); PG8_MMA(1, 1, At, B1); PG8_BAR; PG8_SCHED;
            PG8_LDB(B0, 1, 0); PG8_LDB(B1, 1, 1); PG8_SCHED; PG8_LDA(At, 1, 0); PG8_STAGE(PG8_SA(0, 1), a2 + hstep, voffA);
            PG8_WAIT_V(8); PG8_WAIT_L(0); PG8_BAR; PG8_MMA(0, 0, At, B0); PG8_MMA(0, 1, At, B1); PG8_BAR; PG8_SCHED;
            PG8_LDA(At, 1, 1); PG8_STAGE(PG8_SB(1, 0), b3, voffB); PG8_STAGE(PG8_SB(1, 1), b3 + hstep, voffB); PG8_STAGE(PG8_SA(1, 0), a3, voffA);
            PG8_WAIT_V(8); PG8_WAIT_L(0); PG8_BAR; PG8_MMA(1, 0, At, B0); PG8_MMA(1, 1, At, B1); PG8_BAR; PG8_SCHED;
            } else {
            PG8_LDB(B0, 0, 0); PG8_SCHED; PG8_LDA(At, 0, 0); PG8_STAGE(PG8_SA(1, 1), a1 + hstep, voffA);
            PG8_WAIT_L(8); PG8_BAR; PG8_WAIT_L(0); PG8_MMA(0, 0, At, B0); PG8_BAR; PG8_SCHED;
            PG8_LDB(B1, 0, 1); PG8_STAGE(PG8_SB(0, 0), b2, voffB);
            PG8_BAR; PG8_WAIT_L(0); PG8_MMA(0, 1, At, B1); PG8_BAR;
            PG8_LDA(At, 0, 1); PG8_STAGE(PG8_SA(0, 0), a2, voffA);
            PG8_BAR; PG8_WAIT_L(0); PG8_MMA(1, 0, At, B0); PG8_BAR; PG8_SCHED;
            PG8_STAGE(PG8_SB(0, 1), b2 + hstep, voffB);
            PG8_WAIT_V(6); PG8_BAR; PG8_MMA(1, 1, At, B1); PG8_BAR;
            PG8_LDB(B0, 1, 0); PG8_SCHED; PG8_LDA(At, 1, 0); PG8_STAGE(PG8_SA(0, 1), a2 + hstep, voffA);
            PG8_WAIT_L(8); PG8_BAR; PG8_WAIT_L(0); PG8_MMA(0, 0, At, B0); PG8_BAR; PG8_SCHED;
            PG8_LDB(B1, 1, 1); PG8_STAGE(PG8_SB(1, 0), b3, voffB);
            PG8_BAR; PG8_WAIT_L(0); PG8_MMA(0, 1, At, B1); PG8_BAR;
            PG8_LDA(At, 1, 1); PG8_STAGE(PG8_SA(1, 0), a3, voffA);
            PG8_BAR; PG8_WAIT_L(0); PG8_MMA(1, 0, At, B0); PG8_BAR; PG8_SCHED;
            PG8_STAGE(PG8_SB(1, 1), b3 + hstep, voffB);
            PG8_WAIT_V(6); PG8_BAR; PG8_MMA(1, 1, At, B1); PG8_BAR;
            }
        }
        if constexpr (ALIGN_EPI) { if (wr == 0) PG8_BAR; }
        if constexpr (!Epi::AFTER_DRAIN) { E(acc, cur, wr, wc, fr, fq); S.done(cur); }
        if (!has_next) break;
#pragma unroll
        for (int a = 0; a < 2; ++a)
#pragma unroll
            for (int b = 0; b < 2; ++b)
#pragma unroll
                for (int m = 0; m < 4; ++m)
#pragma unroll
                    for (int n = 0; n < 2; ++n) acc[a][b][m][n] = (f32x4){0.f, 0.f, 0.f, 0.f};
        cur = nxt; cA = nA; cB = nB; ++ui;
        if constexpr (ALIGN_EPI) { if (wr == 1) PG8_BAR; }
    }
    PG8_WAIT_V(0);
    if constexpr (!ALIGN_EPI) { if (wr == 0) PG8_BAR; }
    PG8_BAR;
    if constexpr (Epi::AFTER_DRAIN) { E.fused(acc, cur, wr, wc, fr, fq, lds, wid, lane); S.done(cur); }
#undef PG8_SA
#undef PG8_SB
#undef PG8_STAGE
#undef PG8_LDA
#undef PG8_LDB
#undef PG8_MMA
#undef PG8_WAIT_V
#undef PG8_WAIT_L
#undef PG8_BAR
#undef PG8_SCHED
}
}
#define GAS __attribute__((address_space(1)))
#define LAS __attribute__((address_space(3)))
typedef unsigned short bf16;
typedef unsigned v4u __attribute__((ext_vector_type(4)));
typedef float f32x4 __attribute__((ext_vector_type(4)));
typedef short bf16x8 __attribute__((ext_vector_type(8)));
typedef GAS unsigned gu32;
typedef GAS unsigned long long gu64;
#define RLX_AGENT __ATOMIC_RELAXED, __HIP_MEMORY_SCOPE_AGENT
#define LDS_WAIT() asm volatile("s_waitcnt lgkmcnt(0)" ::: "memory")
#define VM_WAIT() asm volatile("s_waitcnt vmcnt(0)" ::: "memory")
__device__ __forceinline__ unsigned long long rt() { return __builtin_amdgcn_s_memrealtime(); }
__device__ __forceinline__ unsigned f2bf(float f) { unsigned u = __builtin_bit_cast(unsigned, f); return (u + 0x7fffu + ((u >> 16) & 1u)) >> 16; }
__device__ __forceinline__ unsigned pk2(float lo, float hi) { return f2bf(lo) | (f2bf(hi) << 16); }

#define XB_TMO      128
#define XB_XCNT(j)  (256  + 64 * (j))
#define XB_XSUB(j)  (1280 + 64 * (j))
#define XB_XGEN(j)  (2304 + 64 * (j))
#define XB_TOP      3328
#define XB_TOPGEN   3392
#define XCD_BAR_WORDS 3456
#define XB_SPIN_CAP (1u << 18)

__device__ __forceinline__ unsigned xb_ld(unsigned* p)              { return __hip_atomic_load(p, __ATOMIC_RELAXED, __HIP_MEMORY_SCOPE_AGENT); }
__device__ __forceinline__ unsigned xb_add(unsigned* p, unsigned v) { return __hip_atomic_fetch_add(p, v, __ATOMIC_RELAXED, __HIP_MEMORY_SCOPE_AGENT); }
__device__ __forceinline__ unsigned xb_xcc_id() { return (unsigned)__builtin_amdgcn_s_getreg((3 << 11) | 20) & 0xFu; }
#define XB_SPIN(cond, bar) do { unsigned _sp = 0; while (cond) { __builtin_amdgcn_s_sleep(1); \
    if ((++_sp & 255u) == 0u) { if (xb_ld(&(bar)[XB_TMO])) break; if (_sp > XB_SPIN_CAP) { atomicAdd(&(bar)[XB_TMO], 1u); break; } } } } while (0)

struct XcdBarrier {
    unsigned* bar; unsigned x;
    volatile LAS unsigned* st;
};

__device__ __forceinline__ XcdBarrier xcd_barrier_post(unsigned* bar, volatile LAS unsigned* st) {
    XcdBarrier b; b.bar = bar; b.x = xb_xcc_id(); b.st = st;
    if (threadIdx.x == 0) (void)xb_add(&bar[XB_XCNT(b.x)], 1u);
    return b;
}
__device__ __forceinline__ void xcd_barrier_complete(unsigned* bar, unsigned x, unsigned& nloc, unsigned& nx) {
    const unsigned G = gridDim.x * gridDim.y * gridDim.z;
    unsigned sum, cnt, mine, sp = 0u;
    for (;;) {
        sum = 0u; cnt = 0u; mine = 0u;
#pragma unroll
        for (unsigned j = 0; j < 16; ++j) { const unsigned c = xb_ld(&bar[XB_XCNT(j)]); sum += c; cnt += (c > 0u) ? 1u : 0u; mine = (j == x) ? c : mine; }
        if (sum == G) break;
        __builtin_amdgcn_s_sleep(1);
        if ((++sp & 255u) == 0u) { if (xb_ld(&bar[XB_TMO])) break; if (sp > XB_SPIN_CAP) { atomicAdd(&bar[XB_TMO], 1u); break; } }
    }
    nloc = mine > 0u ? mine : 1u; nx = cnt > 0u ? cnt : 1u;
}

__device__ __forceinline__ void xcd_barrier(const XcdBarrier& b) {
    asm volatile("s_waitcnt vmcnt(0)" ::: "memory");
    __syncthreads();
    if (threadIdx.x == 0) {
        unsigned* bar = b.bar;
        __builtin_amdgcn_s_waitcnt(0);
        unsigned nloc = b.st[0], nx = b.st[1];
        if (nloc == 0u) { xcd_barrier_complete(bar, b.x, nloc, nx); b.st[0] = nloc; b.st[1] = nx; }
        const unsigned old = xb_add(&bar[XB_XSUB(b.x)], 1u);
        const unsigned gen = old / nloc;
        if (old + 1u == (gen + 1u) * nloc) {
            __builtin_amdgcn_fence(__ATOMIC_RELEASE, "agent");
            asm volatile("s_waitcnt vmcnt(0)" ::: "memory");
            const unsigned og = xb_add(&bar[XB_TOP], 1u);
            const unsigned tg = og / nx;
            if (og + 1u == (tg + 1u) * nx) xb_add(&bar[XB_TOPGEN], 1u);
            else XB_SPIN(xb_ld(&bar[XB_TOPGEN]) == tg, bar);
            __builtin_amdgcn_fence(__ATOMIC_ACQUIRE, "agent");
            xb_add(&bar[XB_XGEN(b.x)], 1u);
            asm volatile("s_waitcnt vmcnt(0)" ::: "memory");
        } else {
            XB_SPIN(xb_ld(&bar[XB_XGEN(b.x)]) == gen, bar);
            __builtin_amdgcn_fence(__ATOMIC_ACQUIRE, "agent");
            asm volatile("s_waitcnt vmcnt(0)" ::: "memory");
        }
    }
    __syncthreads();
}
constexpr int NWAVES = 8, NTHR = 512;
constexpr int DM = 1024, NB = 16, SEQ = 2048, NMETA = 16, LTOT = NMETA + SEQ, DB = 128, DS = 4, NPAGES = 64, PAGE = 128;
constexpr int R_PROMPT = NB * SEQ, R_SAMPLE0 = R_PROMPT, R_META0 = R_PROMPT + DB * DS, R_VALID = R_META0 + NMETA, RTOT = 33536;
constexpr int R_FFN = R_META0;
static_assert(R_PROMPT == 32768 && R_META0 == 33280 && R_VALID == 33296 && RTOT % 256 == 0 && RTOT >= R_META0 + 256, "row map");
constexpr int ZC = 2304;
constexpr int ZQ = 0, ZK = 256, ZV = 512, ZG = 1024, ZCQ = 1536, ZKR = 1920, ZA = 1952, ZCKV = 2048, ZEND = 2224;
__host__ __device__ __forceinline__ int zsrc(int n) { return n < 1536 ? n : n < 1920 ? 1552 + (n - 1536) : n < 1952 ? 2192 + (n - 1920) : n < 1968 ? 1536 + (n - 1952) : n < 2048 ? -1 : 1936 + (n - 2048); }
constexpr int QL = 384, KVL = 256, ROPE = 32, QW = 768, FF = 2816;
constexpr float NORM_EPS = 1e-5f, DN_ALPHA = 1.189207115002721f;
constexpr float ATT_SC = 0.10206207261596575f * 1.4426950408889634f;
constexpr size_t O_YP = 0, O_YS = 33554432, O_CKVP = 34078720, O_KRP = 42532864, O_GLAP = 43589632, O_CONVP = 44113920, O_CKVS = 44204032, O_KRS = 44335104, O_GLAS = 44351488, O_CONVS = 48545792, O_END = 49266688;
constexpr size_t MiB = 1u << 20;
constexpr size_t WS_CTL = 0, CTL_ZERO_BYTES = 1 * MiB, WS_ROPE = 1 * MiB, WS_WIN = 2 * MiB, WS_WUQ = 7 * MiB, WS_WKV = 8 * MiB, WS_WO = 9 * MiB, WS_WFFN = 11 * MiB, WS_WDOWN = 22 * MiB;
constexpr size_t WS_XN = 32 * MiB, WS_Z = 98 * MiB, WS_CQN = 246 * MiB, WS_CKV = 271 * MiB, WS_KR = 288 * MiB, WS_Q = 291 * MiB, WS_KV = 341 * MiB, WS_AO = 407 * MiB, WS_Y1 = 473 * MiB, WS_H1 = 604 * MiB;
constexpr size_t WS_G = 670 * MiB, WS_Y2 = 851 * MiB, WS_KVC = 982 * MiB, WS_DEC = 1047 * MiB, WS_ST = 1048 * MiB, WS_HALO = 1081 * MiB, WS_SL5 = 1084 * MiB, WS_SL9 = 1097 * MiB, WS_GQA = 1120 * MiB, WS_END = 1153 * MiB;
static_assert(WS_WIN + (size_t)ZC * DM * 2 <= WS_WUQ && WS_WFFN + (size_t)2 * FF * DM * 2 <= WS_WDOWN && WS_WDOWN + (size_t)DM * FF * 2 <= WS_XN, "weights map");
static_assert(WS_XN + (size_t)RTOT * DM * 2 <= WS_Z && WS_Z + (size_t)RTOT * ZC * 2 <= WS_CQN && WS_CQN + (size_t)RTOT * QL * 2 <= WS_CKV && WS_CKV + (size_t)RTOT * KVL * 2 <= WS_KR && WS_KR + (size_t)RTOT * ROPE * 2 <= WS_Q, "act map 1");
static_assert(WS_Q + (size_t)RTOT * QW * 2 <= WS_KV && WS_KV + (size_t)RTOT * 1024 * 2 <= WS_AO && WS_AO + (size_t)RTOT * DM * 2 <= WS_Y1 && WS_Y1 + (size_t)RTOT * DM * 4 <= WS_H1 && WS_H1 + (size_t)RTOT * DM * 2 <= WS_G, "act map 2");
static_assert(WS_G + (size_t)RTOT * FF * 2 <= WS_Y2 && WS_Y2 + (size_t)RTOT * DM * 4 <= WS_KVC && WS_KVC + (size_t)2052 * 32768 <= WS_DEC && WS_DEC + (size_t)2052 * 256 <= WS_ST && WS_ST + (size_t)2048 * 16384 <= WS_HALO && WS_HALO + (size_t)128 * 2 * FF * 4 <= WS_SL5 && WS_SL5 + (size_t)4 * 768 * DM * 4 <= WS_SL9 && WS_SL9 + (size_t)11 * 512 * DM * 4 <= WS_GQA && WS_GQA + (size_t)2052 * 16384 <= WS_END, "act map 3");
constexpr int CW_TMO = 0, CW_QUEUE = 64, CW_BAR = 4096;
constexpr int RING_OFF = 0, RING_BYTES = 131072, XTRA_OFF = RING_BYTES, XTRA_BYTES = 4096, LDSCTL_OFF = XTRA_OFF + XTRA_BYTES, MISC_OFF = LDSCTL_OFF + 320, LDSCTL_END = LDSCTL_OFF + 4096,
              WG_OFF = LDSCTL_END, WG_BYTES = 16 * 256 * 4 + 1024, LDS_BYTES = 163840;
static_assert(MISC_OFF + 128 <= LDSCTL_END && WG_OFF + WG_BYTES <= LDS_BYTES, "LDS map");
#ifndef SUBPROBE
#define SUBPROBE 0
#endif
constexpr int NPH = 11;
#ifndef MK_N_LAUNCHES
#define MK_N_LAUNCHES 1
#endif
constexpr int N_LAUNCHES = MK_N_LAUNCHES;

#define LDS_BARRIER() do { asm volatile("s_waitcnt lgkmcnt(0)" ::: "memory"); __builtin_amdgcn_s_barrier(); asm volatile("" ::: "memory"); } while (0)
typedef float f32x16 __attribute__((ext_vector_type(16)));
typedef unsigned u32x2 __attribute__((ext_vector_type(2)));
typedef short s16x4 __attribute__((ext_vector_type(4)));
typedef LAS unsigned char* ldsp;
__device__ __forceinline__ float bf2f(unsigned short x) { return __uint_as_float((unsigned)x << 16); }
__device__ __forceinline__ float bflo(unsigned x) { return __uint_as_float(x << 16); }
__device__ __forceinline__ float bfhi(unsigned x) { return __uint_as_float(x & 0xffff0000u); }
__device__ __forceinline__ int crow(int r, int hi) { return (r & 3) + 8 * (r >> 2) + 4 * hi; }
__device__ __forceinline__ float wave_sum(float v) {
#pragma unroll
    for (int o = 1; o < 64; o <<= 1) v += __shfl_xor(v, o);
    return v;
}
__device__ __forceinline__ s16x4 tr_read(const LAS unsigned char* p) { return __builtin_bit_cast(s16x4, __builtin_amdgcn_ds_read_tr16_b64_v4i16((LAS s16x4*)p)); }
__device__ __forceinline__ bf16x8 cat4(s16x4 a, s16x4 b) { return (bf16x8){a[0], a[1], a[2], a[3], b[0], b[1], b[2], b[3]}; }
__device__ __forceinline__ unsigned pkbf(float lo, float hi) { unsigned r; asm("v_cvt_pk_bf16_f32 %0, %1, %2" : "=v"(r) : "v"(lo), "v"(hi)); return r; }
__device__ __forceinline__ bf16x8 pack8(float a, float b, float c, float d, float e, float f, float g, float h) { v4u w; w.x = pkbf(a, b); w.y = pkbf(c, d); w.z = pkbf(e, f); w.w = pkbf(g, h); return __builtin_bit_cast(bf16x8, w); }
__device__ __forceinline__ void lds_mma32(f32x16& acc, const LAS unsigned char* a, int sa, const LAS unsigned char* bt, int sb, int m0, int n0, int K, int lane) {
    const int r = lane & 31, h = lane >> 5;
    const LAS unsigned char* pa = a + (m0 + r) * sa + h * 16; const LAS unsigned char* pb = bt + (n0 + r) * sb + h * 16;
#pragma unroll 4
    for (int k = 0; k < K; k += 16) acc = __builtin_amdgcn_mfma_f32_32x32x16_bf16(*(const LAS bf16x8*)(pa + k * 2), *(const LAS bf16x8*)(pb + k * 2), acc, 0, 0, 0);
}

__device__ __forceinline__ const void* kin(int i) { return (const void*)((const __attribute__((address_space(4))) unsigned long long*)__builtin_amdgcn_kernarg_segment_ptr())[i]; }
struct Frame {
    ldsp lds; volatile LAS unsigned* MISC; gu32* ctl;
    int tid, lane, wave, G, bid;
    float* out; unsigned char* ws;
    __device__ __forceinline__ const float* x_prompt() const { return (const float*)kin(0); }
    __device__ __forceinline__ const float* x_sample() const { return (const float*)kin(1); }
    __device__ __forceinline__ const float* cache_ckv() const { return (const float*)kin(2); }
    __device__ __forceinline__ const float* cache_krope() const { return (const float*)kin(3); }
    __device__ __forceinline__ const int* page_table() const { return (const int*)kin(4); }
    __device__ __forceinline__ const float* state_gla() const { return (const float*)kin(5); }
    __device__ __forceinline__ const float* state_conv() const { return (const float*)kin(6); }
    __device__ __forceinline__ const float* meta() const { return (const float*)kin(7); }
    __device__ __forceinline__ const float* ln_emb_g() const { return (const float*)kin(8); }
    __device__ __forceinline__ const float* ln_emb_b() const { return (const float*)kin(9); }
    __device__ __forceinline__ const float* w_in() const { return (const float*)kin(10); }
    __device__ __forceinline__ const float* w_gate_up() const { return (const float*)kin(11); }
    __device__ __forceinline__ const float* b_gate() const { return (const float*)kin(12); }
    __device__ __forceinline__ const float* gla_norm_g() const { return (const float*)kin(13); }
    __device__ __forceinline__ const float* q_norm_g() const { return (const float*)kin(14); }
    __device__ __forceinline__ const float* kv_norm_g() const { return (const float*)kin(15); }
    __device__ __forceinline__ const float* w_uq() const { return (const float*)kin(16); }
    __device__ __forceinline__ const float* w_uk() const { return (const float*)kin(17); }
    __device__ __forceinline__ const float* w_uv() const { return (const float*)kin(18); }
    __device__ __forceinline__ const float* w_o() const { return (const float*)kin(19); }
    __device__ __forceinline__ const float* ln1_g() const { return (const float*)kin(20); }
    __device__ __forceinline__ const float* ln1_b() const { return (const float*)kin(21); }
    __device__ __forceinline__ const float* w_ffn_in() const { return (const float*)kin(22); }
    __device__ __forceinline__ const float* conv_w() const { return (const float*)kin(23); }
    __device__ __forceinline__ const float* conv_b() const { return (const float*)kin(24); }
    __device__ __forceinline__ const float* w_down() const { return (const float*)kin(25); }
    __device__ __forceinline__ const float* ln2_g() const { return (const float*)kin(26); }
    __device__ __forceinline__ const float* ln2_b() const { return (const float*)kin(27); }
    __device__ __forceinline__ bf16* Win_t() const { return (bf16*)(ws + WS_WIN); }
    __device__ __forceinline__ bf16* Wuq_t() const { return (bf16*)(ws + WS_WUQ); }
    __device__ __forceinline__ bf16* Wkv_t() const { return (bf16*)(ws + WS_WKV); }
    __device__ __forceinline__ bf16* Wo_t() const { return (bf16*)(ws + WS_WO); }
    __device__ __forceinline__ bf16* Wffn_t() const { return (bf16*)(ws + WS_WFFN); }
    __device__ __forceinline__ bf16* Wdown_t() const { return (bf16*)(ws + WS_WDOWN); }
    __device__ __forceinline__ bf16* XN() const { return (bf16*)(ws + WS_XN); }
    __device__ __forceinline__ bf16* Z() const { return (bf16*)(ws + WS_Z); }
    __device__ __forceinline__ bf16* CQN() const { return (bf16*)(ws + WS_CQN); }
    __device__ __forceinline__ bf16* CKV() const { return (bf16*)(ws + WS_CKV); }
    __device__ __forceinline__ bf16* KR() const { return (bf16*)(ws + WS_KR); }
    __device__ __forceinline__ bf16* Q() const { return (bf16*)(ws + WS_Q); }
    __device__ __forceinline__ bf16* KV() const { return (bf16*)(ws + WS_KV); }
    __device__ __forceinline__ bf16* AO() const { return (bf16*)(ws + WS_AO); }
    __device__ __forceinline__ bf16* H1() const { return (bf16*)(ws + WS_H1); }
    __device__ __forceinline__ bf16* Gb() const { return (bf16*)(ws + WS_G); }
    __device__ __forceinline__ bf16* ST() const { return (bf16*)(ws + WS_ST); }
    __device__ __forceinline__ bf16* Y1() const { return (bf16*)(ws + WS_Y1); }
    __device__ __forceinline__ bf16* Y2() const { return (bf16*)(ws + WS_Y2); }
    __device__ __forceinline__ float* ROPE_T() const { return (float*)(ws + WS_ROPE); }
    __device__ __forceinline__ bf16* KVC() const { return (bf16*)(ws + WS_KVC); }
    __device__ __forceinline__ float* DEC() const { return (float*)(ws + WS_DEC); }
    __device__ __forceinline__ float* HALO() const { return (float*)(ws + WS_HALO); }
    __device__ __forceinline__ bf16* GQA() const { return (bf16*)(ws + WS_GQA); }
    __device__ __forceinline__ bf16* SL5() const { return (bf16*)(ws + WS_SL5); }
    __device__ __forceinline__ bf16* SL9() const { return (bf16*)(ws + WS_SL9); }
};


template <bool ZMAP = false> __device__ __forceinline__ void p0_transpose_item(const float* W, int K, int N, bf16* WT, int k0, int n0, int drow0, LAS float* scr, int lane) {
    float t_[32];
#pragma unroll
    for (int i = 0; i < 32; ++i) { const int kk = 2 * i + (lane >> 5), n = ZMAP ? zsrc(n0 + (lane & 31)) : n0 + (lane & 31); t_[i] = (n >= 0 && n < N) ? W[(size_t)(k0 + kk) * N + n] : 0.f; }
#pragma unroll
    for (int i = 0; i < 32; ++i) scr[(2 * i + (lane >> 5)) * 33 + (lane & 31)] = t_[i];
    LDS_WAIT(); asm volatile("" ::: "memory");
    const int c = lane & 7;
#pragma unroll
    for (int j = 0; j < 4; ++j) { const int n = (lane >> 3) + 8 * j; const LAS float* s = scr + (8 * c) * 33 + n;
        v4u o; o.x = pk2(s[0 * 33], s[1 * 33]); o.y = pk2(s[2 * 33], s[3 * 33]); o.z = pk2(s[4 * 33], s[5 * 33]); o.w = pk2(s[6 * 33], s[7 * 33]);
        *(GAS v4u*)(WT + (size_t)(drow0 + n) * K + k0 + 8 * c) = o; }
    LDS_WAIT(); asm volatile("" ::: "memory");
}
__device__ __forceinline__ void ln_rows4_bf16(const float* x0, const float* g, const float* b, bf16* o0, int lane) {
    if (!x0) {
#pragma unroll
        for (int r = 0; r < 4; ++r) { GAS unsigned long long* o8 = (GAS unsigned long long*)(o0 + (size_t)r * DM) + lane;
#pragma unroll
            for (int j = 0; j < 4; ++j) o8[64 * j] = 0ull; }
        return; }
    f32x4 v[4][4]; float s[4], s2[4], mean[4], rstd[4];
#pragma unroll
    for (int r = 0; r < 4; ++r) { const GAS f32x4* xr = (const GAS f32x4*)(x0 + (size_t)r * DM) + lane;
#pragma unroll
        for (int j = 0; j < 4; ++j) v[r][j] = __builtin_nontemporal_load(xr + 64 * j); }
#pragma unroll
    for (int r = 0; r < 4; ++r) { s[r] = 0.f;
#pragma unroll
        for (int j = 0; j < 4; ++j) s[r] += (v[r][j].x + v[r][j].y) + (v[r][j].z + v[r][j].w); }
#pragma unroll
    for (int o = 1; o < 64; o <<= 1) {
#pragma unroll
        for (int r = 0; r < 4; ++r) s[r] += __shfl_xor(s[r], o); }
#pragma unroll
    for (int r = 0; r < 4; ++r) { mean[r] = s[r] * (1.f / DM); s2[r] = 0.f;
#pragma unroll
        for (int j = 0; j < 4; ++j) { v[r][j] = v[r][j] - mean[r]; s2[r] += (v[r][j].x * v[r][j].x + v[r][j].y * v[r][j].y) + (v[r][j].z * v[r][j].z + v[r][j].w * v[r][j].w); } }
#pragma unroll
    for (int o = 1; o < 64; o <<= 1) {
#pragma unroll
        for (int r = 0; r < 4; ++r) s2[r] += __shfl_xor(s2[r], o); }
#pragma unroll
    for (int r = 0; r < 4; ++r) rstd[r] = 1.f / sqrtf(s2[r] * (1.f / DM) + NORM_EPS);
#pragma unroll
    for (int j = 0; j < 4; ++j) { const f32x4 gg = *((const GAS f32x4*)g + lane + 64 * j), bb = *((const GAS f32x4*)b + lane + 64 * j);
#pragma unroll
        for (int r = 0; r < 4; ++r) { const f32x4 y = v[r][j] * rstd[r] * gg + bb; ((GAS unsigned long long*)(o0 + (size_t)r * DM) + lane)[64 * j] = (unsigned long long)pk2(y.x, y.y) | ((unsigned long long)pk2(y.z, y.w) << 32); } }
}
__device__ __forceinline__ void p0_prologue(Frame& F) {
    LAS float* scr = (LAS float*)(F.lds + RING_OFF + F.wave * 16384);
    const int gw = F.bid * NWAVES + F.wave, NGW = F.G * NWAVES;
    constexpr int I_IN = 16 * 72, I_UQ = 6 * 24, I_UK = 4 * 16, I_UV = 4 * 16;
    constexpr int NITEMS = I_IN + I_UQ + I_UK + I_UV;
    for (int rep0_ = 0; rep0_ < (((SUBPROBE) & 16) ? 2 : 1); ++rep0_)
    for (int it = gw; it < NITEMS; it += NGW) {
        int r = it;
        if (r < I_IN) { const int kb = r / 72, nb = r % 72; p0_transpose_item<true>(F.w_in(), DM, ZEND, F.Win_t(), 64 * kb, 32 * nb, 32 * nb, scr, F.lane); continue; } r -= I_IN;
        if (r < I_UQ) { const int kb = r / 24, nb = r % 24; p0_transpose_item(F.w_uq(), QL, QW, F.Wuq_t(), 64 * kb, 32 * nb, 32 * nb, scr, F.lane); continue; } r -= I_UQ;
        if (r < I_UK) { const int kb = r / 16, nb = r % 16; p0_transpose_item(F.w_uk(), KVL, 512, F.Wkv_t(), 64 * kb, 32 * nb, 32 * nb, scr, F.lane); continue; } r -= I_UK;
        { const int kb = r / 16, nb = r % 16; p0_transpose_item(F.w_uv(), KVL, 512, F.Wkv_t(), 64 * kb, 32 * nb, 512 + 32 * nb, scr, F.lane); }
    }
    for (int rep1_ = 0; rep1_ < (((SUBPROBE) & 32) ? 2 : 1); ++rep1_)
    for (int m = 4 * gw; m < RTOT; m += 4 * NGW) {
        const float* src = m < R_PROMPT ? F.x_prompt() + (size_t)m * DM : m < R_META0 ? F.x_sample() + (size_t)(m - R_SAMPLE0) * DM : m < R_VALID ? F.meta() + (size_t)(m - R_META0) * DM : nullptr;
        ln_rows4_bf16(src, F.ln_emb_g(), F.ln_emb_b(), F.XN() + (size_t)m * DM, F.lane);
    }
    for (int i = F.bid * NTHR + F.tid; i < (LTOT + DS) * 16; i += F.G * NTHR) { const int p = i >> 4, k = i & 15; const float pos = (float)(p < LTOT ? p : 8192 + (p - LTOT));
        const float inv = exp2f(-(float)k * (13.287712379549449f / 16.0f)); const float ang = pos * inv;
        const double tw = 6.283185307179586476925; const double n = rint((double)ang / tw); const float rr = (float)((double)ang - n * tw);
        F.ROPE_T()[p * 32 + k] = cosf(rr); F.ROPE_T()[p * 32 + 16 + k] = sinf(rr); }
}

__device__ __forceinline__ void late_transposes(Frame& F, int which, int first) {
    if (F.bid < first) return;
    LAS float* scr = (LAS float*)(F.lds + RING_OFF + F.wave * 16384);
    const int gw = (F.bid - first) * NWAVES + F.wave, NGW = (F.G - first) * NWAVES;
    constexpr int I_O = 16 * 32, I_FF = 16 * 176, I_DN = 44 * 32;
    if (which == 0) {
        for (int it = gw; it < I_O + I_FF; it += NGW) {
            if (it < I_O) { const int kb = it / 32, nb = it % 32; p0_transpose_item(F.w_o(), DM, DM, F.Wo_t(), 64 * kb, 32 * nb, 32 * nb, scr, F.lane); }
            else { const int r = it - I_O, kb = r / 176, nb = r % 176; const int n0 = 32 * nb, half = n0 >= FF ? 1 : 0, ch = n0 - half * FF;
                p0_transpose_item(F.w_ffn_in(), DM, 2 * FF, F.Wffn_t(), 64 * kb, n0, 256 * (ch >> 7) + 128 * half + (ch & 127), scr, F.lane); } }
    } else {
        for (int it = gw; it < I_DN; it += NGW) { const int kb = it / 32, nb = it % 32; p0_transpose_item(F.w_down(), FF, DM, F.Wdown_t(), 64 * kb, 32 * nb, 32 * nb, scr, F.lane); }
    }
}

__device__ __forceinline__ void p2_rows8(Frame& F, int m0) {
    const int lane = F.lane; const v4u z4 = (v4u){0u, 0u, 0u, 0u};
    v4u w[8]; float ss[8];
#pragma unroll
    for (int r = 0; r < 8; ++r) w[r] = (lane < 48) ? *(const GAS v4u*)(F.Z() + (size_t)(m0 + r) * ZC + ZCQ + 8 * lane) : z4;
#pragma unroll
    for (int r = 0; r < 8; ++r) { const float a = bflo(w[r].x), b = bfhi(w[r].x), c = bflo(w[r].y), d = bfhi(w[r].y), e = bflo(w[r].z), f = bfhi(w[r].z), g = bflo(w[r].w), h = bfhi(w[r].w);
        ss[r] = (a * a + b * b) + (c * c + d * d) + (e * e + f * f) + (g * g + h * h); }
#pragma unroll
    for (int o = 1; o < 64; o <<= 1) {
#pragma unroll
        for (int r = 0; r < 8; ++r) ss[r] += __shfl_xor(ss[r], o); }
    if (lane < 48) { const f32x4 g0 = *(const GAS f32x4*)(F.q_norm_g() + 8 * lane), g1 = *(const GAS f32x4*)(F.q_norm_g() + 8 * lane + 4);
#pragma unroll
        for (int r = 0; r < 8; ++r) { const float rs = 1.f / sqrtf(ss[r] * (1.f / QL) + NORM_EPS);
            v4u o; o.x = pk2(bflo(w[r].x) * rs * g0.x, bfhi(w[r].x) * rs * g0.y); o.y = pk2(bflo(w[r].y) * rs * g0.z, bfhi(w[r].y) * rs * g0.w); o.z = pk2(bflo(w[r].z) * rs * g1.x, bfhi(w[r].z) * rs * g1.y); o.w = pk2(bflo(w[r].w) * rs * g1.z, bfhi(w[r].w) * rs * g1.w);
            *(GAS v4u*)(F.CQN() + (size_t)(m0 + r) * QL + 8 * lane) = o; } }
}
constexpr int GL_WT = 0, GL_GM = 2048, GL_A0 = 4096;
constexpr int GL_S64 = 144, GL_T64 = 192, GL_T128 = 320;
constexpr int GL1_KD = GL_A0, GL1_V = GL1_KD + 64 * GL_T64, GL1_QM = GL1_V + 64 * GL_T128, GL1_KM = GL1_QM + 64 * GL_S64, GL1_END = GL1_KM + 64 * GL_S64;
constexpr int GL3_QD = GL_A0, GL3_ATT = GL3_QD + 64 * GL_S64, GL3_ST = GL3_ATT + 64 * GL_S64, GL3_V = GL3_ST + 128 * GL_S64, GL3_OL = GL3_V + 64 * GL_T128, GL3_END = GL3_OL + 64 * 132 * 4;
static_assert(GL3_END <= RING_BYTES && GL1_END <= RING_BYTES, "GLA LDS map");
constexpr float LOG2E = 1.4426950408889634f, LN2 = 0.6931471805599453f;
__device__ __forceinline__ float fexp(float x) { return __builtin_amdgcn_exp2f(x * LOG2E); }
__device__ __forceinline__ float logsigmoid_f(float x) { return fminf(x, 0.f) - LN2 * __builtin_amdgcn_logf(1.f + __builtin_amdgcn_exp2f(-fabsf(x) * LOG2E)); }
__device__ __forceinline__ float fsilu(float x) { return x * __builtin_amdgcn_rcpf(1.f + __builtin_amdgcn_exp2f(-x * LOG2E)); }
__device__ __forceinline__ void unpack8(v4u w, float (&v)[8]) { v[0] = bflo(w.x); v[1] = bfhi(w.x); v[2] = bflo(w.y); v[3] = bfhi(w.y); v[4] = bflo(w.z); v[5] = bfhi(w.z); v[6] = bflo(w.w); v[7] = bfhi(w.w); }
__device__ __forceinline__ bf16x8 frag_tr(const LAS unsigned char* img, int stride, int k0, int n0, int lane) {
    const int h = lane >> 5, blk = (lane >> 4) & 1, qq = (lane & 15) >> 2, pp = lane & 3;
    const LAS unsigned char* p = img + (k0 + 8 * h + qq) * stride + (n0 + 16 * blk + 4 * pp) * 2;
    return cat4(tr_read(p), tr_read(p + 4 * stride));
}
__device__ __forceinline__ void gla_stage_wg(Frame& F) {
    LAS float* WG = (LAS float*)(F.lds + WG_OFF);
    for (int i = F.tid; i < 16 * 256 / 4; i += NTHR) *(LAS f32x4*)(WG + 4 * i) = *(const GAS f32x4*)(F.w_gate_up() + 4 * i);
    if (F.tid < 64) *(LAS f32x4*)(WG + 4096 + 4 * F.tid) = *(const GAS f32x4*)(F.b_gate() + 4 * F.tid);
}
struct GlaGeom { int row0, nvalid, h, mid; };
__device__ __forceinline__ GlaGeom gla_unit_geom(int unit) { GlaGeom g;
    if (unit < 2048) { const int bh = unit >> 5, c = unit & 31; g.row0 = (bh >> 2) * SEQ + 64 * c; g.h = bh & 3; g.nvalid = 64; g.mid = 32; } else { g.row0 = R_META0; g.h = unit - 2048; g.nvalid = NMETA; g.mid = 8; }
    return g; }
__device__ __forceinline__ void gla_decay(Frame& F, ldsp L, v4u a0, v4u a1, GlaGeom gm, float (&b)[8], float (&bm)[8], float (&bl)[8]) {
    const int tid = F.tid, lane = F.lane, wave = F.wave, i = tid >> 3, c = tid & 7;
    const LAS float* WG = (const LAS float*)(F.lds + WG_OFF) + 64 * gm.h + 8 * c;
    LAS float* WT = (LAS float*)(L + GL_WT); LAS float* GM = (LAS float*)(L + GL_GM);
    float al[16]; { float t0[8], t1[8]; unpack8(a0, t0); unpack8(a1, t1);
#pragma unroll
        for (int r = 0; r < 8; ++r) { al[r] = t0[r]; al[8 + r] = t1[r]; } }
    { const f32x4 g0 = *(const LAS f32x4*)(WG + 4096), g1 = *(const LAS f32x4*)(WG + 4096 + 4); b[0] = g0.x; b[1] = g0.y; b[2] = g0.z; b[3] = g0.w; b[4] = g1.x; b[5] = g1.y; b[6] = g1.z; b[7] = g1.w; }
#pragma unroll
    for (int r = 0; r < 16; ++r) { if ((r & 3) == 0) __builtin_amdgcn_sched_barrier(0);
        const f32x4 w0 = *(const LAS f32x4*)(WG + 256 * r), w1 = *(const LAS f32x4*)(WG + 256 * r + 4);
        b[0] += al[r] * w0.x; b[1] += al[r] * w0.y; b[2] += al[r] * w0.z; b[3] += al[r] * w0.w; b[4] += al[r] * w1.x; b[5] += al[r] * w1.y; b[6] += al[r] * w1.z; b[7] += al[r] * w1.w; }
    const bool live = i < gm.nvalid;
#pragma unroll
    for (int j = 0; j < 8; ++j) b[j] = live ? logsigmoid_f(b[j]) * (1.f / 16.f) : 0.f;
#pragma unroll
    for (int off = 8; off < 64; off <<= 1) {
#pragma unroll
        for (int j = 0; j < 8; ++j) { const float t = __shfl_up(b[j], off); b[j] += (lane >= off) ? t : 0.f; } }
    if ((lane >> 3) == 7) { *(LAS f32x4*)(WT + wave * 64 + 8 * c) = (f32x4){b[0], b[1], b[2], b[3]}; *(LAS f32x4*)(WT + wave * 64 + 8 * c + 4) = (f32x4){b[4], b[5], b[6], b[7]}; }
    if (i == gm.mid) { *(LAS f32x4*)(GM + 8 * c) = (f32x4){b[0], b[1], b[2], b[3]}; *(LAS f32x4*)(GM + 8 * c + 4) = (f32x4){b[4], b[5], b[6], b[7]}; }
    LDS_BARRIER();
    const int wm = gm.mid >> 3;
    float pre[8];
#pragma unroll
    for (int j = 0; j < 8; ++j) { pre[j] = 0.f; bm[j] = 0.f; bl[j] = 0.f; }
#pragma unroll
    for (int w = 0; w < 8; ++w) { const f32x4 t0 = *(const LAS f32x4*)(WT + w * 64 + 8 * c), t1 = *(const LAS f32x4*)(WT + w * 64 + 8 * c + 4);
        const float t[8] = {t0.x, t0.y, t0.z, t0.w, t1.x, t1.y, t1.z, t1.w};
#pragma unroll
        for (int j = 0; j < 8; ++j) { pre[j] += (w < wave) ? t[j] : 0.f; bm[j] += (w < wm) ? t[j] : 0.f; bl[j] += t[j]; } }
    { const f32x4 t0 = *(const LAS f32x4*)(GM + 8 * c), t1 = *(const LAS f32x4*)(GM + 8 * c + 4);
      bm[0] += t0.x; bm[1] += t0.y; bm[2] += t0.z; bm[3] += t0.w; bm[4] += t1.x; bm[5] += t1.y; bm[6] += t1.z; bm[7] += t1.w; }
#pragma unroll
    for (int j = 0; j < 8; ++j) b[j] += pre[j];
}
struct Gla1Regs { v4u a0, a1, q8, k8, v0, v1; };
__device__ __forceinline__ Gla1Regs gla1_load(Frame& F, int unit) { Gla1Regs r; const v4u z4 = (v4u){0u, 0u, 0u, 0u}; r.a0 = z4; r.a1 = z4; r.q8 = z4; r.k8 = z4; r.v0 = z4; r.v1 = z4;
    const GlaGeom gm = gla_unit_geom(unit); const int i = F.tid >> 3, c = F.tid & 7;
    if (i < gm.nvalid) { const bf16* zr = F.Z() + (size_t)(gm.row0 + i) * ZC; r.a0 = *(const GAS v4u*)(zr + ZA); r.a1 = *(const GAS v4u*)(zr + ZA + 8); r.q8 = *(const GAS v4u*)(zr + ZQ + 64 * gm.h + 8 * c); r.k8 = *(const GAS v4u*)(zr + ZK + 64 * gm.h + 8 * c);
        r.v0 = *(const GAS v4u*)(zr + ZV + 128 * gm.h + 16 * c); r.v1 = *(const GAS v4u*)(zr + ZV + 128 * gm.h + 16 * c + 8); }
    return r; }
__device__ __forceinline__ void gla_pass1_units(Frame& F, ldsp L, int base, int per, int extra) {
    const int nun = per + (extra >= 0 ? 1 : 0); if (nun <= 0) return;
#define GL1_UNIT(n) ((n) < per ? base + (n) : extra)
    const int wave = F.wave;
    Gla1Regs nx = gla1_load(F, GL1_UNIT(0));
    for (int n = 0; n < nun; ++n) { const int unit = GL1_UNIT(n);
        int tid = F.tid; asm volatile("" : "+v"(tid));
        const int lane = tid & 63, i = tid >> 3, c = tid & 7;
        const Gla1Regs cu = nx; const GlaGeom gm = gla_unit_geom(unit);
        float b[8], bm[8], bl[8]; gla_decay(F, L, cu.a0, cu.a1, gm, b, bm, bl);
        __builtin_amdgcn_sched_barrier(0);
        { float q[8], k[8], qd[8], qm[8], km[8], kd[8]; unpack8(cu.q8, q); unpack8(cu.k8, k);
#pragma unroll
          for (int j = 0; j < 8; ++j) { const float qs = q[j] * 0.125f; qd[j] = qs * fexp(b[j]); qm[j] = qs * fexp(b[j] - bm[j]); km[j] = k[j] * fexp(bm[j] - b[j]); kd[j] = k[j] * fexp(bl[j] - b[j]); }
          *(LAS bf16x8*)(L + GL1_KD + i * GL_T64 + 16 * c) = pack8(kd[0], kd[1], kd[2], kd[3], kd[4], kd[5], kd[6], kd[7]);
          *(LAS bf16x8*)(L + GL1_QM + i * GL_S64 + 16 * c) = pack8(qm[0], qm[1], qm[2], qm[3], qm[4], qm[5], qm[6], qm[7]);
          *(LAS bf16x8*)(L + GL1_KM + i * GL_S64 + 16 * c) = pack8(km[0], km[1], km[2], km[3], km[4], km[5], km[6], km[7]);
          *(LAS v4u*)(L + GL1_V + i * GL_T128 + 32 * c) = cu.v0; *(LAS v4u*)(L + GL1_V + i * GL_T128 + 32 * c + 16) = cu.v1;
          *(GAS bf16x8*)(F.GQA() + (size_t)unit * 8192 + i * 64 + 8 * c) = pack8(qd[0], qd[1], qd[2], qd[3], qd[4], qd[5], qd[6], qd[7]);
          if (tid < 8) { float* dp = F.DEC() + (size_t)unit * 64 + 8 * c; *(GAS f32x4*)dp = (f32x4){fexp(bl[0]), fexp(bl[1]), fexp(bl[2]), fexp(bl[3])}; *(GAS f32x4*)(dp + 4) = (f32x4){fexp(bl[4]), fexp(bl[5]), fexp(bl[6]), fexp(bl[7])}; } }
        __builtin_amdgcn_sched_barrier(0);
        if (n + 1 < nun) nx = gla1_load(F, GL1_UNIT(n + 1));
        LDS_BARRIER();
        { f32x16 acc = {}; const int m0 = 32 * (wave >> 1), n0 = 32 * (wave & 1);
#pragma unroll
          for (int k0 = 0; k0 < 64; k0 += 16) acc = __builtin_amdgcn_mfma_f32_32x32x16_bf16(frag_tr(L + GL1_V, GL_T128, k0, m0, lane), frag_tr(L + GL1_KD, GL_T64, k0, n0, lane), acc, 0, 0, 0);
          bf16* dst = F.KVC() + (size_t)unit * 8192 + n0 + (lane & 31);
#pragma unroll
          for (int r = 0; r < 16; ++r) dst[(m0 + crow(r, lane >> 5)) * 64] = (bf16)f2bf(acc[r]); }
        if (wave < 4) { f32x16 at = {}; const int m0 = 32 * (wave >> 1), n0 = 32 * (wave & 1);
            if (!(m0 == 0 && n0 == 32)) lds_mma32(at, L + GL1_QM, GL_S64, L + GL1_KM, GL_S64, m0, n0, 64, lane);
            const int j = n0 + (lane & 31); bf16* ap = F.GQA() + (size_t)unit * 8192 + 4096 + j;
#pragma unroll
            for (int r = 0; r < 16; ++r) { const int ii = m0 + crow(r, lane >> 5); ap[ii * 64] = (bf16)f2bf(j <= ii ? at[r] : 0.f); } }
    }
#undef GL1_UNIT
    __syncthreads();
}
__device__ __forceinline__ void gla_pass2(Frame& F) {
    for (int it = F.bid * NTHR + F.tid; it < 64 * 2048; it += F.G * NTHR) {
        const int bh = it >> 11, q = it & 2047, e = q >> 4, d0 = (q & 15) * 4, h = bh & 3, b = bh >> 2;
        f32x4 S; { const u32x2 w0 = *(const GAS u32x2*)(F.KVC() + (size_t)(2048 + h) * 8192 + e * 64 + d0); S = (f32x4){bflo(w0.x), bfhi(w0.x), bflo(w0.y), bfhi(w0.y)}; }
        for (int c = 0; c < 32; ++c) { const size_t u = (size_t)bh * 32 + c;
            const u32x2 kw = *(const GAS u32x2*)(F.KVC() + u * 8192 + e * 64 + d0); const f32x4 kv = (f32x4){bflo(kw.x), bfhi(kw.x), bflo(kw.y), bfhi(kw.y)}, dc = *(const GAS f32x4*)(F.DEC() + u * 64 + d0);
            u32x2 w; w.x = pk2(S.x, S.y); w.y = pk2(S.z, S.w); *(GAS u32x2*)(F.ST() + u * 8192 + e * 64 + d0) = w;
            S = dc * S + kv; }
        float* o = F.out + O_GLAP + ((size_t)(b * 4 + h) * 64 + d0) * 128 + e; o[0] = S.x; o[128] = S.y; o[256] = S.z; o[384] = S.w;
    }
}
__device__ __forceinline__ void gla_norm_gate_store(Frame& F, const LAS float* OL, int row0, int nvalid, int h, v4u g0, v4u g1) {
    const int i = F.tid >> 3, seg = F.tid & 7; const LAS float* o = OL + i * 132 + 16 * seg;
    float v[16]; float ss = 0.f;
#pragma unroll
    for (int j4 = 0; j4 < 4; ++j4) { const f32x4 t = *(const LAS f32x4*)(o + 4 * j4); v[4 * j4] = t.x; v[4 * j4 + 1] = t.y; v[4 * j4 + 2] = t.z; v[4 * j4 + 3] = t.w; ss += (t.x * t.x + t.y * t.y) + (t.z * t.z + t.w * t.w); }
    ss += __shfl_xor(ss, 1); ss += __shfl_xor(ss, 2); ss += __shfl_xor(ss, 4);
    const float rs = 1.f / sqrtf(ss * (1.f / 128.f) + NORM_EPS);
    if (i < nvalid) { const size_t row = (size_t)(row0 + i);
        float ga[8], gb[8]; unpack8(g0, ga); unpack8(g1, gb);
        float y[16];
#pragma unroll
        for (int j4 = 0; j4 < 4; ++j4) { const f32x4 gn = *(const GAS f32x4*)(F.gla_norm_g() + 16 * seg + 4 * j4);
#pragma unroll
            for (int j = 0; j < 4; ++j) { const int jj = 4 * j4 + j; const float x = jj < 8 ? ga[jj & 7] : gb[jj & 7]; y[jj] = v[jj] * rs * gn[j] * fsilu(x); } }
        v4u a, b2; a.x = pk2(y[0], y[1]); a.y = pk2(y[2], y[3]); a.z = pk2(y[4], y[5]); a.w = pk2(y[6], y[7]); b2.x = pk2(y[8], y[9]); b2.y = pk2(y[10], y[11]); b2.z = pk2(y[12], y[13]); b2.w = pk2(y[14], y[15]);
        *(GAS v4u*)(F.AO() + row * DM + h * 128 + 16 * seg) = a; *(GAS v4u*)(F.AO() + row * DM + h * 128 + 16 * seg + 8) = b2; }
}
struct Gla3Regs { v4u qd, at, v0, v1, g0, g1, s0, s1; };
__device__ __forceinline__ Gla3Regs gla3_load(Frame& F, int unit) { Gla3Regs r; const v4u z4 = (v4u){0u, 0u, 0u, 0u}; r.v0 = z4; r.v1 = z4; r.g0 = z4; r.g1 = z4; r.s0 = z4; r.s1 = z4;
    const GlaGeom gm = gla_unit_geom(unit); const int i = F.tid >> 3, c = F.tid & 7;
    { const bf16* gq = F.GQA() + (size_t)unit * 8192 + F.tid * 8; r.qd = *(const GAS v4u*)gq; r.at = *(const GAS v4u*)(gq + 4096); }
    if (i < gm.nvalid) { const bf16* zr = F.Z() + (size_t)(gm.row0 + i) * ZC;
        r.v0 = *(const GAS v4u*)(zr + ZV + 128 * gm.h + 16 * c); r.v1 = *(const GAS v4u*)(zr + ZV + 128 * gm.h + 16 * c + 8); r.g0 = *(const GAS v4u*)(zr + ZG + 128 * gm.h + 16 * c); r.g1 = *(const GAS v4u*)(zr + ZG + 128 * gm.h + 16 * c + 8); }
    if (unit < 2048) { const bf16* st = F.ST() + (size_t)unit * 8192 + F.tid * 8; r.s0 = *(const GAS v4u*)st; r.s1 = *(const GAS v4u*)(st + 4096); }
    return r; }
__device__ __forceinline__ void gla_pass3_units(Frame& F, ldsp L, int u0, int u1) {
    if (u0 >= u1) return;
    int tid = F.tid; asm volatile("" : "+v"(tid));
    const int lane = tid & 63, wave = F.wave, i = tid >> 3, c = tid & 7;
    Gla3Regs nx = gla3_load(F, u0);
    for (int unit = u0; unit < u1; ++unit) {
        const Gla3Regs cu = nx; const GlaGeom gm = gla_unit_geom(unit); const bool has_state = unit < 2048;
        *(LAS v4u*)(L + GL3_QD + i * GL_S64 + 16 * c) = cu.qd; *(LAS v4u*)(L + GL3_ATT + i * GL_S64 + 16 * c) = cu.at;
        *(LAS v4u*)(L + GL3_V + i * GL_T128 + 32 * c) = cu.v0; *(LAS v4u*)(L + GL3_V + i * GL_T128 + 32 * c + 16) = cu.v1;
        if (has_state) { *(LAS v4u*)(L + GL3_ST + i * GL_S64 + 16 * c) = cu.s0; *(LAS v4u*)(L + GL3_ST + (64 + i) * GL_S64 + 16 * c) = cu.s1; }
        if (unit + 1 < u1) nx = gla3_load(F, unit + 1);
        LDS_BARRIER();
        f32x16 acc = {}; const int m0 = 32 * (wave >> 2), n0 = 32 * (wave & 3);
        if (has_state) lds_mma32(acc, L + GL3_QD, GL_S64, L + GL3_ST, GL_S64, m0, n0, 64, lane);
        { const int r = lane & 31, hh = lane >> 5; const LAS unsigned char* pa = L + GL3_ATT + (m0 + r) * GL_S64 + hh * 16;
#pragma unroll
          for (int k0 = 0; k0 < 64; k0 += 16) acc = __builtin_amdgcn_mfma_f32_32x32x16_bf16(*(const LAS bf16x8*)(pa + k0 * 2), frag_tr(L + GL3_V, GL_T128, k0, n0, lane), acc, 0, 0, 0); }
        { LAS float* OL = (LAS float*)(L + GL3_OL);
#pragma unroll
          for (int r = 0; r < 16; ++r) OL[(m0 + crow(r, lane >> 5)) * 132 + n0 + (lane & 31)] = acc[r]; }
        LDS_BARRIER();
        gla_norm_gate_store(F, (const LAS float*)(L + GL3_OL), gm.row0, gm.nvalid, gm.h, cu.g0, cu.g1);
    }
    __syncthreads();
}
constexpr int GS_G = 0, GS_QD = 1024, GS_KD = 2048, GS_DEC = 3072, GS_ATT = 3328, GS_V = 3584, GS_Q = 5632, GS_K = 6656, GS_PART = 8192, GS_OL = 16384;
__device__ __forceinline__ void gla_sample_unit(Frame& F, ldsp L, int unit) {
    const int tid = F.tid, sb = unit >> 2, h = unit & 3, row0 = R_SAMPLE0 + 4 * sb;
    LAS float* G4 = (LAS float*)(L + GS_G); LAS float* QD = (LAS float*)(L + GS_QD); LAS float* KD = (LAS float*)(L + GS_KD); LAS float* DEC = (LAS float*)(L + GS_DEC); LAS float* ATT = (LAS float*)(L + GS_ATT);
    LAS float* V4 = (LAS float*)(L + GS_V); LAS float* Q4 = (LAS float*)(L + GS_Q); LAS float* K4 = (LAS float*)(L + GS_K); LAS float* PART = (LAS float*)(L + GS_PART); LAS float* OL = (LAS float*)(L + GS_OL);
    const int e = tid & 127, dg = tid >> 7;
    float S[16];
    { const float* sp = F.state_gla() + ((size_t)(sb * 4 + h) * 64 + 16 * dg) * 128 + e;
#pragma unroll
      for (int dd = 0; dd < 16; ++dd) S[dd] = sp[dd * 128]; }
    v4u g0 = (v4u){0u, 0u, 0u, 0u}, g1 = g0;
    if ((tid >> 3) < 4) { const bf16* zr = F.Z() + (size_t)(row0 + (tid >> 3)) * ZC + ZG + 128 * h + 16 * (tid & 7); g0 = *(const GAS v4u*)zr; g1 = *(const GAS v4u*)(zr + 8); }
    if (tid < 256) { const int t = tid >> 6, d = tid & 63; const bf16* z = F.Z() + (size_t)(row0 + t) * ZC; float x = F.b_gate()[h * 64 + d];
#pragma unroll
        for (int r = 0; r < 16; ++r) x += bf2f(z[ZA + r]) * F.w_gate_up()[r * 256 + h * 64 + d];
        G4[t * 64 + d] = logsigmoid_f(x) * (1.f / 16.f); Q4[t * 64 + d] = bf2f(z[ZQ + h * 64 + d]) * 0.125f; K4[t * 64 + d] = bf2f(z[ZK + h * 64 + d]); }
    { const int t = tid >> 7; V4[t * 128 + e] = bf2f(F.Z()[(size_t)(row0 + t) * ZC + ZV + h * 128 + e]); }
    __syncthreads();
    if (tid < 64) { const int d = tid; float b[4]; float run = 0.f;
#pragma unroll
        for (int t = 0; t < 4; ++t) { run += G4[t * 64 + d]; b[t] = run; }
        const float bm = b[2], bl = b[3];
#pragma unroll
        for (int t = 0; t < 4; ++t) { const float q = Q4[t * 64 + d], k = K4[t * 64 + d]; QD[t * 64 + d] = q * fexp(b[t]); KD[t * 64 + d] = k * fexp(bl - b[t]); Q4[t * 64 + d] = q * fexp(b[t] - bm); K4[t * 64 + d] = k * fexp(bm - b[t]); }
        DEC[d] = fexp(bl); }
    __syncthreads();
    if (tid < 16) { const int t = tid >> 2, j = tid & 3; float a = 0.f;
        for (int d = 0; d < 64; ++d) a += Q4[t * 64 + d] * K4[j * 64 + d];
        ATT[tid] = (j <= t) ? a : 0.f; }
    float po[4] = {0.f, 0.f, 0.f, 0.f};
#pragma unroll
    for (int dd = 0; dd < 16; ++dd) { const int d = 16 * dg + dd;
#pragma unroll
        for (int t = 0; t < 4; ++t) po[t] += QD[t * 64 + d] * S[dd]; }
#pragma unroll
    for (int t = 0; t < 4; ++t) PART[(dg * 4 + t) * 128 + e] = po[t];
    { float* op = F.out + O_GLAS + ((size_t)(sb * 4 + h) * 64 + 16 * dg) * 128 + e;
#pragma unroll
      for (int dd = 0; dd < 16; ++dd) { const int d = 16 * dg + dd; float s = S[dd] * DEC[d];
#pragma unroll
          for (int j = 0; j < 4; ++j) s += KD[j * 64 + d] * V4[j * 128 + e];
          op[dd * 128] = s; } }
    __syncthreads();
    { const int t = tid >> 7; float o = PART[(0 * 4 + t) * 128 + e] + PART[(1 * 4 + t) * 128 + e] + PART[(2 * 4 + t) * 128 + e] + PART[(3 * 4 + t) * 128 + e];
#pragma unroll
      for (int j = 0; j < 4; ++j) o += ATT[t * 4 + j] * V4[j * 128 + e];
      OL[t * 132 + e] = o; }
    __syncthreads();
    gla_norm_gate_store(F, OL, row0, 4, h, g0, g1);
    __syncthreads();
}
constexpr int AT_KS = 208, AT_VS = 192;
constexpr int AT_K0 = 0, AT_KB = 64 * AT_KS, AT_V0 = 2 * AT_KB, AT_VB = 64 * AT_VS, AT_F = AT_V0 + 3 * AT_VB, AT_END = AT_F + 8 * 128;
static_assert(AT_END <= RING_BYTES, "attention LDS map");
__device__ __forceinline__ void attn_prompt_unit(Frame& F, ldsp L, int qrow0, int kvrow0, int qb, int h) {
    int tid = F.tid; asm volatile("" : "+v"(tid));
    const int lane = tid & 63, wave = F.wave, r32 = lane & 31, hi = lane >> 5;
    const bool metau = qb < 0; const int NT = metau ? 1 : 4 * qb + 5;
    const int qi = (metau ? 0 : 256 * qb) + 32 * wave + r32;
    const int ridx = metau ? qi : NMETA + qi;
    const int qi0w = (metau ? 0 : 256 * qb) + 32 * wave + 31;
    bf16x8 qf[6];
    { const bf16* qp = F.Q() + (size_t)(qrow0 + 32 * wave + r32) * QW + 96 * h + 8 * hi; v4u raw[6];
#pragma unroll
      for (int s = 0; s < 6; ++s) raw[s] = *(const GAS v4u*)(qp + 16 * s);
#pragma unroll
      for (int s = 0; s < 4; ++s) qf[s] = pack8(bflo(raw[s].x) * ATT_SC, bfhi(raw[s].x) * ATT_SC, bflo(raw[s].y) * ATT_SC, bfhi(raw[s].y) * ATT_SC, bflo(raw[s].z) * ATT_SC, bfhi(raw[s].z) * ATT_SC, bflo(raw[s].w) * ATT_SC, bfhi(raw[s].w) * ATT_SC);
      const float* rt_ = F.ROPE_T() + ridx * 32 + 8 * hi; const f32x4 c0 = *(const GAS f32x4*)rt_, c1 = *(const GAS f32x4*)(rt_ + 4), s0 = *(const GAS f32x4*)(rt_ + 16), s1 = *(const GAS f32x4*)(rt_ + 20);
      float x1[8], x2[8], cs[8], sn[8], y1[8], y2[8];
      x1[0] = bflo(raw[4].x); x1[1] = bfhi(raw[4].x); x1[2] = bflo(raw[4].y); x1[3] = bfhi(raw[4].y); x1[4] = bflo(raw[4].z); x1[5] = bfhi(raw[4].z); x1[6] = bflo(raw[4].w); x1[7] = bfhi(raw[4].w);
      x2[0] = bflo(raw[5].x); x2[1] = bfhi(raw[5].x); x2[2] = bflo(raw[5].y); x2[3] = bfhi(raw[5].y); x2[4] = bflo(raw[5].z); x2[5] = bfhi(raw[5].z); x2[6] = bflo(raw[5].w); x2[7] = bfhi(raw[5].w);
      cs[0] = c0.x; cs[1] = c0.y; cs[2] = c0.z; cs[3] = c0.w; cs[4] = c1.x; cs[5] = c1.y; cs[6] = c1.z; cs[7] = c1.w; sn[0] = s0.x; sn[1] = s0.y; sn[2] = s0.z; sn[3] = s0.w; sn[4] = s1.x; sn[5] = s1.y; sn[6] = s1.z; sn[7] = s1.w;
#pragma unroll
      for (int j = 0; j < 8; ++j) { y1[j] = (x1[j] * cs[j] - x2[j] * sn[j]) * ATT_SC; y2[j] = (x2[j] * cs[j] + x1[j] * sn[j]) * ATT_SC; }
      qf[4] = pack8(y1[0], y1[1], y1[2], y1[3], y1[4], y1[5], y1[6], y1[7]); qf[5] = pack8(y2[0], y2[1], y2[2], y2[3], y2[4], y2[5], y2[6], y2[7]); }
    const int srow = tid >> 3, sch = tid & 7, rrow = tid >> 2, rch = tid & 3;
    v4u knA, vvA, krA = (v4u){0u, 0u, 0u, 0u}, knB, vvB, krB = (v4u){0u, 0u, 0u, 0u};
#define AT_LOAD(S, t) do { const int tt_ = (t) < NT ? (t) : NT - 1; const size_t rb_ = (size_t)(tt_ == 0 ? R_META0 : kvrow0 + 64 * (tt_ - 1));     \
        kn##S = *(const GAS v4u*)(F.KV() + (rb_ + srow) * 1024 + 64 * h + 8 * sch); vv##S = *(const GAS v4u*)(F.KV() + (rb_ + srow) * 1024 + 512 + 64 * h + 8 * sch); \
        if (tid < 256) kr##S = *(const GAS v4u*)(F.KR() + (rb_ + rrow) * ROPE + 8 * rch); } while (0)
#define AT_STORE(S, kbuf, vboff) do { *(LAS v4u*)(L + AT_K0 + (kbuf) * AT_KB + srow * AT_KS + 16 * sch) = kn##S; *(LAS v4u*)(L + AT_V0 + (vboff) + srow * AT_VS + 16 * sch) = vv##S; \
        if (tid < 256) *(LAS v4u*)(L + AT_K0 + (kbuf) * AT_KB + rrow * AT_KS + 128 + 16 * rch) = kr##S; } while (0)
    LAS float* FS = (LAS float*)(L + AT_F + wave * 128);
    float m = 0.f, l = 0.f; f32x16 o0 = {}, o1 = {}, negm = {};
    const int qq = (lane & 15) >> 2, pp = lane & 3, blk = (lane >> 4) & 1;
    const int vlane = (4 * hi + qq) * AT_VS + (16 * blk + 4 * pp) * 2;
    const int klane = r32 * AT_KS + 16 * hi;
#define AT_SBAR() __builtin_amdgcn_sched_barrier(0)
#define AT_PIN(x) asm volatile("" : "+v"(x))
#define AT_KF(Kb_, i) (*(const LAS bf16x8*)((Kb_) + ((i) & 1) * 32 * AT_KS + 32 * ((i) >> 1)))
#define AT_VF(Vb_, j) cat4(tr_read((Vb_) + (32 * ((j) >> 2) + 16 * (((j) >> 1) & 1)) * AT_VS + 64 * ((j) & 1)), tr_read((Vb_) + (32 * ((j) >> 2) + 16 * (((j) >> 1) & 1) + 8) * AT_VS + 64 * ((j) & 1)))
#define AT_PV(P0, P1, i) ((i) < 16 ? P0[(i) & 15] : P1[(i) & 15])
#define AT_MASK(C0, C1, t) do { if ((t) == 0) { _Pragma("unroll") for (int r = 0; r < 16; ++r) { const int key = crow(r, hi); if (key >= NMETA || (metau && key > qi)) C0[r] = -INFINITY; C1[r] = -INFINITY; } } \
        else if ((t) >= NT - 4) { const int kb0 = 64 * ((t) - 1); _Pragma("unroll") for (int r = 0; r < 16; ++r) { const int key = kb0 + crow(r, hi); if (key > qi) C0[r] = -INFINITY; if (key + 32 > qi) C1[r] = -INFINITY; } } } while (0)
#define AT_ROWMAX(C0, C1, rm) do { float a_ = __builtin_fmaxf(__builtin_fmaxf(C0[0], C0[1]), C1[0]), b_ = __builtin_fmaxf(__builtin_fmaxf(C0[2], C0[3]), C1[1]); a_ = __builtin_fmaxf(__builtin_fmaxf(a_, C1[2]), C1[3]); \
        _Pragma("unroll") for (int r = 4; r < 16; r += 4) { a_ = __builtin_fmaxf(__builtin_fmaxf(a_, C0[r]), C0[r + 1]); b_ = __builtin_fmaxf(__builtin_fmaxf(b_, C0[r + 2]), C0[r + 3]); a_ = __builtin_fmaxf(__builtin_fmaxf(a_, C1[r]), C1[r + 1]); b_ = __builtin_fmaxf(__builtin_fmaxf(b_, C1[r + 2]), C1[r + 3]); } \
        rm = __builtin_fmaxf(a_, b_); { auto rr_ = __builtin_amdgcn_permlane32_swap(__float_as_uint(rm), __float_as_uint(rm), false, false); rm = __builtin_fmaxf(__uint_as_float(rr_[0]), __uint_as_float(rr_[1])); } } while (0)
    f32x16 pA0, pA1, pB0, pB1; v4u pw[4]; bool resc = false;
    int vprev = 0, vcur = 0, vnext = AT_VB;
#define AT_ROT() do { vprev = vcur; vcur = vnext; vnext = (vnext == 2 * AT_VB) ? 0 : vnext + AT_VB; } while (0)
    AT_LOAD(A, 0); AT_STORE(A, 0, 0); AT_LOAD(A, 1); AT_LOAD(B, 2); LDS_BARRIER();
    { const LAS unsigned char* Kb = L + AT_K0 + klane;
      pA0 = negm; pA1 = negm;
#pragma unroll
      for (int i = 0; i < 12; ++i) { if (i & 1) pA1 = __builtin_amdgcn_mfma_f32_32x32x16_bf16(AT_KF(Kb, i), qf[i >> 1], pA1, 0, 0, 0); else pA0 = __builtin_amdgcn_mfma_f32_32x32x16_bf16(AT_KF(Kb, i), qf[i >> 1], pA0, 0, 0, 0); }
      AT_MASK(pA0, pA1, 0);
      float rm; AT_ROWMAX(pA0, pA1, rm); m = rm;
#pragma unroll
      for (int r = 0; r < 16; ++r) { pA0[r] = __builtin_amdgcn_exp2f(pA0[r] - rm); pA1[r] = __builtin_amdgcn_exp2f(pA1[r] - rm); negm[r] = -m; }
      AT_STORE(A, 1, AT_VB); LDS_BARRIER(); AT_ROT(); }
#define AT_GAPA(i, C0, C1, P0, P1) do { \
        if ((i) & 1) C1 = __builtin_amdgcn_mfma_f32_32x32x16_bf16(kf[i], qf[(i) >> 1], (i) < 2 ? negm : C1, 0, 0, 0); else C0 = __builtin_amdgcn_mfma_f32_32x32x16_bf16(kf[i], qf[(i) >> 1], (i) < 2 ? negm : C0, 0, 0, 0); \
        if ((i) + 4 < 12) kf[((i) + 4) % 12] = AT_KF(Kb, (i) + 4); \
        if ((i) < 10) { sacc += AT_PV(P0, P1, 2 + 3 * (i)); sacc += AT_PV(P0, P1, 3 + 3 * (i)); sacc += AT_PV(P0, P1, 4 + 3 * (i)); AT_PIN(sacc); } \
        if ((i) < 8) { pw[(i) >> 1][2 * ((i) & 1)] = pkbf(AT_PV(P0, P1, 4 * (i)), AT_PV(P0, P1, 4 * (i) + 1)); pw[(i) >> 1][2 * ((i) & 1) + 1] = pkbf(AT_PV(P0, P1, 4 * (i) + 2), AT_PV(P0, P1, 4 * (i) + 3)); AT_PIN(pw[(i) >> 1]); } \
        AT_SBAR(); } while (0)
#define AT_GAPB(j, C0, C1) do { \
        if ((j) & 1) o1 = __builtin_amdgcn_mfma_f32_32x32x16_bf16(__builtin_bit_cast(bf16x8, pw[(j) >> 1]), vf[j], o1, 0, 0, 0); else o0 = __builtin_amdgcn_mfma_f32_32x32x16_bf16(__builtin_bit_cast(bf16x8, pw[(j) >> 1]), vf[j], o0, 0, 0, 0); \
        if ((j) + 2 < 8) vf[(j) + 2] = AT_VF(Vb, (j) + 2); \
        if ((j) < 4) { C0[4 * (j)] = __builtin_amdgcn_exp2f(C0[4 * (j)]); C0[4 * (j) + 1] = __builtin_amdgcn_exp2f(C0[4 * (j) + 1]); C0[4 * (j) + 2] = __builtin_amdgcn_exp2f(C0[4 * (j) + 2]); C0[4 * (j) + 3] = __builtin_amdgcn_exp2f(C0[4 * (j) + 3]); AT_PIN(C0); } \
        else { C1[4 * (j) - 16] = __builtin_amdgcn_exp2f(C1[4 * (j) - 16]); C1[4 * (j) - 15] = __builtin_amdgcn_exp2f(C1[4 * (j) - 15]); C1[4 * (j) - 14] = __builtin_amdgcn_exp2f(C1[4 * (j) - 14]); C1[4 * (j) - 13] = __builtin_amdgcn_exp2f(C1[4 * (j) - 13]); AT_PIN(C1); } \
        AT_SBAR(); } while (0)
#define AT_STEP(C0, C1, P0, P1, t, LS, SS) do { AT_LOAD(LS, (t) + 2); AT_SBAR(); \
        const LAS unsigned char* Kb = L + AT_K0 + ((t) & 1) * AT_KB + klane; const LAS unsigned char* Vb = L + AT_V0 + vprev + vlane; \
        bf16x8 kf[12], vf[8]; kf[0] = AT_KF(Kb, 0); kf[1] = AT_KF(Kb, 1); kf[2] = AT_KF(Kb, 2); kf[3] = AT_KF(Kb, 3); AT_SBAR(); \
        float sacc = P0[0] + P0[1]; \
        AT_GAPA(0, C0, C1, P0, P1); AT_GAPA(1, C0, C1, P0, P1); AT_GAPA(2, C0, C1, P0, P1); AT_GAPA(3, C0, C1, P0, P1); AT_GAPA(4, C0, C1, P0, P1); AT_GAPA(5, C0, C1, P0, P1); \
        AT_GAPA(6, C0, C1, P0, P1); AT_GAPA(7, C0, C1, P0, P1); AT_GAPA(8, C0, C1, P0, P1); AT_GAPA(9, C0, C1, P0, P1); \
        vf[0] = AT_VF(Vb, 0); vf[1] = AT_VF(Vb, 1); \
        AT_GAPA(10, C0, C1, P0, P1); AT_GAPA(11, C0, C1, P0, P1); \
        l += sacc; \
        AT_MASK(C0, C1, t); \
        { float rm; AT_ROWMAX(C0, C1, rm); resc = false; \
          if (__builtin_expect(__any(rm > 8.f), 0)) { const float dl = __builtin_fmaxf(rm, 0.f); m += dl; \
              _Pragma("unroll") for (int r = 0; r < 16; ++r) { C0[r] -= dl; C1[r] -= dl; negm[r] = -m; } \
              const float f_ = __builtin_amdgcn_exp2f(-dl); l *= f_; if (hi == 0) FS[r32] = f_; resc = true; } } \
        AT_SBAR(); \
        AT_GAPB(0, C0, C1); AT_GAPB(1, C0, C1); AT_GAPB(2, C0, C1); AT_GAPB(3, C0, C1); AT_GAPB(4, C0, C1); AT_GAPB(5, C0, C1); AT_GAPB(6, C0, C1); AT_GAPB(7, C0, C1); \
        AT_STORE(SS, ((t) + 1) & 1, vnext); LDS_BARRIER(); \
        if (resc) { _Pragma("unroll") for (int g = 0; g < 4; ++g) { const f32x4 f = *(const LAS f32x4*)(FS + 8 * g + 4 * hi); _Pragma("unroll") for (int j = 0; j < 4; ++j) { o0[4 * g + j] *= f[j]; o1[4 * g + j] *= f[j]; } } } \
        AT_ROT(); } while (0)
#pragma unroll 1
    for (int t = 1; t < NT; t += 2) { AT_STEP(pB0, pB1, pA0, pA1, t, A, B); AT_STEP(pA0, pA1, pB0, pB1, t + 1, B, A); }
    { float sacc = 0.f;
#pragma unroll
      for (int r = 0; r < 16; ++r) sacc += pA0[r] + pA1[r];
      l += sacc;
      const LAS unsigned char* Vb = L + AT_V0 + vprev + vlane;
      const bf16x8 pa0 = pack8(pA0[0], pA0[1], pA0[2], pA0[3], pA0[4], pA0[5], pA0[6], pA0[7]), pa1 = pack8(pA0[8], pA0[9], pA0[10], pA0[11], pA0[12], pA0[13], pA0[14], pA0[15]);
      const bf16x8 pa2 = pack8(pA1[0], pA1[1], pA1[2], pA1[3], pA1[4], pA1[5], pA1[6], pA1[7]), pa3 = pack8(pA1[8], pA1[9], pA1[10], pA1[11], pA1[12], pA1[13], pA1[14], pA1[15]);
      o0 = __builtin_amdgcn_mfma_f32_32x32x16_bf16(pa0, AT_VF(Vb, 0), o0, 0, 0, 0); o1 = __builtin_amdgcn_mfma_f32_32x32x16_bf16(pa0, AT_VF(Vb, 1), o1, 0, 0, 0);
      o0 = __builtin_amdgcn_mfma_f32_32x32x16_bf16(pa1, AT_VF(Vb, 2), o0, 0, 0, 0); o1 = __builtin_amdgcn_mfma_f32_32x32x16_bf16(pa1, AT_VF(Vb, 3), o1, 0, 0, 0);
      o0 = __builtin_amdgcn_mfma_f32_32x32x16_bf16(pa2, AT_VF(Vb, 4), o0, 0, 0, 0); o1 = __builtin_amdgcn_mfma_f32_32x32x16_bf16(pa2, AT_VF(Vb, 5), o1, 0, 0, 0);
      o0 = __builtin_amdgcn_mfma_f32_32x32x16_bf16(pa3, AT_VF(Vb, 6), o0, 0, 0, 0); o1 = __builtin_amdgcn_mfma_f32_32x32x16_bf16(pa3, AT_VF(Vb, 7), o1, 0, 0, 0); }
#undef AT_STEP
#undef AT_GAPA
#undef AT_GAPB
#undef AT_ROT
#undef AT_ROWMAX
#undef AT_MASK
#undef AT_PV
#undef AT_VF
#undef AT_KF
#undef AT_PIN
#undef AT_SBAR
#undef AT_LOAD
#undef AT_STORE
    { const float lt = l + __shfl_xor(l, 32); if (hi == 0) FS[r32] = 1.f / lt;
      bf16* op = F.AO() + (size_t)(qrow0 + 32 * wave) * DM + 512 + 64 * h + r32;
#pragma unroll
      for (int g = 0; g < 4; ++g) { const f32x4 f = *(const LAS f32x4*)(FS + 8 * g + 4 * hi);
#pragma unroll
          for (int j = 0; j < 4; ++j) { const int row = 8 * g + 4 * hi + j; op[(size_t)row * DM] = (bf16)f2bf(o0[4 * g + j] * f[j]); op[(size_t)row * DM + 32] = (bf16)f2bf(o1[4 * g + j] * f[j]); } } }
    __syncthreads();
}

constexpr int DC_QS = 592, DC_Q = 0, DC_IMG = 19456, DC_IMGB = 2 * 16384 + 64 * 80, DC_QN = DC_IMG + 2 * DC_IMGB  , DC_PX = WG_OFF, DC_PXB = 2304, DC_F = DC_PX + 4 * DC_PXB, DC_END = DC_F + 8 * 256;
constexpr int DC_OL = DC_IMG, DC_XO = DC_IMG + DC_IMGB, DC_XM = DC_XO + 32768;
static_assert(DC_IMG + 3 * DC_IMGB <= XTRA_OFF + XTRA_BYTES && DC_END <= LDS_BYTES && 32 * 260 * 4 <= DC_IMGB && 32768 + 2 * 2 * 32 * 4 <= DC_IMGB, "decode LDS map");
__device__ __forceinline__ int dc_off(int row, int ch) { return 256 * row + 16 * (ch ^ (((row & 3) << 2) | ((row >> 2) & 3))); }
__device__ __forceinline__ bf16x8 cvt8(f32x4 a, f32x4 b) { return pack8(a.x, a.y, a.z, a.w, b.x, b.y, b.z, b.w); }
__device__ __forceinline__ void dc_scores(const LAS unsigned char* Ib, const LAS unsigned char* Qimg, LAS unsigned char* PXw, int lane, int kb, bool first, bool newt, float& m, float& l) {
    asm volatile("" : "+v"(lane));
    const int r32 = lane & 31, hi = lane >> 5, krow = 32 * kb + r32;
    const LAS unsigned char* Qb = Qimg + r32 * DC_QS + 16 * hi;
    f32x16 p = {};
#define DC_KQ(kf_, qf_, s0_) do { _Pragma("unroll") for (int j = 0; j < 3; ++j) { const int s = (s0_) + j; \
            kf_[j] = (s < 16) ? *(const LAS bf16x8*)(Ib + (s >> 3) * 16384 + dc_off(krow, 2 * (s & 7) + hi)) : *(const LAS bf16x8*)(Ib + 32768 + krow * 80 + (2 * (s - 16) + hi) * 16); \
            qf_[j] = *(const LAS bf16x8*)(Qb + 32 * s); } } while (0)
#define DC_MM(kf_, qf_) do { _Pragma("unroll") for (int j = 0; j < 3; ++j) p = __builtin_amdgcn_mfma_f32_32x32x16_bf16(kf_[j], qf_[j], p, 0, 0, 0); } while (0)
    { bf16x8 kfa[3], qfa[3], kfb[3], qfb[3], kfc[3], qfc[3];
      DC_KQ(kfa, qfa, 0); DC_KQ(kfb, qfb, 3); __builtin_amdgcn_sched_barrier(0);
      DC_KQ(kfc, qfc, 6); DC_MM(kfa, qfa); __builtin_amdgcn_sched_barrier(0);
      DC_KQ(kfa, qfa, 9); DC_MM(kfb, qfb); __builtin_amdgcn_sched_barrier(0);
      DC_KQ(kfb, qfb, 12); DC_MM(kfc, qfc); __builtin_amdgcn_sched_barrier(0);
      DC_KQ(kfc, qfc, 15); DC_MM(kfa, qfa); __builtin_amdgcn_sched_barrier(0);
      DC_MM(kfb, qfb); DC_MM(kfc, qfc); __builtin_amdgcn_sched_barrier(0); }
#undef DC_KQ
#undef DC_MM
    if (newt) { const int tq = r32 >> 3;
#pragma unroll
        for (int r = 0; r < 16; ++r) { const int key = 32 * kb + crow(r, hi); if (key >= DS || key > tq) p[r] = -INFINITY; } }
    float mxa = __builtin_fmaxf(__builtin_fmaxf(p[0], p[1]), p[2]), mxb = __builtin_fmaxf(__builtin_fmaxf(p[3], p[4]), p[5]);
    mxa = __builtin_fmaxf(__builtin_fmaxf(mxa, p[6]), p[7]); mxb = __builtin_fmaxf(__builtin_fmaxf(mxb, p[8]), p[9]); mxa = __builtin_fmaxf(__builtin_fmaxf(mxa, p[10]), p[11]); mxb = __builtin_fmaxf(__builtin_fmaxf(mxb, p[12]), p[13]);
    float mx = __builtin_fmaxf(__builtin_fmaxf(mxa, mxb), __builtin_fmaxf(p[14], p[15]));
    { auto r_ = __builtin_amdgcn_permlane32_swap(__float_as_uint(mx), __float_as_uint(mx), false, false); mx = __builtin_fmaxf(__uint_as_float(r_[0]), __uint_as_float(r_[1])); }
    const float d = mx - m, dl = first ? d : (d > 8.f ? d : 0.f);
    float alpha = 1.f;
    if (first || __any(dl != 0.f)) { m += dl; alpha = first ? 1.f : __builtin_amdgcn_exp2f(-dl); }
    float ps = 0.f;
#pragma unroll
    for (int r = 0; r < 16; ++r) { p[r] = __builtin_amdgcn_exp2f(p[r] - m); ps += p[r]; }
    l = l * alpha + ps;
    *(LAS bf16x8*)(PXw + lane * 32) = pack8(p[0], p[1], p[2], p[3], p[4], p[5], p[6], p[7]); *(LAS bf16x8*)(PXw + lane * 32 + 16) = pack8(p[8], p[9], p[10], p[11], p[12], p[13], p[14], p[15]);
    if (hi == 0) ((LAS float*)(PXw + 2048))[r32] = alpha;
    { const bool anyr = __any(alpha != 1.f); if (lane == 0) ((LAS unsigned*)(PXw + 2048 + 128))[0] = anyr ? 1u : 0u; }
}
__device__ __forceinline__ void dc_pv(const LAS unsigned char* Ib, const LAS unsigned char* PXr, int lane, int kb, int cg, f32x16& o0, f32x16& o1) {
    asm volatile("" : "+v"(lane));
    const int hi = lane >> 5, qq = (lane & 15) >> 2, pp = lane & 3, blk = (lane >> 4) & 1;
    const LAS float* AL = (const LAS float*)(PXr + 2048);
    if (__builtin_amdgcn_readfirstlane(((const LAS unsigned*)(PXr + 2048 + 128))[0])) {
#pragma unroll
        for (int g = 0; g < 4; ++g) { const f32x4 f = *(const LAS f32x4*)(AL + 8 * g + 4 * hi);
#pragma unroll
            for (int j = 0; j < 4; ++j) { o0[4 * g + j] *= f[j]; o1[4 * g + j] *= f[j]; } } }
    const bf16x8 pa0 = *(const LAS bf16x8*)(PXr + lane * 32), pa1 = *(const LAS bf16x8*)(PXr + lane * 32 + 16);
#define DC_VADDR(s, tt, cc) (Ib + ((2 * cg + (cc)) >> 2) * 16384 + dc_off(32 * kb + 16 * (s) + 8 * (tt) + 4 * hi + qq, 4 * ((2 * cg + (cc)) & 3) + 2 * blk + (pp >> 1)) + 8 * (pp & 1))
#define DC_VF(s, cc) cat4(tr_read(DC_VADDR(s, 0, cc)), tr_read(DC_VADDR(s, 1, cc)))
    o0 = __builtin_amdgcn_mfma_f32_32x32x16_bf16(pa0, DC_VF(0, 0), o0, 0, 0, 0); o1 = __builtin_amdgcn_mfma_f32_32x32x16_bf16(pa0, DC_VF(0, 1), o1, 0, 0, 0);
    o0 = __builtin_amdgcn_mfma_f32_32x32x16_bf16(pa1, DC_VF(1, 0), o0, 0, 0, 0); o1 = __builtin_amdgcn_mfma_f32_32x32x16_bf16(pa1, DC_VF(1, 1), o1, 0, 0, 0);
#undef DC_VF
#undef DC_VADDR
}
__device__ __forceinline__ void attn_decode_unit(Frame& F, ldsp L, int sb) {
    int tid = F.tid; asm volatile("" : "+v"(tid));
    const int lane = tid & 63, wave = F.wave, r32 = lane & 31, hi = lane >> 5, kb = wave & 1, cg = wave >> 1;
    const int row0 = R_SAMPLE0 + 4 * sb;
    { { const int t = tid >> 7, hh = (tid >> 4) & 7, i = tid & 15; const bf16* qp = F.Q() + (size_t)(row0 + t) * QW + 96 * hh + 64;
        const float x1 = bf2f(qp[i]), x2 = bf2f(qp[16 + i]), c = F.ROPE_T()[(LTOT + t) * 32 + i], s = F.ROPE_T()[(LTOT + t) * 32 + 16 + i];
        LAS unsigned short* qd = (LAS unsigned short*)(L + DC_Q + (t * 8 + hh) * DC_QS + 512);
        qd[i] = (unsigned short)f2bf((x1 * c - x2 * s) * ATT_SC); qd[16 + i] = (unsigned short)f2bf((x2 * c + x1 * s) * ATT_SC); }
      { const int hh = wave; bf16x8 af[4];
#pragma unroll
        for (int s = 0; s < 4; ++s) { v4u ar = *(const GAS v4u*)(F.Q() + (size_t)(row0 + (r32 & 3)) * QW + 96 * hh + 16 * s + 8 * hi); if (r32 >= DS) ar = (v4u){0u, 0u, 0u, 0u}; af[s] = __builtin_bit_cast(bf16x8, ar); }
#pragma unroll 2
        for (int cb = 0; cb < 8; ++cb) { f32x16 acc = {}; const float* wp = F.w_uk() + (size_t)(32 * cb + r32) * 512 + 64 * hh + 8 * hi;
#pragma unroll
            for (int s = 0; s < 4; ++s) acc = __builtin_amdgcn_mfma_f32_32x32x16_bf16(af[s], cvt8(*(const GAS f32x4*)(wp + 16 * s), *(const GAS f32x4*)(wp + 16 * s + 4)), acc, 0, 0, 0);
            if (hi == 0) {
#pragma unroll
                for (int t = 0; t < DS; ++t) *(LAS unsigned short*)(L + DC_Q + (t * 8 + hh) * DC_QS + 2 * (32 * cb + r32)) = (unsigned short)f2bf(acc[t] * ATT_SC); } } }
      __syncthreads(); }
    float m = 0.f, l = 0.f; f32x16 o0 = {}, o1 = {};
    constexpr int NTILE = 2 * NPAGES;
    f32x4 ckA[8], ckrA, ckB[8], ckrB;
    const int ptv = ((const GAS int*)F.page_table())[sb * NPAGES + lane];
    const unsigned gvo = (unsigned)(((tid >> 5) * KVL + 8 * (tid & 31)) * 4), gro = (unsigned)(((tid >> 3) * ROPE + 4 * (tid & 7)) * 4);
    const int lso = ((tid & 31) >> 4) * 16384 + dc_off(tid >> 5, tid & 15), lro = 32768 + (tid >> 3) * 80 + 8 * (tid & 7);
#define DC_LOAD(ck, ckr, tile) do { const int tl_ = (tile) < NTILE ? (tile) : NTILE - 1;     \
        const int pg_ = __builtin_amdgcn_readlane(ptv, tl_ >> 1); const GAS char* sc_ = (const GAS char*)(F.cache_ckv() + ((size_t)pg_ * PAGE + 64 * (tl_ & 1)) * KVL); const GAS char* sr_ = (const GAS char*)(F.cache_krope() + ((size_t)pg_ * PAGE + 64 * (tl_ & 1)) * ROPE); \
        _Pragma("unroll") for (int i_ = 0; i_ < 4; ++i_) { const GAS char* p_ = sc_ + 16384 * i_; ck[2 * i_] = *(const GAS f32x4*)(p_ + gvo); ck[2 * i_ + 1] = *(const GAS f32x4*)(p_ + gvo + 16); } \
        ckr = *(const GAS f32x4*)(sr_ + gro); } while (0)
#define DC_STORE(ck, ckr, ib_) do { \
        _Pragma("unroll") for (int i_ = 0; i_ < 4; ++i_) *(LAS bf16x8*)((ib_) + lso + 4096 * i_) = cvt8(ck[2 * i_], ck[2 * i_ + 1]); \
        { u32x2 w_; w_.x = pkbf(ckr.x, ckr.y); w_.y = pkbf(ckr.z, ckr.w); *(LAS u32x2*)((ib_) + lro) = w_; } } while (0)
#define DC_NEWKEYS(ib) do { \
            _Pragma("unroll") for (int i = 0; i < 4; ++i) { const int ix = tid + 512 * i, row = ix >> 5, ch = ix & 31; v4u w = (v4u){0u, 0u, 0u, 0u}; if (row < DS) w = *(const GAS v4u*)(F.CKV() + (size_t)(row0 + row) * KVL + 8 * ch); \
                *(LAS v4u*)((ib) + (ch >> 4) * 16384 + dc_off(row, ch & 15)) = w; } \
            if (tid < 256) { const int row = tid >> 2; v4u w = (v4u){0u, 0u, 0u, 0u}; if (row < DS) w = *(const GAS v4u*)(F.KR() + (size_t)(row0 + row) * ROPE + 8 * (tid & 3)); *(LAS v4u*)((ib) + 32768 + row * 80 + 16 * (tid & 3)) = w; } } while (0)
#define DC_ITER(t, ck, ckr, nk, nkr) do { ldsp i0_ = L + DC_IMG + b0 * DC_IMGB, im_ = L + DC_IMG + (b0 == 0 ? 2 : b0 - 1) * DC_IMGB, ip_ = L + DC_IMG + (b0 == 2 ? 0 : b0 + 1) * DC_IMGB; const int pb_ = (t) & 1; \
        if (cg == 0) dc_scores(i0_, L + DC_Q, L + DC_PX + (2 * kb + pb_) * DC_PXB, lane, kb, (t) == 0, (t) == NTILE, m, l); \
        if ((t) > 0) dc_pv(im_, L + DC_PX + (2 * kb + (pb_ ^ 1)) * DC_PXB, lane, kb, cg, o0, o1); \
        if ((t) + 1 < NTILE) DC_STORE(ck, ckr, ip_); else if ((t) + 1 == NTILE) DC_NEWKEYS(ip_); \
        DC_LOAD(ck, ckr, (t) + 3);     \
        LDS_BARRIER(); b0 = (b0 == 2) ? 0 : b0 + 1; } while (0)
    int b0 = 0;
    DC_LOAD(ckA, ckrA, 0); DC_STORE(ckA, ckrA, L + DC_IMG); DC_LOAD(ckA, ckrA, 1); DC_LOAD(ckB, ckrB, 2); LDS_BARRIER();
    for (int t = 0; t <= NTILE; t += 2) { DC_ITER(t, ckA, ckrA, ckB, ckrB); if (t + 1 <= NTILE) DC_ITER(t + 1, ckB, ckrB, ckA, ckrA); }
#undef DC_ITER
#undef DC_NEWKEYS
#undef DC_LOAD
#undef DC_STORE
    dc_pv(L + DC_IMG + (NTILE % 3) * DC_IMGB, L + DC_PX + (2 * kb + (NTILE & 1)) * DC_PXB, lane, kb, cg, o0, o1);
    __syncthreads();
    { LAS float* XO = (LAS float*)(L + DC_XO) + cg * 2048; LAS float* XM = (LAS float*)(L + DC_XM); LAS float* FS = (LAS float*)(L + DC_F + wave * 256);
      if (cg == 0) { const float lt = l + __shfl_xor(l, 32); if (hi == 0) { XM[kb * 64 + r32] = m; XM[kb * 64 + 32 + r32] = lt; } }
      __syncthreads();
      { const float m0 = XM[r32], l0 = XM[32 + r32], m1 = XM[64 + r32], l1 = XM[96 + r32], M = fmaxf(m0, m1), e0 = __builtin_amdgcn_exp2f(m0 - M), e1 = __builtin_amdgcn_exp2f(m1 - M), inv = 1.f / (l0 * e0 + l1 * e1);
        if (hi == 0) FS[r32] = (kb == 0 ? e0 : e1) * inv; }
#pragma unroll
      for (int g = 0; g < 4; ++g) { const f32x4 f = *(const LAS f32x4*)(FS + 8 * g + 4 * hi);
#pragma unroll
          for (int j = 0; j < 4; ++j) { o0[4 * g + j] *= f[j]; o1[4 * g + j] *= f[j]; } }
      if (kb == 1) {
#pragma unroll
          for (int r = 0; r < 16; ++r) { XO[r * 64 + lane] = o0[r]; XO[(16 + r) * 64 + lane] = o1[r]; } }
      __syncthreads();
      if (kb == 0) { LAS float* OL = (LAS float*)(L + DC_OL);
#pragma unroll
          for (int r = 0; r < 16; ++r) { const int q = crow(r, hi); OL[q * 260 + 64 * cg + r32] = o0[r] + XO[r * 64 + lane]; OL[q * 260 + 64 * cg + 32 + r32] = o1[r] + XO[(16 + r) * 64 + lane]; } }
      __syncthreads(); }
    { const int hh = wave; const LAS float* ol = (const LAS float*)(L + DC_OL) + ((r32 & 3) * 8 + hh) * 260 + 8 * hi; const bf16* wp = F.Wkv_t() + (size_t)(512 + 64 * hh + r32) * KVL + 8 * hi;
      f32x16 a0 = {}, a1 = {};
#pragma unroll 4
      for (int s = 0; s < KVL / 16; ++s) { bf16x8 af = cvt8(*(const LAS f32x4*)(ol + 16 * s), *(const LAS f32x4*)(ol + 16 * s + 4)); if (r32 >= DS) af = (bf16x8){0, 0, 0, 0, 0, 0, 0, 0};
          a0 = __builtin_amdgcn_mfma_f32_32x32x16_bf16(af, *(const GAS bf16x8*)(wp + 16 * s), a0, 0, 0, 0);
          a1 = __builtin_amdgcn_mfma_f32_32x32x16_bf16(af, *(const GAS bf16x8*)(wp + (size_t)32 * KVL + 16 * s), a1, 0, 0, 0); }
      if (hi == 0) {
#pragma unroll
          for (int t = 0; t < DS; ++t) { bf16* op = F.AO() + (size_t)(row0 + t) * DM + 512 + 64 * hh + r32; op[0] = (bf16)f2bf(a0[t]); op[32] = (bf16)f2bf(a1[t]); } } }
    __syncthreads();
}
__device__ __forceinline__ void ln_load_bf16(const bf16* row, int lane, float (&v)[16]) {
    const v4u a = *(const GAS v4u*)(row + 8 * lane), b = *(const GAS v4u*)(row + 512 + 8 * lane);
    v[0] = bflo(a.x); v[1] = bfhi(a.x); v[2] = bflo(a.y); v[3] = bfhi(a.y); v[4] = bflo(a.z); v[5] = bfhi(a.z); v[6] = bflo(a.w); v[7] = bfhi(a.w);
    v[8] = bflo(b.x); v[9] = bfhi(b.x); v[10] = bflo(b.y); v[11] = bfhi(b.y); v[12] = bflo(b.z); v[13] = bfhi(b.z); v[14] = bflo(b.w); v[15] = bfhi(b.w);
}
__device__ __forceinline__ void ln_load_slabs(const bf16* srow, size_t sst, int ns, const bf16* res, float alpha, int lane, float (&v)[16]) {
    ln_load_bf16(res, lane, v);
#pragma unroll
    for (int j = 0; j < 16; ++j) v[j] *= alpha;
#pragma unroll 1
    for (int s = 0; s < ns; ++s) { float t[16]; ln_load_bf16(srow + (size_t)s * sst, lane, t);
#pragma unroll
        for (int j = 0; j < 16; ++j) v[j] += t[j]; }
}
__device__ __forceinline__ void ln_norm(float (&v)[16], const float* g, const float* b, int lane) {
    float s = 0.f;
#pragma unroll
    for (int j = 0; j < 16; ++j) s += v[j];
    const float mean = wave_sum(s) * (1.f / DM); float s2 = 0.f;
#pragma unroll
    for (int j = 0; j < 16; ++j) { v[j] -= mean; s2 += v[j] * v[j]; }
    const float rstd = 1.f / sqrtf(wave_sum(s2) * (1.f / DM) + NORM_EPS);
    const f32x4 g0 = *(const GAS f32x4*)(g + 8 * lane), g1 = *(const GAS f32x4*)(g + 8 * lane + 4), g2 = *(const GAS f32x4*)(g + 512 + 8 * lane), g3 = *(const GAS f32x4*)(g + 512 + 8 * lane + 4);
    const f32x4 b0 = *(const GAS f32x4*)(b + 8 * lane), b1 = *(const GAS f32x4*)(b + 8 * lane + 4), b2 = *(const GAS f32x4*)(b + 512 + 8 * lane), b3 = *(const GAS f32x4*)(b + 512 + 8 * lane + 4);
#pragma unroll
    for (int j = 0; j < 4; ++j) { v[j] = v[j] * rstd * g0[j] + b0[j]; v[4 + j] = v[4 + j] * rstd * g1[j] + b1[j]; v[8 + j] = v[8 + j] * rstd * g2[j] + b2[j]; v[12 + j] = v[12 + j] * rstd * g3[j] + b3[j]; }
}
__device__ __forceinline__ void ln_norm4(float (&v)[4][16], const float* g, const float* b, int lane) {
    float s[4], s2[4], rstd[4];
#pragma unroll
    for (int r = 0; r < 4; ++r) { s[r] = 0.f;
#pragma unroll
        for (int j = 0; j < 16; ++j) s[r] += v[r][j]; }
#pragma unroll
    for (int o = 1; o < 64; o <<= 1) {
#pragma unroll
        for (int r = 0; r < 4; ++r) s[r] += __shfl_xor(s[r], o); }
#pragma unroll
    for (int r = 0; r < 4; ++r) { const float mean = s[r] * (1.f / DM); s2[r] = 0.f;
#pragma unroll
        for (int j = 0; j < 16; ++j) { v[r][j] -= mean; s2[r] += v[r][j] * v[r][j]; } }
#pragma unroll
    for (int o = 1; o < 64; o <<= 1) {
#pragma unroll
        for (int r = 0; r < 4; ++r) s2[r] += __shfl_xor(s2[r], o); }
#pragma unroll
    for (int r = 0; r < 4; ++r) rstd[r] = 1.f / sqrtf(s2[r] * (1.f / DM) + NORM_EPS);
    const f32x4 g0 = *(const GAS f32x4*)(g + 8 * lane), g1 = *(const GAS f32x4*)(g + 8 * lane + 4), g2 = *(const GAS f32x4*)(g + 512 + 8 * lane), g3 = *(const GAS f32x4*)(g + 512 + 8 * lane + 4);
    const f32x4 b0 = *(const GAS f32x4*)(b + 8 * lane), b1 = *(const GAS f32x4*)(b + 8 * lane + 4), b2 = *(const GAS f32x4*)(b + 512 + 8 * lane), b3 = *(const GAS f32x4*)(b + 512 + 8 * lane + 4);
#pragma unroll
    for (int r = 0; r < 4; ++r)
#pragma unroll
        for (int j = 0; j < 4; ++j) { v[r][j] = v[r][j] * rstd[r] * g0[j] + b0[j]; v[r][4 + j] = v[r][4 + j] * rstd[r] * g1[j] + b1[j]; v[r][8 + j] = v[r][8 + j] * rstd[r] * g2[j] + b2[j]; v[r][12 + j] = v[r][12 + j] * rstd[r] * g3[j] + b3[j]; }
}
__device__ __forceinline__ void ln_store_bf16(const float (&v)[16], bf16* orow, int lane) {
    v4u a, b; a.x = pk2(v[0], v[1]); a.y = pk2(v[2], v[3]); a.z = pk2(v[4], v[5]); a.w = pk2(v[6], v[7]); b.x = pk2(v[8], v[9]); b.y = pk2(v[10], v[11]); b.z = pk2(v[12], v[13]); b.w = pk2(v[14], v[15]);
    *(GAS v4u*)(orow + 8 * lane) = a; *(GAS v4u*)(orow + 512 + 8 * lane) = b;
}
__device__ __forceinline__ void ln_store_f32(const float (&v)[16], float* orow, int lane) {
    *(GAS f32x4*)(orow + 8 * lane) = (f32x4){v[0], v[1], v[2], v[3]}; *(GAS f32x4*)(orow + 8 * lane + 4) = (f32x4){v[4], v[5], v[6], v[7]};
    *(GAS f32x4*)(orow + 512 + 8 * lane) = (f32x4){v[8], v[9], v[10], v[11]}; *(GAS f32x4*)(orow + 512 + 8 * lane + 4) = (f32x4){v[12], v[13], v[14], v[15]};
}
__device__ __forceinline__ void halo_phase(Frame& F, int first) {
    const int lane = F.lane, gw = (F.bid - first) * NWAVES + F.wave, NGW = (F.G - first) * NWAVES, i16 = lane & 15, kq = lane >> 4;
    for (int j = gw; j < 16 * 176; j += NGW) { const int rt_ = j / 176, cgp = j % 176;
        const int pa = i16 >> 1, wh = i16 & 1, srow = (pa == 0) ? (R_META0 + 14 + wh) : (256 * (8 * rt_ + pa) - 2 + wh);
        const int ch = 16 * cgp + i16, brow = 256 * (ch >> 7) + (ch & 127);
        const bf16* ap = F.H1() + (size_t)srow * DM + 8 * kq; const bf16* bp = F.Wffn_t() + (size_t)brow * DM + 8 * kq;
        f32x4 acc = (f32x4){0.f, 0.f, 0.f, 0.f};
#pragma unroll 16
        for (int s = 0; s < 32; ++s) acc = __builtin_amdgcn_mfma_f32_16x16x32_bf16(*(const GAS bf16x8*)(ap + 32 * s), *(const GAS bf16x8*)(bp + 32 * s), acc, 0, 0, 0);
#pragma unroll
        for (int r = 0; r < 4; ++r) { const int i = 4 * kq + r; F.HALO()[((size_t)(8 * rt_ + (i >> 1)) * 2 + (i & 1)) * FF + ch] = acc[r]; }
    }
}

__device__ __forceinline__ void meta_kv(Frame& F) {
    const int lane = F.lane, i16 = lane & 15, kq = lane >> 4;
    for (int j = F.wave; j < 64; j += NWAVES) {
        const bf16* ap = F.CKV() + (size_t)(R_META0 + i16) * KVL + 8 * kq; const bf16* bp = F.Wkv_t() + (size_t)(16 * j + i16) * KVL + 8 * kq;
        f32x4 acc = (f32x4){0.f, 0.f, 0.f, 0.f};
#pragma unroll
        for (int s = 0; s < 8; ++s) acc = __builtin_amdgcn_mfma_f32_16x16x32_bf16(*(const GAS bf16x8*)(ap + 32 * s), *(const GAS bf16x8*)(bp + 32 * s), acc, 0, 0, 0);
#pragma unroll
        for (int r = 0; r < 4; ++r) F.KV()[(size_t)(R_META0 + 4 * kq + r) * 1024 + 16 * j + i16] = (bf16)f2bf(acc[r]);
    }
    for (int i = F.tid; i < 48 * 1024 / 8; i += NTHR) *(GAS v4u*)(F.KV() + (size_t)(R_META0 + 16) * 1024 + 8 * i) = (v4u){0u, 0u, 0u, 0u};
}

struct Args { const void* in[28]; float* out; unsigned char* ws; int ph_lo, ph_hi; };
__global__ void __launch_bounds__(NTHR, 2) hymba_fwd(Args args) {
    extern __shared__ __attribute__((aligned(16))) unsigned char lds[];
    Frame F;
    F.lds = (ldsp)lds; F.MISC = (volatile LAS unsigned*)(F.lds + MISC_OFF);
    F.tid = threadIdx.x; F.lane = F.tid & 63; F.wave = __builtin_amdgcn_readfirstlane(F.tid >> 6); F.G = gridDim.x; F.bid = blockIdx.x;
    unsigned char* ws = args.ws; F.ws = ws; F.out = args.out; F.ctl = (gu32*)(ws + WS_CTL);
    for (int u = F.tid; u < (LDSCTL_END - LDSCTL_OFF) / 4; u += NTHR) ((LAS unsigned*)(F.lds + LDSCTL_OFF))[u] = 0u;
    __syncthreads();
    XcdBarrier bar; bar.bar = (unsigned*)(F.ctl + CW_BAR); bar.x = 0; bar.st = nullptr;
    if (N_LAUNCHES == 1) bar = xcd_barrier_post((unsigned*)(F.ctl + CW_BAR), F.MISC + 8);
    const int lo = args.ph_lo, hi = args.ph_hi;
#ifndef P4_MASK
#define P4_MASK 15
#endif
#ifndef PHASE_MASK
#define PHASE_MASK 0x7ff
#endif
#define IN(k) ((((PHASE_MASK) >> (k)) & 1) && lo <= (k) && (k) < hi)
#define BOTH(k) (IN(k) && IN((k) + 1))
#define PHASE_BEGIN() do { int t_ = F.wave * 64 + (int)__builtin_amdgcn_mbcnt_hi(~0u, __builtin_amdgcn_mbcnt_lo(~0u, 0u)); asm volatile("" : "+v"(t_)); F.tid = t_; F.lane = t_ & 63; } while (0)
#define SEAM(k) do { if (BOTH(k)) xcd_barrier(bar); } while (0)
#ifndef PROBE_MASK
#define PROBE_MASK 0
#endif
#ifndef SUBPROBE
#define SUBPROBE 0
#endif
#define DUP(bit, ...) do { __VA_ARGS__; if ((SUBPROBE) & (bit)) { __VA_ARGS__; } } while (0)
#define REPS(k) for (int rep_ = 0; rep_ < ((((PROBE_MASK) >> (k)) & 1) ? 2 : 1); ++rep_)
#define RSEAM(k) do { if (rep_ == 0 && (((PROBE_MASK) >> (k)) & 1) && N_LAUNCHES == 1) xcd_barrier(bar); } while (0)
    const int gw = F.bid * NWAVES + F.wave, NGW = F.G * NWAVES;
    ldsp L = F.lds + RING_OFF;

    if (IN(0)) { PHASE_BEGIN(); REPS(0) { p0_prologue(F); RSEAM(0); } SEAM(0); }
    if (IN(1)) { PHASE_BEGIN(); REPS(1) { pg8::Gemm g{F.XN(), F.Win_t(), RTOT, ZC, DM}; pg8::StaticOrder S; S.init(RTOT, ZC, F.G, F.bid);
        pg8::EpiInProj E{F.Z(), F.CKV(), F.KR(), F.out, F.kv_norm_g(), F.ROPE_T(), (LAS float*)(F.lds + XTRA_OFF)};
        pg8::gemm_phase<pg8::EpiInProj, pg8::StaticOrder, true, true>(L, g, S, E, F.tid); RSEAM(1); }
        late_transposes(F, 0, (RTOT / 256 * (ZC / 256)) % F.G);
        SEAM(1); }
    if (IN(2)) { PHASE_BEGIN(); REPS(2) {
        DUP(1, for (int m = 8 * gw; m < RTOT; m += 8 * NGW) p2_rows8(F, m));
        gla_stage_wg(F); __syncthreads();
        DUP(2, { const int per = 2052 / F.G, rem = 2052 - per * F.G; gla_pass1_units(F, L, F.bid * per, per, F.bid < rem ? per * F.G + F.bid : -1); });
        DUP(4, for (int u = F.bid; u < DB * 4; u += F.G) gla_sample_unit(F, L, u));
        RSEAM(2); }
        SEAM(2); }
    if (IN(3)) { PHASE_BEGIN(); REPS(3) {
        DUP(8, gla_pass2(F));
        if (F.bid == F.G - 1) meta_kv(F);
        { pg8::Gemm g{F.CQN(), F.Wuq_t(), RTOT, QW, QL}; pg8::StaticOrder S; S.init(RTOT, QW, F.G, F.bid); pg8::EpiBf16<0> E{F.Q(), QW, nullptr, 0, 0, 1.f};
          pg8::gemm_phase<pg8::EpiBf16<0>, pg8::StaticOrder, true, true>(L, g, S, E, F.tid); }
        { pg8::Gemm g{F.CKV(), F.Wkv_t(), R_PROMPT, 1024, KVL}; pg8::StaticOrder S; S.init(R_PROMPT, 1024, F.G, F.bid); pg8::EpiBf16<0> E{F.KV(), 1024, nullptr, 0, 0, 1.f};
          pg8::gemm_phase<pg8::EpiBf16<0>, pg8::StaticOrder, true, true>(L, g, S, E, F.tid); }
        RSEAM(3); }
        SEAM(3); }
    if (IN(4)) { PHASE_BEGIN();
#define DEQ(word) ({ if (F.tid == 0) F.MISC[0] = __hip_atomic_fetch_add(F.ctl + CW_QUEUE + 64 * (word), 1u, RLX_AGENT); __syncthreads(); const int id_ = (int)F.MISC[0]; __syncthreads(); id_; })
#ifdef P4_DECODE_LAST
#define P4_BODY(QO, MSK) do { \
        if ((MSK) & 2) for (;;) { const int id = DEQ((QO) + 1); if (id >= NB * 64 + 8) break; \
            int qrow0, kvrow0, qb, h; \
            if (id < NB * 64) { const int bh = id & 127, b = bh >> 3; qb = 7 - (id >> 7); h = bh & 7; qrow0 = b * SEQ + 256 * qb; kvrow0 = b * SEQ; } else { qb = -1; h = id - NB * 64; qrow0 = R_META0; kvrow0 = 0; } \
            attn_prompt_unit(F, L, qrow0, kvrow0, qb, h); } \
        if ((MSK) & 8) for (;;) { const int id = DEQ((QO) + 2); if (id >= 513) break; \
            gla_pass3_units(F, L, 4 * id, 4 * id + 4 < 2052 ? 4 * id + 4 : 2052); } \
        if ((MSK) & 1) for (;;) { const int id = DEQ((QO) + 0); if (id >= DB) break; attn_decode_unit(F, L, id); } } while (0)
#else
#define P4_BODY(QO, MSK) do { \
        if ((MSK) & 1) for (;;) { const int id = DEQ((QO) + 0); if (id >= DB) break; attn_decode_unit(F, L, id); } \
        if ((MSK) & 2) for (;;) { const int id = DEQ((QO) + 1); if (id >= NB * 64 + 8) break; \
            int qrow0, kvrow0, qb, h; \
            if (id < NB * 64) { const int bh = id & 127, b = bh >> 3; qb = 7 - (id >> 7); h = bh & 7; qrow0 = b * SEQ + 256 * qb; kvrow0 = b * SEQ; } else { qb = -1; h = id - NB * 64; qrow0 = R_META0; kvrow0 = 0; } \
            attn_prompt_unit(F, L, qrow0, kvrow0, qb, h); } \
        if ((MSK) & 8) for (;;) { const int id = DEQ((QO) + 2); if (id >= 513) break; \
            gla_pass3_units(F, L, 4 * id, 4 * id + 4 < 2052 ? 4 * id + 4 : 2052); } } while (0)
#endif
        P4_BODY(0, P4_MASK);
#ifdef P4_DUP
        if (N_LAUNCHES == 1) xcd_barrier(bar);
        P4_BODY(3, P4_DUP);
#endif
#undef P4_BODY
#undef DEQ
        SEAM(4); }
    if (IN(5)) { PHASE_BEGIN(); REPS(5) {
        { pg8::Gemm g{F.AO(), F.Wo_t(), R_PROMPT, DM, DM}; pg8::StaticOrder S; S.init(R_PROMPT, DM, F.G, F.bid); pg8::EpiResBf16 E{F.Y1(), F.XN(), DM, DN_ALPHA};
          pg8::gemm_phase<pg8::EpiResBf16, pg8::StaticOrder, true, true>(L, g, S, E, F.tid); }
        { pg8::Gemm g{F.AO(), F.Wo_t(), RTOT, DM, DM, 256}; pg8::SplitOrder S{128, 3, 4, 4, 256, F.G, F.bid}; pg8::EpiSlabBf16 E{F.SL5(), DM, 128, 256, (size_t)768 * DM};
          pg8::gemm_phase<pg8::EpiSlabBf16, pg8::SplitOrder, true, true>(L, g, S, E, F.tid); }
        RSEAM(5); }
        late_transposes(F, 1, 48);
        SEAM(5); }
    if (IN(6)) { PHASE_BEGIN(); REPS(6) {
        for (int m = 4 * gw; m < R_PROMPT; m += 4 * NGW) { float v[4][16];
#pragma unroll
            for (int r = 0; r < 4; ++r) ln_load_bf16(F.Y1() + (size_t)(m + r) * DM, F.lane, v[r]);
            ln_norm4(v, F.ln1_g(), F.ln1_b(), F.lane);
#pragma unroll
            for (int r = 0; r < 4; ++r) ln_store_bf16(v[r], F.H1() + (size_t)(m + r) * DM, F.lane); }
        for (int m = R_PROMPT + gw; m < R_VALID; m += NGW) { float v[16];
            ln_load_slabs(F.SL5() + (size_t)(m - R_PROMPT) * DM, (size_t)768 * DM, 4, F.XN() + (size_t)m * DM, DN_ALPHA, F.lane, v);
            ln_norm(v, F.ln1_g(), F.ln1_b(), F.lane); ln_store_bf16(v, F.H1() + (size_t)m * DM, F.lane); }
        RSEAM(6); } SEAM(6); }
    if (IN(7)) { PHASE_BEGIN(); REPS(7) {
        constexpr int NSU = 2 * (2 * FF / 256);
        if (F.bid < NSU) { pg8::Gemm g{F.H1(), F.Wffn_t(), R_FFN, 2 * FF, DM}; pg8::SplitOrder S{R_PROMPT / 256, 2, 2 * FF / 256, 1, 0, NSU, F.bid};
            pg8::EpiFfn<true> E{F.Gb(), F.HALO(), F.conv_w(), F.conv_b(), F.state_conv(), F.out + O_CONVP, F.out + O_CONVS, (LAS float*)(F.lds + XTRA_OFF)};
            pg8::gemm_phase<pg8::EpiFfn<true>, pg8::SplitOrder, true, true>(L, g, S, E, F.tid); }
        else halo_phase(F, NSU);
        RSEAM(7); } SEAM(7); }
    if (IN(8)) { PHASE_BEGIN(); REPS(8) { pg8::Gemm g{F.H1(), F.Wffn_t(), R_PROMPT, 2 * FF, DM}; pg8::StaticOrder S; S.init(R_PROMPT, 2 * FF, F.G, F.bid);
        pg8::EpiFfn<false> E{F.Gb(), F.HALO(), F.conv_w(), F.conv_b(), F.state_conv(), F.out + O_CONVP, F.out + O_CONVS, (LAS float*)(F.lds + XTRA_OFF)};
        pg8::gemm_phase<pg8::EpiFfn<false>, pg8::StaticOrder, true, true>(L, g, S, E, F.tid); RSEAM(8); }
        SEAM(8); }
    if (IN(9)) { PHASE_BEGIN(); REPS(9) {
        { pg8::Gemm g{F.Gb(), F.Wdown_t(), R_PROMPT, DM, FF}; pg8::StaticOrder S; S.init(R_PROMPT, DM, F.G, F.bid); pg8::EpiResBf16 E{F.Y2(), F.H1(), DM, DN_ALPHA};
          pg8::gemm_phase<pg8::EpiResBf16, pg8::StaticOrder, true, true>(L, g, S, E, F.tid); }
        { pg8::Gemm g{F.Gb(), F.Wdown_t(), R_FFN, DM, FF, 256}; pg8::SplitOrder S{128, 2, 4, 11, 256, F.G, F.bid}; pg8::EpiSlabBf16 E{F.SL9(), DM, 128, 256, (size_t)512 * DM};
          pg8::gemm_phase<pg8::EpiSlabBf16, pg8::SplitOrder, true, true>(L, g, S, E, F.tid); }
        RSEAM(9); } SEAM(9); }
    if (IN(10)) { PHASE_BEGIN(); REPS(10) {
        for (int m = 4 * gw; m < R_PROMPT; m += 4 * NGW) { float v[4][16];
#pragma unroll
            for (int r = 0; r < 4; ++r) { const bf16* yr = F.Y2() + (size_t)(m + r) * DM + 4 * F.lane;
#pragma unroll
                for (int j = 0; j < 4; ++j) { const u32x2 w = *(const GAS u32x2*)(yr + 256 * j); v[r][4 * j] = bflo(w.x); v[r][4 * j + 1] = bfhi(w.x); v[r][4 * j + 2] = bflo(w.y); v[r][4 * j + 3] = bfhi(w.y); } }
            float s[4], s2[4];
#pragma unroll
            for (int r = 0; r < 4; ++r) { s[r] = 0.f;
#pragma unroll
                for (int j = 0; j < 16; ++j) s[r] += v[r][j]; }
#pragma unroll
            for (int o = 1; o < 64; o <<= 1) {
#pragma unroll
                for (int r = 0; r < 4; ++r) s[r] += __shfl_xor(s[r], o); }
#pragma unroll
            for (int r = 0; r < 4; ++r) { const float mean = s[r] * (1.f / DM); s2[r] = 0.f;
#pragma unroll
                for (int j = 0; j < 16; ++j) { v[r][j] -= mean; s2[r] += v[r][j] * v[r][j]; } }
#pragma unroll
            for (int o = 1; o < 64; o <<= 1) {
#pragma unroll
                for (int r = 0; r < 4; ++r) s2[r] += __shfl_xor(s2[r], o); }
#pragma unroll
            for (int j = 0; j < 4; ++j) { const f32x4 gg = *(const GAS f32x4*)(F.ln2_g() + 4 * F.lane + 256 * j), bb = *(const GAS f32x4*)(F.ln2_b() + 4 * F.lane + 256 * j);
#pragma unroll
                for (int r = 0; r < 4; ++r) { const float rstd = 1.f / sqrtf(s2[r] * (1.f / DM) + NORM_EPS);
                    __builtin_nontemporal_store((f32x4){v[r][4 * j] * rstd * gg.x + bb.x, v[r][4 * j + 1] * rstd * gg.y + bb.y, v[r][4 * j + 2] * rstd * gg.z + bb.z, v[r][4 * j + 3] * rstd * gg.w + bb.w}, (GAS f32x4*)(F.out + O_YP + (size_t)(m + r) * DM + 4 * F.lane + 256 * j)); } } }
        for (int m = R_PROMPT + gw; m < R_FFN; m += NGW) { float v[16];
            ln_load_slabs(F.SL9() + (size_t)(m - R_PROMPT) * DM, (size_t)512 * DM, 11, F.H1() + (size_t)m * DM, DN_ALPHA, F.lane, v);
            ln_norm(v, F.ln2_g(), F.ln2_b(), F.lane); ln_store_f32(v, F.out + O_YP + (size_t)m * DM, F.lane); }
        RSEAM(10); } }
#undef IN
#undef BOTH
#undef SEAM
}

extern "C" void kernel_launch(void* const* d_in, const int* in_sizes, int n_in, void* d_out, int out_size, void* d_ws, size_t ws_size, hipStream_t stream) {
    static int grid = 0;
    if (grid == 0) {
        if (n_in != 28 || out_size != (int)O_END || ws_size < WS_END) { fprintf(stderr, "kernel_launch: unexpected problem shape (n_in %d, out %d, ws %zu); nothing launched\n", n_in, out_size, ws_size); grid = -1; return; }
        int dev = 0, cus = 0, per_cu = 0;
        if (hipGetDevice(&dev) != hipSuccess || hipDeviceGetAttribute(&cus, hipDeviceAttributeMultiprocessorCount, dev) != hipSuccess) { grid = -1; return; }
        if (hipFuncSetAttribute((const void*)hymba_fwd, hipFuncAttributeMaxDynamicSharedMemorySize, LDS_BYTES) != hipSuccess) { fprintf(stderr, "kernel_launch: hipFuncSetAttribute failed\n"); grid = -1; return; }
        if (hipOccupancyMaxActiveBlocksPerMultiprocessor(&per_cu, (const void*)hymba_fwd, NTHR, LDS_BYTES) != hipSuccess || per_cu < 1) { fprintf(stderr, "kernel_launch: occupancy query reports %d workgroups per CU\n", per_cu); }
        (void)hipGetLastError();
        grid = cus;
    }
    if (grid < 0) return;
    if (hipMemsetAsync((char*)d_ws + WS_CTL, 0, CTL_ZERO_BYTES, stream) != hipSuccess) { fprintf(stderr, "kernel_launch: memset failed\n"); return; }
    Args a{};
    for (int i = 0; i < 28; ++i) a.in[i] = d_in[i];
    a.out = (float*)d_out; a.ws = (unsigned char*)d_ws;
    for (int li = 0; li < N_LAUNCHES; ++li) {
        a.ph_lo = (N_LAUNCHES == 1) ? 0 : li; a.ph_hi = (N_LAUNCHES == 1) ? NPH : li + 1;
        hipLaunchKernelGGL(hymba_fwd, dim3(grid), dim3(NTHR), LDS_BYTES, stream, a);
        const hipError_t le = hipPeekAtLastError();
        if (le != hipSuccess) { fprintf(stderr, "kernel_launch: launch %d failed: %s\n", li, hipGetErrorName(le)); break; }
    }
}
```

```cpp
#include <hip/hip_runtime.h>
#include <cstdio>
#include <cstdint>
namespace pg8 {
#define PG8_LAS __attribute__((address_space(3)))
typedef unsigned short bf16_t;
typedef short bf16x8 __attribute__((ext_vector_type(8)));
typedef float f32x4 __attribute__((ext_vector_type(4)));
typedef unsigned u32x4 __attribute__((ext_vector_type(4)));
constexpr int BM = 256, BK = 64, HALF = 128, HTB = HALF * BK * 2  , STAGE_BYTES = 8 * HTB, NXCD = 8, WGM = 8;

__host__ __device__ __forceinline__ int lds_byte(int r, int c) { const int st = (r >> 4) * 2 + (c >> 5), rr = r & 15, cc = c & 31, ob = rr * 64 + cc * 2; return st * 1024 + (ob ^ (((ob >> 9) & 1) << 5)); }
__host__ __device__ __forceinline__ void stage_rc(int b, int& R, int& C) { const int st = b / 1024, sb = b % 1024, swz = sb ^ (((sb >> 9) & 1) << 5); R = (st >> 1) * 16 + swz / 64; C = (st & 1) * 32 + (swz % 64) / 2; }
__host__ __device__ __forceinline__ int perm32(int rho) { const int n = rho >> 4, i = rho & 15; return 8 * (i >> 2) + 4 * n + (i & 3); }

struct Unit { int pm, pn, ko; };
struct Gemm { const bf16_t* A; const bf16_t* Bt; int M, N, K, Ku; };

struct StaticOrder {
    int nM, nN, nwg, G, c;
    __host__ __device__ void init(int M, int N, int G_, int c_) { nM = M / BM; nN = N / BM; nwg = nM * nN; G = G_; c = c_; }
    __host__ __device__ bool next(int i, Unit& u) const {
        const long L = (long)i * G + c; if (L >= nwg) return false;
        int wgid = (int)L; { const int q = nwg / NXCD, r = nwg % NXCD, xcd = wgid % NXCD, off = wgid / NXCD; wgid = (xcd < r ? xcd * (q + 1) : r * (q + 1) + (xcd - r) * q) + off; }
        const int nig = WGM * nN, gid = wgid / nig, fm = gid * WGM, gsz = (nM - fm) < WGM ? (nM - fm) : WGM;
        u.pm = fm + ((wgid % nig) % gsz); u.pn = (wgid % nig) / gsz; u.ko = 0; return true;
    }
    __device__ __forceinline__ void a_ready(const Unit&) const {}
    __device__ __forceinline__ void done(const Unit&) const {}
};

__device__ __forceinline__ unsigned cvt_pk_bf16(float lo, float hi) { unsigned r; asm volatile("v_cvt_pk_bf16_f32 %0, %1, %2" : "=v"(r) : "v"(lo), "v"(hi)); return r; }
typedef float f32x2 __attribute__((ext_vector_type(2)));
__device__ __forceinline__ f32x2 gelu_pk(f32x2 v) {
    const f32x2 av = __builtin_elementwise_abs(v), d = av * 0.2316418882f + 1.0f;
    f32x2 t; t.x = __builtin_amdgcn_rcpf(d.x); t.y = __builtin_amdgcn_rcpf(d.y);
    f32x2 q = t * 0.5307027145f + (-0.7265760135f); q = q * t + 0.7107068705f; q = q * t + (-0.142248368f); q = q * t + 0.127414796f; q = q * t;
    const f32x2 s = (v * v) * (-0.72134752044f);
    f32x2 e; e.x = __builtin_amdgcn_exp2f(s.x); e.y = __builtin_amdgcn_exp2f(s.y);
    const f32x2 m = v * (q * e), r = v - m;
    f32x2 o; o.x = v.x < 0.f ? m.x : r.x; o.y = v.y < 0.f ? m.y : r.y; return o;
}

template <int ACT  > struct EpiBf16 {
    static constexpr bool PERM = true, AFTER_DRAIN = false; static_assert(ACT == 0 || ACT == 1, "EpiBf16: ACT is 0 (none) or 1 (gelu_pk)");
    bf16_t* O; int ldc; const float* bias; int split_cols; size_t split_stride; float scale0;
    __device__ __forceinline__ void operator()(const f32x4 (&acc)[2][2][4][2], const Unit& u, int wr, int wc, int fr, int fq) const {
        const int row0 = u.pm * BM + wr * 64 + fr; int colt = u.pn * BM; bf16_t* base = O;
        float sc = 1.f; if (split_cols) { const int t = colt / split_cols; base += (size_t)t * split_stride; colt -= t * split_cols; if (t == 0) sc = scale0; }
        const int col0 = colt + wc * 32 + 8 * fq, bcol0 = u.pn * BM + wc * 32 + 8 * fq;
        f32x4 bv[2][2];
#pragma unroll
        for (int bj = 0; bj < 2; ++bj)
#pragma unroll
            for (int n = 0; n < 2; ++n) bv[bj][n] = bias ? *(const f32x4*)(bias + bcol0 + bj * HALF + 4 * n) : (f32x4){0.f, 0.f, 0.f, 0.f};
#pragma unroll
        for (int ai = 0; ai < 2; ++ai)
#pragma unroll
            for (int m = 0; m < 4; ++m) { bf16_t* rowp = base + (size_t)(row0 + ai * HALF + m * 16) * ldc + col0;
#pragma unroll
                for (int bj = 0; bj < 2; ++bj) { f32x4 v0 = acc[ai][bj][m][0] + bv[bj][0], v1 = acc[ai][bj][m][1] + bv[bj][1];
                    if (ACT == 1) { f32x2 a = gelu_pk((f32x2){v0[0], v0[1]}), b = gelu_pk((f32x2){v0[2], v0[3]}), c = gelu_pk((f32x2){v1[0], v1[1]}), d = gelu_pk((f32x2){v1[2], v1[3]});
                        v0 = (f32x4){a.x, a.y, b.x, b.y}; v1 = (f32x4){c.x, c.y, d.x, d.y}; }
                    v0 = v0 * sc; v1 = v1 * sc; u32x4 w; w.x = cvt_pk_bf16(v0[0], v0[1]); w.y = cvt_pk_bf16(v0[2], v0[3]); w.z = cvt_pk_bf16(v1[0], v1[1]); w.w = cvt_pk_bf16(v1[2], v1[3]);
                    *(u32x4*)(rowp + bj * HALF) = w; } }
    }
};
struct EpiResF32 {
    static constexpr bool PERM = false, AFTER_DRAIN = false;
    float* O; const bf16_t* res; int ldc; float alpha;
    __device__ __forceinline__ void operator()(const f32x4 (&acc)[2][2][4][2], const Unit& u, int wr, int wc, int fr, int fq) const {
        typedef unsigned u32x2v __attribute__((ext_vector_type(2)));
        const int row0 = u.pm * BM + wr * 64 + fr, col0 = u.pn * BM + wc * 32 + 4 * fq;
#pragma unroll
        for (int ai = 0; ai < 2; ++ai)
#pragma unroll
            for (int m = 0; m < 4; ++m) { const size_t off = (size_t)(row0 + ai * HALF + m * 16) * ldc + col0;
#pragma unroll
                for (int bj = 0; bj < 2; ++bj)
#pragma unroll
                    for (int n = 0; n < 2; ++n) { const u32x2v rb = *(const u32x2v*)(res + off + bj * HALF + n * 16);
                        f32x4 r; r[0] = __uint_as_float(rb.x << 16); r[1] = __uint_as_float(rb.x & 0xffff0000u); r[2] = __uint_as_float(rb.y << 16); r[3] = __uint_as_float(rb.y & 0xffff0000u);
                        *(f32x4*)(O + off + bj * HALF + n * 16) = acc[ai][bj][m][n] + r * alpha; } }
    }
};
struct EpiResBf16 {
    static constexpr bool PERM = true, AFTER_DRAIN = false;
    bf16_t* O; const bf16_t* res; int ldc; float alpha;
    __device__ __forceinline__ void operator()(const f32x4 (&acc)[2][2][4][2], const Unit& u, int wr, int wc, int fr, int fq) const {
        const int row0 = u.pm * BM + wr * 64 + fr, col0 = u.pn * BM + wc * 32 + 8 * fq;
#pragma unroll
        for (int ai = 0; ai < 2; ++ai)
#pragma unroll
            for (int m = 0; m < 4; ++m) { const size_t off = (size_t)(row0 + ai * HALF + m * 16) * ldc + col0;
#pragma unroll
                for (int bj = 0; bj < 2; ++bj) { const u32x4 rb = *(const u32x4*)(res + off + bj * HALF);
                    const f32x4 a0 = acc[ai][bj][m][0], a1 = acc[ai][bj][m][1]; u32x4 w;
                    w.x = cvt_pk_bf16(a0[0] + alpha * __uint_as_float(rb.x << 16), a0[1] + alpha * __uint_as_float(rb.x & 0xffff0000u)); w.y = cvt_pk_bf16(a0[2] + alpha * __uint_as_float(rb.y << 16), a0[3] + alpha * __uint_as_float(rb.y & 0xffff0000u));
                    w.z = cvt_pk_bf16(a1[0] + alpha * __uint_as_float(rb.z << 16), a1[1] + alpha * __uint_as_float(rb.z & 0xffff0000u)); w.w = cvt_pk_bf16(a1[2] + alpha * __uint_as_float(rb.w << 16), a1[3] + alpha * __uint_as_float(rb.w & 0xffff0000u));
                    *(u32x4*)(O + off + bj * HALF) = w; } }
    }
};
struct EpiSlabBf16 {
    static constexpr bool PERM = true, AFTER_DRAIN = false;
    bf16_t* O; int ldc, pm0, Ku; size_t slab_stride;
    __device__ __forceinline__ void operator()(const f32x4 (&acc)[2][2][4][2], const Unit& u, int wr, int wc, int fr, int fq) const {
        bf16_t* base = O + (size_t)(u.ko / Ku) * slab_stride; const int row0 = (u.pm - pm0) * BM + wr * 64 + fr, col0 = u.pn * BM + wc * 32 + 8 * fq;
#pragma unroll
        for (int ai = 0; ai < 2; ++ai)
#pragma unroll
            for (int m = 0; m < 4; ++m) { const size_t off = (size_t)(row0 + ai * HALF + m * 16) * ldc + col0;
#pragma unroll
                for (int bj = 0; bj < 2; ++bj) { const f32x4 a0 = acc[ai][bj][m][0], a1 = acc[ai][bj][m][1]; u32x4 w;
                    w.x = cvt_pk_bf16(a0[0], a0[1]); w.y = cvt_pk_bf16(a0[2], a0[3]); w.z = cvt_pk_bf16(a1[0], a1[1]); w.w = cvt_pk_bf16(a1[2], a1[3]);
                    *(u32x4*)(base + off + bj * HALF) = w; } }
    }
};
struct SplitOrder {
    int pm0, npm, nN, nks, Ku, G, c;
    __device__ __forceinline__ bool next(int i, Unit& u) const { const int L = i * G + c; if (L >= npm * nN * nks) return false; const int ks = L % nks, r = L / nks; u.pn = r % nN; u.pm = pm0 + r / nN; u.ko = ks * Ku; return true; }
    __device__ __forceinline__ void a_ready(const Unit&) const {}
    __device__ __forceinline__ void done(const Unit&) const {}
};
struct EpiInProj {
    static constexpr bool PERM = true, AFTER_DRAIN = false, TWICE = false;
    bf16_t* Z; bf16_t* CKV; bf16_t* KR; float* out; const float* kvg; const float* rope; PG8_LAS float* red;
    __device__ static __forceinline__ void rowmap(int r, int& ridx, int& nout, size_t& oc, size_t& ok) {
        if (r < 32768) { const int b = r >> 11, t = r & 2047; ridx = 16 + t; nout = 1; oc = 34078720 + ((size_t)b * 2064 + 16 + t) * 256; ok = 42532864 + ((size_t)b * 2064 + 16 + t) * 32; }
        else if (r < 33280) { const int i = r - 32768; ridx = 2064 + (i & 3); nout = 1; oc = 44204032 + (size_t)i * 256; ok = 44335104 + (size_t)i * 32; }
        else if (r < 33296) { const int p = r - 33280; ridx = p; nout = 16; oc = 34078720 + (size_t)p * 256; ok = 42532864 + (size_t)p * 32; }
        else { ridx = 0; nout = 0; oc = 0; ok = 0; } }
    __device__ __forceinline__ void operator()(const f32x4 (&acc)[2][2][4][2], const Unit& u, int wr, int wc, int fr, int fq) const {
        const int pn = u.pn, row0 = u.pm * BM + wr * 64 + fr;
        if (pn < 8) {
            const int col0 = pn * BM + wc * 32 + 8 * fq;
#pragma unroll
            for (int ai = 0; ai < 2; ++ai)
#pragma unroll
                for (int m = 0; m < 4; ++m) { bf16_t* rowp = Z + (size_t)(row0 + ai * HALF + m * 16) * 2304 + col0;
#pragma unroll
                    for (int bj = 0; bj < 2; ++bj) { const f32x4 v0 = acc[ai][bj][m][0], v1 = acc[ai][bj][m][1]; u32x4 w; w.x = cvt_pk_bf16(v0[0], v0[1]); w.y = cvt_pk_bf16(v0[2], v0[3]); w.z = cvt_pk_bf16(v1[0], v1[1]); w.w = cvt_pk_bf16(v1[2], v1[3]);
                        *(u32x4*)(rowp + bj * HALF) = w; } }
            if (pn == 7 && wc == 0) {
                const int ci = 8 * (fq & 1);
#pragma unroll
                for (int ai = 0; ai < 2; ++ai)
#pragma unroll
                    for (int m = 0; m < 4; ++m) { const int row = row0 + ai * HALF + m * 16; int ridx, nout; size_t oc, ok; rowmap(row, ridx, nout, oc, ok);
                        const f32x4 x0 = acc[ai][1][m][0], x1 = acc[ai][1][m][1]; f32x4 p0, p1;
#pragma unroll
                        for (int j = 0; j < 4; ++j) { p0[j] = __shfl_xor(x0[j], 32); p1[j] = __shfl_xor(x1[j], 32); }
                        const f32x4 c0 = *(const f32x4*)(rope + ridx * 32 + ci), c1 = *(const f32x4*)(rope + ridx * 32 + ci + 4), s0 = *(const f32x4*)(rope + ridx * 32 + 16 + ci), s1 = *(const f32x4*)(rope + ridx * 32 + 16 + ci + 4);
                        const float sg = fq < 2 ? -1.f : 1.f;
                        const f32x4 y0 = x0 * c0 + p0 * s0 * sg, y1 = x1 * c1 + p1 * s1 * sg;
                        u32x4 w; w.x = cvt_pk_bf16(y0[0], y0[1]); w.y = cvt_pk_bf16(y0[2], y0[3]); w.z = cvt_pk_bf16(y1[0], y1[1]); w.w = cvt_pk_bf16(y1[2], y1[3]);
                        *(u32x4*)(KR + (size_t)row * 32 + 8 * fq) = w;
                        for (int c = 0; c < nout; ++c) { float* dst = out + ok + (size_t)c * 2064 * 32 + 8 * fq; __builtin_nontemporal_store(y0, (f32x4*)dst); __builtin_nontemporal_store(y1, (f32x4*)(dst + 4)); } }
            }
        } else {
#pragma unroll
            for (int ai = 0; ai < 2; ++ai)
#pragma unroll
                for (int m = 0; m < 4; ++m) { float ss = 0.f;
#pragma unroll
                    for (int bj = 0; bj < 2; ++bj)
#pragma unroll
                        for (int n = 0; n < 2; ++n) { const f32x4 x = acc[ai][bj][m][n]; ss += (x[0] * x[0] + x[1] * x[1]) + (x[2] * x[2] + x[3] * x[3]); }
                    ss += __shfl_xor(ss, 16); ss += __shfl_xor(ss, 32);
                    if (fq == 0) red[(ai * HALF + wr * 64 + m * 16 + fr) * 4 + wc] = ss; }
            asm volatile("s_waitcnt lgkmcnt(0)" ::: "memory"); __builtin_amdgcn_s_barrier(); asm volatile("" ::: "memory");
            f32x4 g0[2], g1[2];
#pragma unroll
            for (int bj = 0; bj < 2; ++bj) { g0[bj] = *(const f32x4*)(kvg + bj * HALF + wc * 32 + 8 * fq); g1[bj] = *(const f32x4*)(kvg + bj * HALF + wc * 32 + 8 * fq + 4); }
#pragma unroll
            for (int ai = 0; ai < 2; ++ai)
#pragma unroll
                for (int m = 0; m < 4; ++m) { const int rl = ai * HALF + wr * 64 + m * 16 + fr, row = u.pm * BM + rl; int ridx, nout; size_t oc, ok; rowmap(row, ridx, nout, oc, ok);
                    const f32x4 pr = *(const PG8_LAS f32x4*)(red + rl * 4); const float rs = 1.0f / sqrtf(((pr[0] + pr[1]) + (pr[2] + pr[3])) * (1.0f / 256.0f) + 1e-5f);
#pragma unroll
                    for (int bj = 0; bj < 2; ++bj) { const int cb = bj * HALF + wc * 32 + 8 * fq; const f32x4 y0 = acc[ai][bj][m][0] * rs * g0[bj], y1 = acc[ai][bj][m][1] * rs * g1[bj];
                        u32x4 w; w.x = cvt_pk_bf16(y0[0], y0[1]); w.y = cvt_pk_bf16(y0[2], y0[3]); w.z = cvt_pk_bf16(y1[0], y1[1]); w.w = cvt_pk_bf16(y1[2], y1[3]);
                        *(u32x4*)(CKV + (size_t)row * 256 + cb) = w;
                        for (int c = 0; c < nout; ++c) { float* dst = out + oc + (size_t)c * 2064 * 256 + cb; __builtin_nontemporal_store(y0, (f32x4*)dst); __builtin_nontemporal_store(y1, (f32x4*)(dst + 4)); } } }
            asm volatile("s_waitcnt lgkmcnt(0)" ::: "memory"); __builtin_amdgcn_s_barrier(); asm volatile("" ::: "memory");
        }
    }
};
__device__ __forceinline__ float dpp_ror1(float v) { return __builtin_bit_cast(float, __builtin_amdgcn_update_dpp(0, __builtin_bit_cast(int, v), 0x121, 0xF, 0xF, false)); }
__device__ __forceinline__ float dpp_ror2(float v) { return __builtin_bit_cast(float, __builtin_amdgcn_update_dpp(0, __builtin_bit_cast(int, v), 0x122, 0xF, 0xF, false)); }
__device__ __forceinline__ float dpp_shr1(float old, float v) { return __builtin_bit_cast(float, __builtin_amdgcn_update_dpp(__builtin_bit_cast(int, old), __builtin_bit_cast(int, v), 0x111, 0xF, 0xF, false)); }
__device__ __forceinline__ float dpp_shr2(float old, float v) { return __builtin_bit_cast(float, __builtin_amdgcn_update_dpp(__builtin_bit_cast(int, old), __builtin_bit_cast(int, v), 0x112, 0xF, 0xF, false)); }
__device__ __forceinline__ float silu_f(float x) { return x * __builtin_amdgcn_rcpf(1.0f + __builtin_amdgcn_exp2f(-1.4426950408889634f * x)); }
template <bool SAMPLE  > struct EpiFfn {
    static constexpr bool PERM = true, AFTER_DRAIN = false;
    bf16_t* G; const float* halo; const float* conv_w; const float* conv_b; const float* state_conv; float* conv_prompt; float* conv_sample; PG8_LAS float* bnd;
    __device__ __forceinline__ void operator()(const f32x4 (&acc)[2][2][4][2], const Unit& u, int wr, int wc, int fr, int fq) const {
        constexpr int FF = 2816;
        const int pm = u.pm, pn = u.pn; constexpr bool sample = SAMPLE;
        const int chl = wc * 32 + 8 * fq, chg = pn * 128 + chl;
#pragma unroll
        for (int ai = 0; ai < 2; ++ai) { const int blk = 2 * ai + wr;
            if (fr >= 14) {
                if (blk < 3) {
#pragma unroll
                    for (int n = 0; n < 2; ++n) *(PG8_LAS f32x4*)(bnd + ((blk + 1) * 2 + (fr - 14)) * 128 + chl + 4 * n) = acc[ai][0][3][n]; }
                else if (!sample && (pm & 7) == 7) {
#pragma unroll
                    for (int n = 0; n < 2; ++n) *(f32x4*)(conv_prompt + ((size_t)(pm >> 3) * 2 + (fr - 14)) * FF + chg + 4 * n) = acc[ai][0][3][n]; }
            } }
        asm volatile("s_waitcnt lgkmcnt(0)" ::: "memory"); __builtin_amdgcn_s_barrier(); asm volatile("" ::: "memory");
        f32x4 w0[2], w1[2], w2[2], cb[2];
#pragma unroll
        for (int n = 0; n < 2; ++n) { w0[n] = *(const f32x4*)(conv_w + chg + 4 * n); w1[n] = *(const f32x4*)(conv_w + FF + chg + 4 * n); w2[n] = *(const f32x4*)(conv_w + 2 * FF + chg + 4 * n); cb[n] = *(const f32x4*)(conv_b + chg + 4 * n); }
#pragma unroll
        for (int ai = 0; ai < 2; ++ai) { const int blk = 2 * ai + wr;
            f32x4 pv[2]; pv[0] = (f32x4){0.f, 0.f, 0.f, 0.f}; pv[1] = pv[0];
            if (fr >= 14) {
                if (blk == 0) { if (!sample) {
#pragma unroll
                    for (int n = 0; n < 2; ++n) pv[n] = *(const f32x4*)(halo + ((size_t)pm * 2 + (fr - 14)) * FF + chg + 4 * n); } }
                else {
#pragma unroll
                    for (int n = 0; n < 2; ++n) pv[n] = *(const PG8_LAS f32x4*)(bnd + (blk * 2 + (fr - 14)) * 128 + chl + 4 * n); }
            }
#pragma unroll
            for (int m = 0; m < 4; ++m) { const int row = pm * BM + ai * HALF + wr * 64 + m * 16 + fr;
                u32x4 wv;
#pragma unroll
                for (int n = 0; n < 2; ++n) { const f32x4 cur = acc[ai][0][m][n], up = acc[ai][1][m][n], pr = (m == 0) ? pv[n] : acc[ai][0][m > 0 ? m - 1 : 0][n];
                    f32x4 p1, p2;
#pragma unroll
                    for (int j = 0; j < 4; ++j) { p1[j] = dpp_shr1(dpp_ror1(pr[j]), cur[j]); p2[j] = dpp_shr2(dpp_ror2(pr[j]), cur[j]); }
                    if (sample) { const int t = fr & 3, sb = (row - 32768) >> 2;
                        if (t < 2) { const f32x4 s1 = *(const f32x4*)(state_conv + ((size_t)sb * 2 + 1) * FF + chg + 4 * n);
                            if (t == 0) { p1 = s1; p2 = *(const f32x4*)(state_conv + ((size_t)sb * 2) * FF + chg + 4 * n); } else p2 = s1; }
                        else *(f32x4*)(conv_sample + ((size_t)sb * 2 + (t - 2)) * FF + chg + 4 * n) = cur; }
                    const f32x4 cv = cb[n] + w0[n] * p2 + w1[n] * p1 + w2[n] * cur;
                    const float g0 = silu_f(cv[0]) * up[0], g1 = silu_f(cv[1]) * up[1], g2 = silu_f(cv[2]) * up[2], g3 = silu_f(cv[3]) * up[3];
                    if (n == 0) { wv.x = cvt_pk_bf16(g0, g1); wv.y = cvt_pk_bf16(g2, g3); } else { wv.z = cvt_pk_bf16(g0, g1); wv.w = cvt_pk_bf16(g2, g3); } }
                *(u32x4*)(G + (size_t)row * FF + chg) = wv; }
        }
        asm volatile("s_waitcnt lgkmcnt(0)" ::: "memory"); __builtin_amdgcn_s_barrier(); asm volatile("" ::: "memory");
    }
};
template <class Epi, class Sched, bool ALIGN_EPI = false, bool SP2 = false>
__device__ __forceinline__ void gemm_phase(PG8_LAS unsigned char* lds, const Gemm g, const Sched& S, const Epi& E, const int tid_in) {
    int tid_ = tid_in; asm volatile("" : "+v"(tid_));
    const int tid = tid_, wid = __builtin_amdgcn_readfirstlane(tid >> 6), lane = tid & 63, wr = wid >> 2, wc = wid & 3, fr = lane & 15, fq = lane >> 4;
    const int K = g.K, nt = (g.Ku ? g.Ku : K) / BK;
    unsigned voffA[2], voffB[2];
#pragma unroll
    for (int i = 0; i < 2; ++i) { int R, C; stage_rc(tid * 16 + i * 8192, R, C); const int Rb = Epi::PERM ? ((R & ~31) + perm32(R & 31)) : R;
        voffA[i] = (unsigned)(R * K + C) * 2u; voffB[i] = (unsigned)(Rb * K + C) * 2u; }
    const size_t kstep = (size_t)(BK * 2);
    const size_t hstep = (size_t)HALF * K * 2;
    const size_t tstep = 2 * hstep;
    const unsigned ldsw = (unsigned)wid * 1024u;
    const int aoff = lds_byte(wr * 64 + fr, fq * 8), boff = lds_byte(wc * 32 + fr, fq * 8);
#define PG8_SA(b, h) (((b) * 2 + (h)) * HTB)
#define PG8_SB(b, h) ((4 + (b) * 2 + (h)) * HTB)
#define PG8_STAGE(bufoff, gbase, voff) do { _Pragma("unroll") for (int _i = 0; _i < 2; ++_i) \
        __builtin_amdgcn_global_load_lds((const unsigned*)((const char*)(gbase) + (voff)[_i]), (PG8_LAS unsigned*)(lds + (bufoff) + ldsw + _i * 8192), 16, 0, 0); } while (0)
#define PG8_LDA(dst, b, h) do { _Pragma("unroll") for (int m = 0; m < 4; ++m) _Pragma("unroll") for (int k = 0; k < 2; ++k) dst[m][k] = *(const PG8_LAS bf16x8*)(lds + PG8_SA(b, h) + aoff + m * 2048 + k * 1024); } while (0)
#define PG8_LDB(dst, b, h) do { _Pragma("unroll") for (int n = 0; n < 2; ++n) _Pragma("unroll") for (int k = 0; k < 2; ++k) dst[n][k] = *(const PG8_LAS bf16x8*)(lds + PG8_SB(b, h) + boff + n * 2048 + k * 1024); } while (0)
#define PG8_MMA(ai, bj, At, Bt) do { __builtin_amdgcn_s_setprio(1); _Pragma("unroll") for (int m = 0; m < 4; ++m) _Pragma("unroll") for (int n = 0; n < 2; ++n) _Pragma("unroll") for (int k = 0; k < 2; ++k) \
        acc[ai][bj][m][n] = __builtin_amdgcn_mfma_f32_16x16x32_bf16(Bt[n][k], At[m][k], acc[ai][bj][m][n], 0, 0, 0); __builtin_amdgcn_s_setprio(0); } while (0)
#define PG8_WAIT_V(n) asm volatile("s_waitcnt vmcnt(" #n ")" ::: "memory")
#define PG8_WAIT_L(n) asm volatile("s_waitcnt lgkmcnt(" #n ")" ::: "memory")
#define PG8_BAR __builtin_amdgcn_s_barrier()
#define PG8_SCHED __builtin_amdgcn_sched_barrier(0)
    Unit cur, nxt; int ui = 0;
    if (!S.next(0, cur)) return;
    f32x4 acc[2][2][4][2];
#pragma unroll
    for (int a = 0; a < 2; ++a)
#pragma unroll
        for (int b = 0; b < 2; ++b)
#pragma unroll
            for (int m = 0; m < 4; ++m)
#pragma unroll
                for (int n = 0; n < 2; ++n) acc[a][b][m][n] = (f32x4){0.f, 0.f, 0.f, 0.f};
    bf16x8 At[4][2], B0[2][2], B1[2][2];
    const char* cA = (const char*)g.A + (size_t)cur.pm * tstep + (size_t)cur.ko * 2; const char* cB = (const char*)g.Bt + (size_t)cur.pn * tstep + (size_t)cur.ko * 2;
    S.a_ready(cur);
    if constexpr (SP2) {
        PG8_STAGE(PG8_SB(0, 0), cB, voffB); PG8_STAGE(PG8_SB(0, 1), cB + hstep, voffB); PG8_STAGE(PG8_SA(0, 0), cA, voffA); PG8_STAGE(PG8_SA(0, 1), cA + hstep, voffA);
        if (wr == 1) PG8_BAR;
        PG8_WAIT_V(2); PG8_BAR;
        PG8_STAGE(PG8_SB(1, 0), cB + kstep, voffB); PG8_STAGE(PG8_SA(1, 0), cA + kstep, voffA); PG8_STAGE(PG8_SB(1, 1), cB + hstep + kstep, voffB);
        PG8_WAIT_V(6); PG8_BAR;
    } else {
        PG8_STAGE(PG8_SB(0, 0), cB, voffB); PG8_STAGE(PG8_SA(0, 0), cA, voffA); PG8_STAGE(PG8_SB(0, 1), cB + hstep, voffB); PG8_STAGE(PG8_SA(0, 1), cA + hstep, voffA);
        if (wr == 1) PG8_BAR;
        PG8_WAIT_V(4); PG8_BAR;
        PG8_STAGE(PG8_SB(1, 0), cB + kstep, voffB); PG8_STAGE(PG8_SA(1, 0), cA + kstep, voffA); PG8_STAGE(PG8_SB(1, 1), cB + hstep + kstep, voffB);
        PG8_WAIT_V(6); PG8_BAR;
    }
    for (;;) {
        const bool has_next = S.next(ui + 1, nxt);
        const char* nA = has_next ? (const char*)g.A + (size_t)nxt.pm * tstep + (size_t)nxt.ko * 2 : cA; const char* nB = has_next ? (const char*)g.Bt + (size_t)nxt.pn * tstep + (size_t)nxt.ko * 2 : cB;
        for (int t = 0; t < nt; t += 2) {
            const bool last = (t == nt - 2);
            const char* a1 = cA + (size_t)(t + 1) * kstep;
            const char* a2 = last ? nA : cA + (size_t)(t + 2) * kstep; const char* b2 = last ? nB : cB + (size_t)(t + 2) * kstep;
            const char* a3 = a2 + kstep; const char* b3 = b2 + kstep;
            if (last && has_next) S.a_ready(nxt);
            if constexpr (SP2) {
            PG8_LDB(B0, 0, 0); PG8_LDB(B1, 0, 1); PG8_SCHED; PG8_LDA(At, 0, 0); PG8_STAGE(PG8_SA(1, 1), a1 + hstep, voffA);
            PG8_WAIT_V(8); PG8_WAIT_L(0); PG8_BAR; PG8_MMA(0, 0, At, B0); PG8_MMA(0, 1, At, B1); PG8_BAR; PG8_SCHED;
            PG8_LDA(At, 0, 1); PG8_STAGE(PG8_SB(0, 0), b2, voffB); PG8_STAGE(PG8_SB(0, 1), b2 + hstep, voffB); PG8_STAGE(PG8_SA(0, 0), a2, voffA);
            PG8_WAIT_V(8); PG8_WAIT_L(0); PG8_BAR; PG8_MMA(1, 0, At, B0); PG8_MMA(1, 1, At, B1); PG8_BAR; PG8_SCHED;
            PG8_LDB(B0, 1, 0); PG8_LDB(B1, 1, 1); PG8_SCHED; PG8_LDA(At, 1, 0); PG8_STAGE(PG8_SA(0, 1), a2 + hstep, voffA);
            PG8_WAIT_V(8); PG8_WAIT_L(0); PG8_BAR; PG8_MMA(0, 0, At, B0); PG8_MMA(0, 1, At, B1); PG8_BAR; PG8_SCHED;
            PG8_LDA(At, 1, 1); PG8_STAGE(PG8_SB(1, 0), b3, voffB); PG8_STAGE(PG8_SB(1, 1), b3 + hstep, voffB); PG8_STAGE(PG8_SA(1, 0), a3, voffA);
            PG8_WAIT_V(8); PG8_WAIT_L(0); PG8_BAR; PG8_MMA(1, 0, At, B0); PG8_MMA(1, 1, At, B1); PG8_BAR; PG8_SCHED;
            } else {
            PG8_LDB(B0, 0, 0); PG8_SCHED; PG8_LDA(At, 0, 0); PG8_STAGE(PG8_SA(1, 1), a1 + hstep, voffA);
            PG8_WAIT_L(8); PG8_BAR; PG8_WAIT_L(0); PG8_MMA(0, 0, At, B0); PG8_BAR; PG8_SCHED;
            PG8_LDB(B1, 0, 1); PG8_STAGE(PG8_SB(0, 0), b2, voffB);
            PG8_BAR; PG8_WAIT_L(0); PG8_MMA(0, 1, At, B1); PG8_BAR;
            PG8_LDA(At, 0, 1); PG8_STAGE(PG8_SA(0, 0), a2, voffA);
            PG8_BAR; PG8_WAIT_L(0); PG8_MMA(1, 0, At, B0); PG8_BAR; PG8_SCHED;
            PG8_STAGE(PG8_SB(0, 1), b2 + hstep, voffB);
            PG8_WAIT_V(6); PG8_BAR; PG8_MMA(1, 1, At, B1); PG8_BAR;
            PG8_LDB(B0, 1, 0); PG8_SCHED; PG8_LDA(At, 1, 0); PG8_STAGE(PG8_SA(0, 1), a2 + hstep, voffA);
            PG8_WAIT_L(8); PG8_BAR; PG8_WAIT_L(0); PG8_MMA(0, 0, At, B0); PG8_BAR; PG8_SCHED;
            PG8_LDB(B1, 1, 1); PG8_STAGE(PG8_SB(1, 0), b3, voffB);
            PG8_BAR; PG8_WAIT_L(0); PG8_MMA(0, 1, At, B1); PG8_BAR;
            PG8_LDA(At, 1, 1); PG8_STAGE(PG8_SA(1, 0), a3, voffA);
            PG8_BAR; PG8_WAIT_L(0); PG8_MMA(1, 0, At, B0); PG8_BAR; PG8_SCHED;
            PG8_STAGE(PG8_SB(1, 1), b3 + hstep, voffB);
            PG8_WAIT_V(6); PG8_BAR; PG8_MMA(1, 1, At, B1); PG8_BAR;
            }
        }
        if constexpr (ALIGN_EPI) { if (wr == 0) PG8_BAR; }
        if constexpr (!Epi::AFTER_DRAIN) { E(acc, cur, wr, wc, fr, fq); S.done(cur); }
        if (!has_next) break;
#pragma unroll
        for (int a = 0; a < 2; ++a)
#pragma unroll
            for (int b = 0; b < 2; ++b)
#pragma unroll
                for (int m = 0; m < 4; ++m)
#pragma unroll
                    for (int n = 0; n < 2; ++n) acc[a][b][m][n] = (f32x4){0.f, 0.f, 0.f, 0.f};
        cur = nxt; cA = nA; cB = nB; ++ui;
        if constexpr (ALIGN_EPI) { if (wr == 1) PG8_BAR; }
    }
    PG8_WAIT_V(0);
    if constexpr (!ALIGN_EPI) { if (wr == 0) PG8_BAR; }
    PG8_BAR;
    if constexpr (Epi::AFTER_DRAIN) { E.fused(acc, cur, wr, wc, fr, fq, lds, wid, lane); S.done(cur); }
#undef PG8_SA
#undef PG8_SB
#undef PG8_STAGE
#undef PG8_LDA
#undef PG8_LDB
#undef PG8_MMA
#undef PG8_WAIT_V
#undef PG8_WAIT_L
#undef PG8_BAR
#undef PG8_SCHED
}
}
#define GAS __attribute__((address_space(1)))
#define LAS __attribute__((address_space(3)))
typedef unsigned short bf16;
typedef unsigned v4u __attribute__((ext_vector_type(4)));
typedef float f32x4 __attribute__((ext_vector_type(4)));
typedef short bf16x8 __attribute__((ext_vector_type(8)));
typedef GAS unsigned gu32;
typedef GAS unsigned long long gu64;
#define RLX_AGENT __ATOMIC_RELAXED, __HIP_MEMORY_SCOPE_AGENT
#define LDS_WAIT() asm volatile("s_waitcnt lgkmcnt(0)" ::: "memory")
#define VM_WAIT() asm volatile("s_waitcnt vmcnt(0)" ::: "memory")
__device__ __forceinline__ unsigned long long rt() { return __builtin_amdgcn_s_memrealtime(); }
__device__ __forceinline__ unsigned f2bf(float f) { unsigned u = __builtin_bit_cast(unsigned, f); return (u + 0x7fffu + ((u >> 16) & 1u)) >> 16; }
__device__ __forceinline__ unsigned pk2(float lo, float hi) { return f2bf(lo) | (f2bf(hi) << 16); }

#define XB_TMO      128
#define XB_XCNT(j)  (256  + 64 * (j))
#define XB_XSUB(j)  (1280 + 64 * (j))
#define XB_XGEN(j)  (2304 + 64 * (j))
#define XB_TOP      3328
#define XB_TOPGEN   3392
#define XCD_BAR_WORDS 3456
#define XB_SPIN_CAP (1u << 18)

__device__ __forceinline__ unsigned xb_ld(unsigned* p)              { return __hip_atomic_load(p, __ATOMIC_RELAXED, __HIP_MEMORY_SCOPE_AGENT); }
__device__ __forceinline__ unsigned xb_add(unsigned* p, unsigned v) { return __hip_atomic_fetch_add(p, v, __ATOMIC_RELAXED, __HIP_MEMORY_SCOPE_AGENT); }
__device__ __forceinline__ unsigned xb_xcc_id() { return (unsigned)__builtin_amdgcn_s_getreg((3 << 11) | 20) & 0xFu; }
#define XB_SPIN(cond, bar) do { unsigned _sp = 0; while (cond) { __builtin_amdgcn_s_sleep(1); \
    if ((++_sp & 255u) == 0u) { if (xb_ld(&(bar)[XB_TMO])) break; if (_sp > XB_SPIN_CAP) { atomicAdd(&(bar)[XB_TMO], 1u); break; } } } } while (0)

struct XcdBarrier {
    unsigned* bar; unsigned x;
    volatile LAS unsigned* st;
};

__device__ __forceinline__ XcdBarrier xcd_barrier_post(unsigned* bar, volatile LAS unsigned* st) {
    XcdBarrier b; b.bar = bar; b.x = xb_xcc_id(); b.st = st;
    if (threadIdx.x == 0) (void)xb_add(&bar[XB_XCNT(b.x)], 1u);
    return b;
}
__device__ __forceinline__ void xcd_barrier_complete(unsigned* bar, unsigned x, unsigned& nloc, unsigned& nx) {
    const unsigned G = gridDim.x * gridDim.y * gridDim.z;
    unsigned sum, cnt, mine, sp = 0u;
    for (;;) {
        sum = 0u; cnt = 0u; mine = 0u;
#pragma unroll
        for (unsigned j = 0; j < 16; ++j) { const unsigned c = xb_ld(&bar[XB_XCNT(j)]); sum += c; cnt += (c > 0u) ? 1u : 0u; mine = (j == x) ? c : mine; }
        if (sum == G) break;
        __builtin_amdgcn_s_sleep(1);
        if ((++sp & 255u) == 0u) { if (xb_ld(&bar[XB_TMO])) break; if (sp > XB_SPIN_CAP) { atomicAdd(&bar[XB_TMO], 1u); break; } }
    }
    nloc = mine > 0u ? mine : 1u; nx = cnt > 0u ? cnt : 1u;
}

__device__ __forceinline__ void xcd_barrier(const XcdBarrier& b) {
    asm volatile("s_waitcnt vmcnt(0)" ::: "memory");
    __syncthreads();
    if (threadIdx.x == 0) {
        unsigned* bar = b.bar;
        __builtin_amdgcn_s_waitcnt(0);
        unsigned nloc = b.st[0], nx = b.st[1];
        if (nloc == 0u) { xcd_barrier_complete(bar, b.x, nloc, nx); b.st[0] = nloc; b.st[1] = nx; }
        const unsigned old = xb_add(&bar[XB_XSUB(b.x)], 1u);
        const unsigned gen = old / nloc;
        if (old + 1u == (gen + 1u) * nloc) {
            __builtin_amdgcn_fence(__ATOMIC_RELEASE, "agent");
            asm volatile("s_waitcnt vmcnt(0)" ::: "memory");
            const unsigned og = xb_add(&bar[XB_TOP], 1u);
            const unsigned tg = og / nx;
            if (og + 1u == (tg + 1u) * nx) xb_add(&bar[XB_TOPGEN], 1u);
            else XB_SPIN(xb_ld(&bar[XB_TOPGEN]) == tg, bar);
            __builtin_amdgcn_fence(__ATOMIC_ACQUIRE, "agent");
            xb_add(&bar[XB_XGEN(b.x)], 1u);
            asm volatile("s_waitcnt vmcnt(0)" ::: "memory");
        } else {
            XB_SPIN(xb_ld(&bar[XB_XGEN(b.x)]) == gen, bar);
            __builtin_amdgcn_fence(__ATOMIC_ACQUIRE, "agent");
            asm volatile("s_waitcnt vmcnt(0)" ::: "memory");
        }
    }
    __syncthreads();
}
constexpr int NWAVES = 8, NTHR = 512;
constexpr int DM = 1024, NB = 16, SEQ = 2048, NMETA = 16, LTOT = NMETA + SEQ, DB = 128, DS = 4, NPAGES = 64, PAGE = 128;
constexpr int R_PROMPT = NB * SEQ, R_SAMPLE0 = R_PROMPT, R_META0 = R_PROMPT + DB * DS, R_VALID = R_META0 + NMETA, RTOT = 33536;
constexpr int R_FFN = R_META0;
static_assert(R_PROMPT == 32768 && R_META0 == 33280 && R_VALID == 33296 && RTOT % 256 == 0 && RTOT >= R_META0 + 256, "row map");
constexpr int ZC = 2304;
constexpr int ZQ = 0, ZK = 256, ZV = 512, ZG = 1024, ZCQ = 1536, ZKR = 1920, ZA = 1952, ZCKV = 2048, ZEND = 2224;
__host__ __device__ __forceinline__ int zsrc(int n) { return n < 1536 ? n : n < 1920 ? 1552 + (n - 1536) : n < 1952 ? 2192 + (n - 1920) : n < 1968 ? 1536 + (n - 1952) : n < 2048 ? -1 : 1936 + (n - 2048); }
constexpr int QL = 384, KVL = 256, ROPE = 32, QW = 768, FF = 2816;
constexpr float NORM_EPS = 1e-5f, DN_ALPHA = 1.189207115002721f;
constexpr float ATT_SC = 0.10206207261596575f * 1.4426950408889634f;
constexpr size_t O_YP = 0, O_YS = 33554432, O_CKVP = 34078720, O_KRP = 42532864, O_GLAP = 43589632, O_CONVP = 44113920, O_CKVS = 44204032, O_KRS = 44335104, O_GLAS = 44351488, O_CONVS = 48545792, O_END = 49266688;
constexpr size_t MiB = 1u << 20;
constexpr size_t WS_CTL = 0, CTL_ZERO_BYTES = 1 * MiB, WS_ROPE = 1 * MiB, WS_WIN = 2 * MiB, WS_WUQ = 7 * MiB, WS_WKV = 8 * MiB, WS_WO = 9 * MiB, WS_WFFN = 11 * MiB, WS_WDOWN = 22 * MiB;
constexpr size_t WS_XN = 32 * MiB, WS_Z = 98 * MiB, WS_CQN = 246 * MiB, WS_CKV = 271 * MiB, WS_KR = 288 * MiB, WS_Q = 291 * MiB, WS_KV = 341 * MiB, WS_AO = 407 * MiB, WS_Y1 = 473 * MiB, WS_H1 = 604 * MiB;
constexpr size_t WS_G = 670 * MiB, WS_Y2 = 851 * MiB, WS_KVC = 982 * MiB, WS_DEC = 1047 * MiB, WS_ST = 1048 * MiB, WS_HALO = 1081 * MiB, WS_SL5 = 1084 * MiB, WS_SL9 = 1097 * MiB, WS_GQA = 1120 * MiB, WS_END = 1153 * MiB;
static_assert(WS_WIN + (size_t)ZC * DM * 2 <= WS_WUQ && WS_WFFN + (size_t)2 * FF * DM * 2 <= WS_WDOWN && WS_WDOWN + (size_t)DM * FF * 2 <= WS_XN, "weights map");
static_assert(WS_XN + (size_t)RTOT * DM * 2 <= WS_Z && WS_Z + (size_t)RTOT * ZC * 2 <= WS_CQN && WS_CQN + (size_t)RTOT * QL * 2 <= WS_CKV && WS_CKV + (size_t)RTOT * KVL * 2 <= WS_KR && WS_KR + (size_t)RTOT * ROPE * 2 <= WS_Q, "act map 1");
static_assert(WS_Q + (size_t)RTOT * QW * 2 <= WS_KV && WS_KV + (size_t)RTOT * 1024 * 2 <= WS_AO && WS_AO + (size_t)RTOT * DM * 2 <= WS_Y1 && WS_Y1 + (size_t)RTOT * DM * 4 <= WS_H1 && WS_H1 + (size_t)RTOT * DM * 2 <= WS_G, "act map 2");
static_assert(WS_G + (size_t)RTOT * FF * 2 <= WS_Y2 && WS_Y2 + (size_t)RTOT * DM * 4 <= WS_KVC && WS_KVC + (size_t)2052 * 32768 <= WS_DEC && WS_DEC + (size_t)2052 * 256 <= WS_ST && WS_ST + (size_t)2048 * 16384 <= WS_HALO && WS_HALO + (size_t)128 * 2 * FF * 4 <= WS_SL5 && WS_SL5 + (size_t)4 * 768 * DM * 4 <= WS_SL9 && WS_SL9 + (size_t)11 * 512 * DM * 4 <= WS_GQA && WS_GQA + (size_t)2052 * 16384 <= WS_END, "act map 3");
constexpr int CW_TMO = 0, CW_QUEUE = 64, CW_BAR = 4096;
constexpr int RING_OFF = 0, RING_BYTES = 131072, XTRA_OFF = RING_BYTES, XTRA_BYTES = 4096, LDSCTL_OFF = XTRA_OFF + XTRA_BYTES, MISC_OFF = LDSCTL_OFF + 320, LDSCTL_END = LDSCTL_OFF + 4096,
              WG_OFF = LDSCTL_END, WG_BYTES = 16 * 256 * 4 + 1024, LDS_BYTES = 163840;
static_assert(MISC_OFF + 128 <= LDSCTL_END && WG_OFF + WG_BYTES <= LDS_BYTES, "LDS map");
#ifndef SUBPROBE
#define SUBPROBE 0
#endif
constexpr int NPH = 11;
#ifndef MK_N_LAUNCHES
#define MK_N_LAUNCHES 1
#endif
constexpr int N_LAUNCHES = MK_N_LAUNCHES;

#define LDS_BARRIER() do { asm volatile("s_waitcnt lgkmcnt(0)" ::: "memory"); __builtin_amdgcn_s_barrier(); asm volatile("" ::: "memory"); } while (0)
typedef float f32x16 __attribute__((ext_vector_type(16)));
typedef unsigned u32x2 __attribute__((ext_vector_type(2)));
typedef short s16x4 __attribute__((ext_vector_type(4)));
typedef LAS unsigned char* ldsp;
__device__ __forceinline__ float bf2f(unsigned short x) { return __uint_as_float((unsigned)x << 16); }
__device__ __forceinline__ float bflo(unsigned x) { return __uint_as_float(x << 16); }
__device__ __forceinline__ float bfhi(unsigned x) { return __uint_as_float(x & 0xffff0000u); }
__device__ __forceinline__ int crow(int r, int hi) { return (r & 3) + 8 * (r >> 2) + 4 * hi; }
__device__ __forceinline__ float wave_sum(float v) {
#pragma unroll
    for (int o = 1; o < 64; o <<= 1) v += __shfl_xor(v, o);
    return v;
}
__device__ __forceinline__ s16x4 tr_read(const LAS unsigned char* p) { return __builtin_bit_cast(s16x4, __builtin_amdgcn_ds_read_tr16_b64_v4i16((LAS s16x4*)p)); }
__device__ __forceinline__ bf16x8 cat4(s16x4 a, s16x4 b) { return (bf16x8){a[0], a[1], a[2], a[3], b[0], b[1], b[2], b[3]}; }
__device__ __forceinline__ unsigned pkbf(float lo, float hi) { unsigned r; asm("v_cvt_pk_bf16_f32 %0, %1, %2" : "=v"(r) : "v"(lo), "v"(hi)); return r; }
__device__ __forceinline__ bf16x8 pack8(float a, float b, float c, float d, float e, float f, float g, float h) { v4u w; w.x = pkbf(a, b); w.y = pkbf(c, d); w.z = pkbf(e, f); w.w = pkbf(g, h); return __builtin_bit_cast(bf16x8, w); }
__device__ __forceinline__ void lds_mma32(f32x16& acc, const LAS unsigned char* a, int sa, const LAS unsigned char* bt, int sb, int m0, int n0, int K, int lane) {
    const int r = lane & 31, h = lane >> 5;
    const LAS unsigned char* pa = a + (m0 + r) * sa + h * 16; const LAS unsigned char* pb = bt + (n0 + r) * sb + h * 16;
#pragma unroll 4
    for (int k = 0; k < K; k += 16) acc = __builtin_amdgcn_mfma_f32_32x32x16_bf16(*(const LAS bf16x8*)(pa + k * 2), *(const LAS bf16x8*)(pb + k * 2), acc, 0, 0, 0);
}

__device__ __forceinline__ const void* kin(int i) { return (const void*)((const __attribute__((address_space(4))) unsigned long long*)__builtin_amdgcn_kernarg_segment_ptr())[i]; }
struct Frame {
    ldsp lds; volatile LAS unsigned* MISC; gu32* ctl;
    int tid, lane, wave, G, bid;
    float* out; unsigned char* ws;
    __device__ __forceinline__ const float* x_prompt() const { return (const float*)kin(0); }
    __device__ __forceinline__ const float* x_sample() const { return (const float*)kin(1); }
    __device__ __forceinline__ const float* cache_ckv() const { return (const float*)kin(2); }
    __device__ __forceinline__ const float* cache_krope() const { return (const float*)kin(3); }
    __device__ __forceinline__ const int* page_table() const { return (const int*)kin(4); }
    __device__ __forceinline__ const float* state_gla() const { return (const float*)kin(5); }
    __device__ __forceinline__ const float* state_conv() const { return (const float*)kin(6); }
    __device__ __forceinline__ const float* meta() const { return (const float*)kin(7); }
    __device__ __forceinline__ const float* ln_emb_g() const { return (const float*)kin(8); }
    __device__ __forceinline__ const float* ln_emb_b() const { return (const float*)kin(9); }
    __device__ __forceinline__ const float* w_in() const { return (const float*)kin(10); }
    __device__ __forceinline__ const float* w_gate_up() const { return (const float*)kin(11); }
    __device__ __forceinline__ const float* b_gate() const { return (const float*)kin(12); }
    __device__ __forceinline__ const float* gla_norm_g() const { return (const float*)kin(13); }
    __device__ __forceinline__ const float* q_norm_g() const { return (const float*)kin(14); }
    __device__ __forceinline__ const float* kv_norm_g() const { return (const float*)kin(15); }
    __device__ __forceinline__ const float* w_uq() const { return (const float*)kin(16); }
    __device__ __forceinline__ const float* w_uk() const { return (const float*)kin(17); }
    __device__ __forceinline__ const float* w_uv() const { return (const float*)kin(18); }
    __device__ __forceinline__ const float* w_o() const { return (const float*)kin(19); }
    __device__ __forceinline__ const float* ln1_g() const { return (const float*)kin(20); }
    __device__ __forceinline__ const float* ln1_b() const { return (const float*)kin(21); }
    __device__ __forceinline__ const float* w_ffn_in() const { return (const float*)kin(22); }
    __device__ __forceinline__ const float* conv_w() const { return (const float*)kin(23); }
    __device__ __forceinline__ const float* conv_b() const { return (const float*)kin(24); }
    __device__ __forceinline__ const float* w_down() const { return (const float*)kin(25); }
    __device__ __forceinline__ const float* ln2_g() const { return (const float*)kin(26); }
    __device__ __forceinline__ const float* ln2_b() const { return (const float*)kin(27); }
    __device__ __forceinline__ bf16* Win_t() const { return (bf16*)(ws + WS_WIN); }
    __device__ __forceinline__ bf16* Wuq_t() const { return (bf16*)(ws + WS_WUQ); }
    __device__ __forceinline__ bf16* Wkv_t() const { return (bf16*)(ws + WS_WKV); }
    __device__ __forceinline__ bf16* Wo_t() const { return (bf16*)(ws + WS_WO); }
    __device__ __forceinline__ bf16* Wffn_t() const { return (bf16*)(ws + WS_WFFN); }
    __device__ __forceinline__ bf16* Wdown_t() const { return (bf16*)(ws + WS_WDOWN); }
    __device__ __forceinline__ bf16* XN() const { return (bf16*)(ws + WS_XN); }
    __device__ __forceinline__ bf16* Z() const { return (bf16*)(ws + WS_Z); }
    __device__ __forceinline__ bf16* CQN() const { return (bf16*)(ws + WS_CQN); }
    __device__ __forceinline__ bf16* CKV() const { return (bf16*)(ws + WS_CKV); }
    __device__ __forceinline__ bf16* KR() const { return (bf16*)(ws + WS_KR); }
    __device__ __forceinline__ bf16* Q() const { return (bf16*)(ws + WS_Q); }
    __device__ __forceinline__ bf16* KV() const { return (bf16*)(ws + WS_KV); }
    __device__ __forceinline__ bf16* AO() const { return (bf16*)(ws + WS_AO); }
    __device__ __forceinline__ bf16* H1() const { return (bf16*)(ws + WS_H1); }
    __device__ __forceinline__ bf16* Gb() const { return (bf16*)(ws + WS_G); }
    __device__ __forceinline__ bf16* ST() const { return (bf16*)(ws + WS_ST); }
    __device__ __forceinline__ bf16* Y1() const { return (bf16*)(ws + WS_Y1); }
    __device__ __forceinline__ bf16* Y2() const { return (bf16*)(ws + WS_Y2); }
    __device__ __forceinline__ float* ROPE_T() const { return (float*)(ws + WS_ROPE); }
    __device__ __forceinline__ bf16* KVC() const { return (bf16*)(ws + WS_KVC); }
    __device__ __forceinline__ float* DEC() const { return (float*)(ws + WS_DEC); }
    __device__ __forceinline__ float* HALO() const { return (float*)(ws + WS_HALO); }
    __device__ __forceinline__ bf16* GQA() const { return (bf16*)(ws + WS_GQA); }
    __device__ __forceinline__ bf16* SL5() const { return (bf16*)(ws + WS_SL5); }
    __device__ __forceinline__ bf16* SL9() const { return (bf16*)(ws + WS_SL9); }
};


template <bool ZMAP = false> __device__ __forceinline__ void p0_transpose_item(const float* W, int K, int N, bf16* WT, int k0, int n0, int drow0, LAS float* scr, int lane) {
    float t_[32];
#pragma unroll
    for (int i = 0; i < 32; ++i) { const int kk = 2 * i + (lane >> 5), n = ZMAP ? zsrc(n0 + (lane & 31)) : n0 + (lane & 31); t_[i] = (n >= 0 && n < N) ? W[(size_t)(k0 + kk) * N + n] : 0.f; }
#pragma unroll
    for (int i = 0; i < 32; ++i) scr[(2 * i + (lane >> 5)) * 33 + (lane & 31)] = t_[i];
    LDS_WAIT(); asm volatile("" ::: "memory");
    const int c = lane & 7;
#pragma unroll
    for (int j = 0; j < 4; ++j) { const int n = (lane >> 3) + 8 * j; const LAS float* s = scr + (8 * c) * 33 + n;
        v4u o; o.x = pk2(s[0 * 33], s[1 * 33]); o.y = pk2(s[2 * 33], s[3 * 33]); o.z = pk2(s[4 * 33], s[5 * 33]); o.w = pk2(s[6 * 33], s[7 * 33]);
        *(GAS v4u*)(WT + (size_t)(drow0 + n) * K + k0 + 8 * c) = o; }
    LDS_WAIT(); asm volatile("" ::: "memory");
}
__device__ __forceinline__ void ln_rows4_bf16(const float* x0, const float* g, const float* b, bf16* o0, int lane) {
    if (!x0) {
#pragma unroll
        for (int r = 0; r < 4; ++r) { GAS unsigned long long* o8 = (GAS unsigned long long*)(o0 + (size_t)r * DM) + lane;
#pragma unroll
            for (int j = 0; j < 4; ++j) o8[64 * j] = 0ull; }
        return; }
    f32x4 v[4][4]; float s[4], s2[4], mean[4], rstd[4];
#pragma unroll
    for (int r = 0; r < 4; ++r) { const GAS f32x4* xr = (const GAS f32x4*)(x0 + (size_t)r * DM) + lane;
#pragma unroll
        for (int j = 0; j < 4; ++j) v[r][j] = __builtin_nontemporal_load(xr + 64 * j); }
#pragma unroll
    for (int r = 0; r < 4; ++r) { s[r] = 0.f;
#pragma unroll
        for (int j = 0; j < 4; ++j) s[r] += (v[r][j].x + v[r][j].y) + (v[r][j].z + v[r][j].w); }
#pragma unroll
    for (int o = 1; o < 64; o <<= 1) {
#pragma unroll
        for (int r = 0; r < 4; ++r) s[r] += __shfl_xor(s[r], o); }
#pragma unroll
    for (int r = 0; r < 4; ++r) { mean[r] = s[r] * (1.f / DM); s2[r] = 0.f;
#pragma unroll
        for (int j = 0; j < 4; ++j) { v[r][j] = v[r][j] - mean[r]; s2[r] += (v[r][j].x * v[r][j].x + v[r][j].y * v[r][j].y) + (v[r][j].z * v[r][j].z + v[r][j].w * v[r][j].w); } }
#pragma unroll
    for (int o = 1; o < 64; o <<= 1) {
#pragma unroll
        for (int r = 0; r < 4; ++r) s2[r] += __shfl_xor(s2[r], o); }
#pragma unroll
    for (int r = 0; r < 4; ++r) rstd[r] = 1.f / sqrtf(s2[r] * (1.f / DM) + NORM_EPS);
#pragma unroll
    for (int j = 0; j < 4; ++j) { const f32x4 gg = *((const GAS f32x4*)g + lane + 64 * j), bb = *((const GAS f32x4*)b + lane + 64 * j);
#pragma unroll
        for (int r = 0; r < 4; ++r) { const f32x4 y = v[r][j] * rstd[r] * gg + bb; ((GAS unsigned long long*)(o0 + (size_t)r * DM) + lane)[64 * j] = (unsigned long long)pk2(y.x, y.y) | ((unsigned long long)pk2(y.z, y.w) << 32); } }
}
__device__ __forceinline__ void p0_prologue(Frame& F) {
    LAS float* scr = (LAS float*)(F.lds + RING_OFF + F.wave * 16384);
    const int gw = F.bid * NWAVES + F.wave, NGW = F.G * NWAVES;
    constexpr int I_IN = 16 * 72, I_UQ = 6 * 24, I_UK = 4 * 16, I_UV = 4 * 16;
    constexpr int NITEMS = I_IN + I_UQ + I_UK + I_UV;
    for (int rep0_ = 0; rep0_ < (((SUBPROBE) & 16) ? 2 : 1); ++rep0_)
    for (int it = gw; it < NITEMS; it += NGW) {
        int r = it;
        if (r < I_IN) { const int kb = r / 72, nb = r % 72; p0_transpose_item<true>(F.w_in(), DM, ZEND, F.Win_t(), 64 * kb, 32 * nb, 32 * nb, scr, F.lane); continue; } r -= I_IN;
        if (r < I_UQ) { const int kb = r / 24, nb = r % 24; p0_transpose_item(F.w_uq(), QL, QW, F.Wuq_t(), 64 * kb, 32 * nb, 32 * nb, scr, F.lane); continue; } r -= I_UQ;
        if (r < I_UK) { const int kb = r / 16, nb = r % 16; p0_transpose_item(F.w_uk(), KVL, 512, F.Wkv_t(), 64 * kb, 32 * nb, 32 * nb, scr, F.lane); continue; } r -= I_UK;
        { const int kb = r / 16, nb = r % 16; p0_transpose_item(F.w_uv(), KVL, 512, F.Wkv_t(), 64 * kb, 32 * nb, 512 + 32 * nb, scr, F.lane); }
    }
    for (int rep1_ = 0; rep1_ < (((SUBPROBE) & 32) ? 2 : 1); ++rep1_)
    for (int m = 4 * gw; m < RTOT; m += 4 * NGW) {
        const float* src = m < R_PROMPT ? F.x_prompt() + (size_t)m * DM : m < R_META0 ? F.x_sample() + (size_t)(m - R_SAMPLE0) * DM : m < R_VALID ? F.meta() + (size_t)(m - R_META0) * DM : nullptr;
        ln_rows4_bf16(src, F.ln_emb_g(), F.ln_emb_b(), F.XN() + (size_t)m * DM, F.lane);
    }
    for (int i = F.bid * NTHR + F.tid; i < (LTOT + DS) * 16; i += F.G * NTHR) { const int p = i >> 4, k = i & 15; const float pos = (float)(p < LTOT ? p : 8192 + (p - LTOT));
        const float inv = exp2f(-(float)k * (13.287712379549449f / 16.0f)); const float ang = pos * inv;
        const double tw = 6.283185307179586476925; const double n = rint((double)ang / tw); const float rr = (float)((double)ang - n * tw);
        F.ROPE_T()[p * 32 + k] = cosf(rr); F.ROPE_T()[p * 32 + 16 + k] = sinf(rr); }
}

__device__ __forceinline__ void late_transposes(Frame& F, int which, int first) {
    if (F.bid < first) return;
    LAS float* scr = (LAS float*)(F.lds + RING_OFF + F.wave * 16384);
    const int gw = (F.bid - first) * NWAVES + F.wave, NGW = (F.G - first) * NWAVES;
    constexpr int I_O = 16 * 32, I_FF = 16 * 176, I_DN = 44 * 32;
    if (which == 0) {
        for (int it = gw; it < I_O + I_FF; it += NGW) {
            if (it < I_O) { const int kb = it / 32, nb = it % 32; p0_transpose_item(F.w_o(), DM, DM, F.Wo_t(), 64 * kb, 32 * nb, 32 * nb, scr, F.lane); }
            else { const int r = it - I_O, kb = r / 176, nb = r % 176; const int n0 = 32 * nb, half = n0 >= FF ? 1 : 0, ch = n0 - half * FF;
                p0_transpose_item(F.w_ffn_in(), DM, 2 * FF, F.Wffn_t(), 64 * kb, n0, 256 * (ch >> 7) + 128 * half + (ch & 127), scr, F.lane); } }
    } else {
        for (int it = gw; it < I_DN; it += NGW) { const int kb = it / 32, nb = it % 32; p0_transpose_item(F.w_down(), FF, DM, F.Wdown_t(), 64 * kb, 32 * nb, 32 * nb, scr, F.lane); }
    }
}

__device__ __forceinline__ void p2_rows8(Frame& F, int m0) {
    const int lane = F.lane; const v4u z4 = (v4u){0u, 0u, 0u, 0u};
    v4u w[8]; float ss[8];
#pragma unroll
    for (int r = 0; r < 8; ++r) w[r] = (lane < 48) ? *(const GAS v4u*)(F.Z() + (size_t)(m0 + r) * ZC + ZCQ + 8 * lane) : z4;
#pragma unroll
    for (int r = 0; r < 8; ++r) { const float a = bflo(w[r].x), b = bfhi(w[r].x), c = bflo(w[r].y), d = bfhi(w[r].y), e = bflo(w[r].z), f = bfhi(w[r].z), g = bflo(w[r].w), h = bfhi(w[r].w);
        ss[r] = (a * a + b * b) + (c * c + d * d) + (e * e + f * f) + (g * g + h * h); }
#pragma unroll
    for (int o = 1; o < 64; o <<= 1) {
#pragma unroll
        for (int r = 0; r < 8; ++r) ss[r] += __shfl_xor(ss[r], o); }
    if (lane < 48) { const f32x4 g0 = *(const GAS f32x4*)(F.q_norm_g() + 8 * lane), g1 = *(const GAS f32x4*)(F.q_norm_g() + 8 * lane + 4);
#pragma unroll
        for (int r = 0; r < 8; ++r) { const float rs = 1.f / sqrtf(ss[r] * (1.f / QL) + NORM_EPS);
            v4u o; o.x = pk2(bflo(w[r].x) * rs * g0.x, bfhi(w[r].x) * rs * g0.y); o.y = pk2(bflo(w[r].y) * rs * g0.z, bfhi(w[r].y) * rs * g0.w); o.z = pk2(bflo(w[r].z) * rs * g1.x, bfhi(w[r].z) * rs * g1.y); o.w = pk2(bflo(w[r].w) * rs * g1.z, bfhi(w[r].w) * rs * g1.w);
            *(GAS v4u*)(F.CQN() + (size_t)(m0 + r) * QL + 8 * lane) = o; } }
}
constexpr int GL_WT = 0, GL_GM = 2048, GL_A0 = 4096;
constexpr int GL_S64 = 144, GL_T64 = 192, GL_T128 = 320;
constexpr int GL1_KD = GL_A0, GL1_V = GL1_KD + 64 * GL_T64, GL1_QM = GL1_V + 64 * GL_T128, GL1_KM = GL1_QM + 64 * GL_S64, GL1_END = GL1_KM + 64 * GL_S64;
constexpr int GL3_QD = GL_A0, GL3_ATT = GL3_QD + 64 * GL_S64, GL3_ST = GL3_ATT + 64 * GL_S64, GL3_V = GL3_ST + 128 * GL_S64, GL3_OL = GL3_V + 64 * GL_T128, GL3_END = GL3_OL + 64 * 132 * 4;
static_assert(GL3_END <= RING_BYTES && GL1_END <= RING_BYTES, "GLA LDS map");
constexpr float LOG2E = 1.4426950408889634f, LN2 = 0.6931471805599453f;
__device__ __forceinline__ float fexp(float x) { return __builtin_amdgcn_exp2f(x * LOG2E); }
__device__ __forceinline__ float logsigmoid_f(float x) { return fminf(x, 0.f) - LN2 * __builtin_amdgcn_logf(1.f + __builtin_amdgcn_exp2f(-fabsf(x) * LOG2E)); }
__device__ __forceinline__ float fsilu(float x) { return x * __builtin_amdgcn_rcpf(1.f + __builtin_amdgcn_exp2f(-x * LOG2E)); }
__device__ __forceinline__ void unpack8(v4u w, float (&v)[8]) { v[0] = bflo(w.x); v[1] = bfhi(w.x); v[2] = bflo(w.y); v[3] = bfhi(w.y); v[4] = bflo(w.z); v[5] = bfhi(w.z); v[6] = bflo(w.w); v[7] = bfhi(w.w); }
__device__ __forceinline__ bf16x8 frag_tr(const LAS unsigned char* img, int stride, int k0, int n0, int lane) {
    const int h = lane >> 5, blk = (lane >> 4) & 1, qq = (lane & 15) >> 2, pp = lane & 3;
    const LAS unsigned char* p = img + (k0 + 8 * h + qq) * stride + (n0 + 16 * blk + 4 * pp) * 2;
    return cat4(tr_read(p), tr_read(p + 4 * stride));
}
__device__ __forceinline__ void gla_stage_wg(Frame& F) {
    LAS float* WG = (LAS float*)(F.lds + WG_OFF);
    for (int i = F.tid; i < 16 * 256 / 4; i += NTHR) *(LAS f32x4*)(WG + 4 * i) = *(const GAS f32x4*)(F.w_gate_up() + 4 * i);
    if (F.tid < 64) *(LAS f32x4*)(WG + 4096 + 4 * F.tid) = *(const GAS f32x4*)(F.b_gate() + 4 * F.tid);
}
struct GlaGeom { int row0, nvalid, h, mid; };
__device__ __forceinline__ GlaGeom gla_unit_geom(int unit) { GlaGeom g;
    if (unit < 2048) { const int bh = unit >> 5, c = unit & 31; g.row0 = (bh >> 2) * SEQ + 64 * c; g.h = bh & 3; g.nvalid = 64; g.mid = 32; } else { g.row0 = R_META0; g.h = unit - 2048; g.nvalid = NMETA; g.mid = 8; }
    return g; }
__device__ __forceinline__ void gla_decay(Frame& F, ldsp L, v4u a0, v4u a1, GlaGeom gm, float (&b)[8], float (&bm)[8], float (&bl)[8]) {
    const int tid = F.tid, lane = F.lane, wave = F.wave, i = tid >> 3, c = tid & 7;
    const LAS float* WG = (const LAS float*)(F.lds + WG_OFF) + 64 * gm.h + 8 * c;
    LAS float* WT = (LAS float*)(L + GL_WT); LAS float* GM = (LAS float*)(L + GL_GM);
    float al[16]; { float t0[8], t1[8]; unpack8(a0, t0); unpack8(a1, t1);
#pragma unroll
        for (int r = 0; r < 8; ++r) { al[r] = t0[r]; al[8 + r] = t1[r]; } }
    { const f32x4 g0 = *(const LAS f32x4*)(WG + 4096), g1 = *(const LAS f32x4*)(WG + 4096 + 4); b[0] = g0.x; b[1] = g0.y; b[2] = g0.z; b[3] = g0.w; b[4] = g1.x; b[5] = g1.y; b[6] = g1.z; b[7] = g1.w; }
#pragma unroll
    for (int r = 0; r < 16; ++r) { if ((r & 3) == 0) __builtin_amdgcn_sched_barrier(0);
        const f32x4 w0 = *(const LAS f32x4*)(WG + 256 * r), w1 = *(const LAS f32x4*)(WG + 256 * r + 4);
        b[0] += al[r] * w0.x; b[1] += al[r] * w0.y; b[2] += al[r] * w0.z; b[3] += al[r] * w0.w; b[4] += al[r] * w1.x; b[5] += al[r] * w1.y; b[6] += al[r] * w1.z; b[7] += al[r] * w1.w; }
    const bool live = i < gm.nvalid;
#pragma unroll
    for (int j = 0; j < 8; ++j) b[j] = live ? logsigmoid_f(b[j]) * (1.f / 16.f) : 0.f;
#pragma unroll
    for (int off = 8; off < 64; off <<= 1) {
#pragma unroll
        for (int j = 0; j < 8; ++j) { const float t = __shfl_up(b[j], off); b[j] += (lane >= off) ? t : 0.f; } }
    if ((lane >> 3) == 7) { *(LAS f32x4*)(WT + wave * 64 + 8 * c) = (f32x4){b[0], b[1], b[2], b[3]}; *(LAS f32x4*)(WT + wave * 64 + 8 * c + 4) = (f32x4){b[4], b[5], b[6], b[7]}; }
    if (i == gm.mid) { *(LAS f32x4*)(GM + 8 * c) = (f32x4){b[0], b[1], b[2], b[3]}; *(LAS f32x4*)(GM + 8 * c + 4) = (f32x4){b[4], b[5], b[6], b[7]}; }
    LDS_BARRIER();
    const int wm = gm.mid >> 3;
    float pre[8];
#pragma unroll
    for (int j = 0; j < 8; ++j) { pre[j] = 0.f; bm[j] = 0.f; bl[j] = 0.f; }
#pragma unroll
    for (int w = 0; w < 8; ++w) { const f32x4 t0 = *(const LAS f32x4*)(WT + w * 64 + 8 * c), t1 = *(const LAS f32x4*)(WT + w * 64 + 8 * c + 4);
        const float t[8] = {t0.x, t0.y, t0.z, t0.w, t1.x, t1.y, t1.z, t1.w};
#pragma unroll
        for (int j = 0; j < 8; ++j) { pre[j] += (w < wave) ? t[j] : 0.f; bm[j] += (w < wm) ? t[j] : 0.f; bl[j] += t[j]; } }
    { const f32x4 t0 = *(const LAS f32x4*)(GM + 8 * c), t1 = *(const LAS f32x4*)(GM + 8 * c + 4);
      bm[0] += t0.x; bm[1] += t0.y; bm[2] += t0.z; bm[3] += t0.w; bm[4] += t1.x; bm[5] += t1.y; bm[6] += t1.z; bm[7] += t1.w; }
#pragma unroll
    for (int j = 0; j < 8; ++j) b[j] += pre[j];
}
struct Gla1Regs { v4u a0, a1, q8, k8, v0, v1; };
__device__ __forceinline__ Gla1Regs gla1_load(Frame& F, int unit) { Gla1Regs r; const v4u z4 = (v4u){0u, 0u, 0u, 0u}; r.a0 = z4; r.a1 = z4; r.q8 = z4; r.k8 = z4; r.v0 = z4; r.v1 = z4;
    const GlaGeom gm = gla_unit_geom(unit); const int i = F.tid >> 3, c = F.tid & 7;
    if (i < gm.nvalid) { const bf16* zr = F.Z() + (size_t)(gm.row0 + i) * ZC; r.a0 = *(const GAS v4u*)(zr + ZA); r.a1 = *(const GAS v4u*)(zr + ZA + 8); r.q8 = *(const GAS v4u*)(zr + ZQ + 64 * gm.h + 8 * c); r.k8 = *(const GAS v4u*)(zr + ZK + 64 * gm.h + 8 * c);
        r.v0 = *(const GAS v4u*)(zr + ZV + 128 * gm.h + 16 * c); r.v1 = *(const GAS v4u*)(zr + ZV + 128 * gm.h + 16 * c + 8); }
    return r; }
__device__ __forceinline__ void gla_pass1_units(Frame& F, ldsp L, int base, int per, int extra) {
    const int nun = per + (extra >= 0 ? 1 : 0); if (nun <= 0) return;
#define GL1_UNIT(n) ((n) < per ? base + (n) : extra)
    const int wave = F.wave;
    Gla1Regs nx = gla1_load(F, GL1_UNIT(0));
    for (int n = 0; n < nun; ++n) { const int unit = GL1_UNIT(n);
        int tid = F.tid; asm volatile("" : "+v"(tid));
        const int lane = tid & 63, i = tid >> 3, c = tid & 7;
        const Gla1Regs cu = nx; const GlaGeom gm = gla_unit_geom(unit);
        float b[8], bm[8], bl[8]; gla_decay(F, L, cu.a0, cu.a1, gm, b, bm, bl);
        __builtin_amdgcn_sched_barrier(0);
        { float q[8], k[8], qd[8], qm[8], km[8], kd[8]; unpack8(cu.q8, q); unpack8(cu.k8, k);
#pragma unroll
          for (int j = 0; j < 8; ++j) { const float qs = q[j] * 0.125f; qd[j] = qs * fexp(b[j]); qm[j] = qs * fexp(b[j] - bm[j]); km[j] = k[j] * fexp(bm[j] - b[j]); kd[j] = k[j] * fexp(bl[j] - b[j]); }
          *(LAS bf16x8*)(L + GL1_KD + i * GL_T64 + 16 * c) = pack8(kd[0], kd[1], kd[2], kd[3], kd[4], kd[5], kd[6], kd[7]);
          *(LAS bf16x8*)(L + GL1_QM + i * GL_S64 + 16 * c) = pack8(qm[0], qm[1], qm[2], qm[3], qm[4], qm[5], qm[6], qm[7]);
          *(LAS bf16x8*)(L + GL1_KM + i * GL_S64 + 16 * c) = pack8(km[0], km[1], km[2], km[3], km[4], km[5], km[6], km[7]);
          *(LAS v4u*)(L + GL1_V + i * GL_T128 + 32 * c) = cu.v0; *(LAS v4u*)(L + GL1_V + i * GL_T128 + 32 * c + 16) = cu.v1;
          *(GAS bf16x8*)(F.GQA() + (size_t)unit * 8192 + i * 64 + 8 * c) = pack8(qd[0], qd[1], qd[2], qd[3], qd[4], qd[5], qd[6], qd[7]);
          if (tid < 8) { float* dp = F.DEC() + (size_t)unit * 64 + 8 * c; *(GAS f32x4*)dp = (f32x4){fexp(bl[0]), fexp(bl[1]), fexp(bl[2]), fexp(bl[3])}; *(GAS f32x4*)(dp + 4) = (f32x4){fexp(bl[4]), fexp(bl[5]), fexp(bl[6]), fexp(bl[7])}; } }
        __builtin_amdgcn_sched_barrier(0);
        if (n + 1 < nun) nx = gla1_load(F, GL1_UNIT(n + 1));
        LDS_BARRIER();
        { f32x16 acc = {}; const int m0 = 32 * (wave >> 1), n0 = 32 * (wave & 1);
#pragma unroll
          for (int k0 = 0; k0 < 64; k0 += 16) acc = __builtin_amdgcn_mfma_f32_32x32x16_bf16(frag_tr(L + GL1_V, GL_T128, k0, m0, lane), frag_tr(L + GL1_KD, GL_T64, k0, n0, lane), acc, 0, 0, 0);
          bf16* dst = F.KVC() + (size_t)unit * 8192 + n0 + (lane & 31);
#pragma unroll
          for (int r = 0; r < 16; ++r) dst[(m0 + crow(r, lane >> 5)) * 64] = (bf16)f2bf(acc[r]); }
        if (wave < 4) { f32x16 at = {}; const int m0 = 32 * (wave >> 1), n0 = 32 * (wave & 1);
            if (!(m0 == 0 && n0 == 32)) lds_mma32(at, L + GL1_QM, GL_S64, L + GL1_KM, GL_S64, m0, n0, 64, lane);
            const int j = n0 + (lane & 31); bf16* ap = F.GQA() + (size_t)unit * 8192 + 4096 + j;
#pragma unroll
            for (int r = 0; r < 16; ++r) { const int ii = m0 + crow(r, lane >> 5); ap[ii * 64] = (bf16)f2bf(j <= ii ? at[r] : 0.f); } }
    }
#undef GL1_UNIT
    __syncthreads();
}
__device__ __forceinline__ void gla_pass2(Frame& F) {
    for (int it = F.bid * NTHR + F.tid; it < 64 * 2048; it += F.G * NTHR) {
        const int bh = it >> 11, q = it & 2047, e = q >> 4, d0 = (q & 15) * 4, h = bh & 3, b = bh >> 2;
        f32x4 S; { const u32x2 w0 = *(const GAS u32x2*)(F.KVC() + (size_t)(2048 + h) * 8192 + e * 64 + d0); S = (f32x4){bflo(w0.x), bfhi(w0.x), bflo(w0.y), bfhi(w0.y)}; }
        for (int c = 0; c < 32; ++c) { const size_t u = (size_t)bh * 32 + c;
            const u32x2 kw = *(const GAS u32x2*)(F.KVC() + u * 8192 + e * 64 + d0); const f32x4 kv = (f32x4){bflo(kw.x), bfhi(kw.x), bflo(kw.y), bfhi(kw.y)}, dc = *(const GAS f32x4*)(F.DEC() + u * 64 + d0);
            u32x2 w; w.x = pk2(S.x, S.y); w.y = pk2(S.z, S.w); *(GAS u32x2*)(F.ST() + u * 8192 + e * 64 + d0) = w;
            S = dc * S + kv; }
        float* o = F.out + O_GLAP + ((size_t)(b * 4 + h) * 64 + d0) * 128 + e; o[0] = S.x; o[128] = S.y; o[256] = S.z; o[384] = S.w;
    }
}
__device__ __forceinline__ void gla_norm_gate_store(Frame& F, const LAS float* OL, int row0, int nvalid, int h, v4u g0, v4u g1) {
    const int i = F.tid >> 3, seg = F.tid & 7; const LAS float* o = OL + i * 132 + 16 * seg;
    float v[16]; float ss = 0.f;
#pragma unroll
    for (int j4 = 0; j4 < 4; ++j4) { const f32x4 t = *(const LAS f32x4*)(o + 4 * j4); v[4 * j4] = t.x; v[4 * j4 + 1] = t.y; v[4 * j4 + 2] = t.z; v[4 * j4 + 3] = t.w; ss += (t.x * t.x + t.y * t.y) + (t.z * t.z + t.w * t.w); }
    ss += __shfl_xor(ss, 1); ss += __shfl_xor(ss, 2); ss += __shfl_xor(ss, 4);
    const float rs = 1.f / sqrtf(ss * (1.f / 128.f) + NORM_EPS);
    if (i < nvalid) { const size_t row = (size_t)(row0 + i);
        float ga[8], gb[8]; unpack8(g0, ga); unpack8(g1, gb);
        float y[16];
#pragma unroll
        for (int j4 = 0; j4 < 4; ++j4) { const f32x4 gn = *(const GAS f32x4*)(F.gla_norm_g() + 16 * seg + 4 * j4);
#pragma unroll
            for (int j = 0; j < 4; ++j) { const int jj = 4 * j4 + j; const float x = jj < 8 ? ga[jj & 7] : gb[jj & 7]; y[jj] = v[jj] * rs * gn[j] * fsilu(x); } }
        v4u a, b2; a.x = pk2(y[0], y[1]); a.y = pk2(y[2], y[3]); a.z = pk2(y[4], y[5]); a.w = pk2(y[6], y[7]); b2.x = pk2(y[8], y[9]); b2.y = pk2(y[10], y[11]); b2.z = pk2(y[12], y[13]); b2.w = pk2(y[14], y[15]);
        *(GAS v4u*)(F.AO() + row * DM + h * 128 + 16 * seg) = a; *(GAS v4u*)(F.AO() + row * DM + h * 128 + 16 * seg + 8) = b2; }
}
struct Gla3Regs { v4u qd, at, v0, v1, g0, g1, s0, s1; };
__device__ __forceinline__ Gla3Regs gla3_load(Frame& F, int unit) { Gla3Regs r; const v4u z4 = (v4u){0u, 0u, 0u, 0u}; r.v0 = z4; r.v1 = z4; r.g0 = z4; r.g1 = z4; r.s0 = z4; r.s1 = z4;
    const GlaGeom gm = gla_unit_geom(unit); const int i = F.tid >> 3, c = F.tid & 7;
    { const bf16* gq = F.GQA() + (size_t)unit * 8192 + F.tid * 8; r.qd = *(const GAS v4u*)gq; r.at = *(const GAS v4u*)(gq + 4096); }
    if (i < gm.nvalid) { const bf16* zr = F.Z() + (size_t)(gm.row0 + i) * ZC;
        r.v0 = *(const GAS v4u*)(zr + ZV + 128 * gm.h + 16 * c); r.v1 = *(const GAS v4u*)(zr + ZV + 128 * gm.h + 16 * c + 8); r.g0 = *(const GAS v4u*)(zr + ZG + 128 * gm.h + 16 * c); r.g1 = *(const GAS v4u*)(zr + ZG + 128 * gm.h + 16 * c + 8); }
    if (unit < 2048) { const bf16* st = F.ST() + (size_t)unit * 8192 + F.tid * 8; r.s0 = *(const GAS v4u*)st; r.s1 = *(const GAS v4u*)(st + 4096); }
    return r; }
__device__ __forceinline__ void gla_pass3_units(Frame& F, ldsp L, int u0, int u1) {
    if (u0 >= u1) return;
    int tid = F.tid; asm volatile("" : "+v"(tid));
    const int lane = tid & 63, wave = F.wave, i = tid >> 3, c = tid & 7;
    Gla3Regs nx = gla3_load(F, u0);
    for (int unit = u0; unit < u1; ++unit) {
        const Gla3Regs cu = nx; const GlaGeom gm = gla_unit_geom(unit); const bool has_state = unit < 2048;
        *(LAS v4u*)(L + GL3_QD + i * GL_S64 + 16 * c) = cu.qd; *(LAS v4u*)(L + GL3_ATT + i * GL_S64 + 16 * c) = cu.at;
        *(LAS v4u*)(L + GL3_V + i * GL_T128 + 32 * c) = cu.v0; *(LAS v4u*)(L + GL3_V + i * GL_T128 + 32 * c + 16) = cu.v1;
        if (has_state) { *(LAS v4u*)(L + GL3_ST + i * GL_S64 + 16 * c) = cu.s0; *(LAS v4u*)(L + GL3_ST + (64 + i) * GL_S64 + 16 * c) = cu.s1; }
        if (unit + 1 < u1) nx = gla3_load(F, unit + 1);
        LDS_BARRIER();
        f32x16 acc = {}; const int m0 = 32 * (wave >> 2), n0 = 32 * (wave & 3);
        if (has_state) lds_mma32(acc, L + GL3_QD, GL_S64, L + GL3_ST, GL_S64, m0, n0, 64, lane);
        { const int r = lane & 31, hh = lane >> 5; const LAS unsigned char* pa = L + GL3_ATT + (m0 + r) * GL_S64 + hh * 16;
#pragma unroll
          for (int k0 = 0; k0 < 64; k0 += 16) acc = __builtin_amdgcn_mfma_f32_32x32x16_bf16(*(const LAS bf16x8*)(pa + k0 * 2), frag_tr(L + GL3_V, GL_T128, k0, n0, lane), acc, 0, 0, 0); }
        { LAS float* OL = (LAS float*)(L + GL3_OL);
#pragma unroll
          for (int r = 0; r < 16; ++r) OL[(m0 + crow(r, lane >> 5)) * 132 + n0 + (lane & 31)] = acc[r]; }
        LDS_BARRIER();
        gla_norm_gate_store(F, (const LAS float*)(L + GL3_OL), gm.row0, gm.nvalid, gm.h, cu.g0, cu.g1);
    }
    __syncthreads();
}
constexpr int GS_G = 0, GS_QD = 1024, GS_KD = 2048, GS_DEC = 3072, GS_ATT = 3328, GS_V = 3584, GS_Q = 5632, GS_K = 6656, GS_PART = 8192, GS_OL = 16384;
__device__ __forceinline__ void gla_sample_unit(Frame& F, ldsp L, int unit) {
    const int tid = F.tid, sb = unit >> 2, h = unit & 3, row0 = R_SAMPLE0 + 4 * sb;
    LAS float* G4 = (LAS float*)(L + GS_G); LAS float* QD = (LAS float*)(L + GS_QD); LAS float* KD = (LAS float*)(L + GS_KD); LAS float* DEC = (LAS float*)(L + GS_DEC); LAS float* ATT = (LAS float*)(L + GS_ATT);
    LAS float* V4 = (LAS float*)(L + GS_V); LAS float* Q4 = (LAS float*)(L + GS_Q); LAS float* K4 = (LAS float*)(L + GS_K); LAS float* PART = (LAS float*)(L + GS_PART); LAS float* OL = (LAS float*)(L + GS_OL);
    const int e = tid & 127, dg = tid >> 7;
    float S[16];
    { const float* sp = F.state_gla() + ((size_t)(sb * 4 + h) * 64 + 16 * dg) * 128 + e;
#pragma unroll
      for (int dd = 0; dd < 16; ++dd) S[dd] = sp[dd * 128]; }
    v4u g0 = (v4u){0u, 0u, 0u, 0u}, g1 = g0;
    if ((tid >> 3) < 4) { const bf16* zr = F.Z() + (size_t)(row0 + (tid >> 3)) * ZC + ZG + 128 * h + 16 * (tid & 7); g0 = *(const GAS v4u*)zr; g1 = *(const GAS v4u*)(zr + 8); }
    if (tid < 256) { const int t = tid >> 6, d = tid & 63; const bf16* z = F.Z() + (size_t)(row0 + t) * ZC; float x = F.b_gate()[h * 64 + d];
#pragma unroll
        for (int r = 0; r < 16; ++r) x += bf2f(z[ZA + r]) * F.w_gate_up()[r * 256 + h * 64 + d];
        G4[t * 64 + d] = logsigmoid_f(x) * (1.f / 16.f); Q4[t * 64 + d] = bf2f(z[ZQ + h * 64 + d]) * 0.125f; K4[t * 64 + d] = bf2f(z[ZK + h * 64 + d]); }
    { const int t = tid >> 7; V4[t * 128 + e] = bf2f(F.Z()[(size_t)(row0 + t) * ZC + ZV + h * 128 + e]); }
    __syncthreads();
    if (tid < 64) { const int d = tid; float b[4]; float run = 0.f;
#pragma unroll
        for (int t = 0; t < 4; ++t) { run += G4[t * 64 + d]; b[t] = run; }
        const float bm = b[2], bl = b[3];
#pragma unroll
        for (int t = 0; t < 4; ++t) { const float q = Q4[t * 64 + d], k = K4[t * 64 + d]; QD[t * 64 + d] = q * fexp(b[t]); KD[t * 64 + d] = k * fexp(bl - b[t]); Q4[t * 64 + d] = q * fexp(b[t] - bm); K4[t * 64 + d] = k * fexp(bm - b[t]); }
        DEC[d] = fexp(bl); }
    __syncthreads();
    if (tid < 16) { const int t = tid >> 2, j = tid & 3; float a = 0.f;
        for (int d = 0; d < 64; ++d) a += Q4[t * 64 + d] * K4[j * 64 + d];
        ATT[tid] = (j <= t) ? a : 0.f; }
    float po[4] = {0.f, 0.f, 0.f, 0.f};
#pragma unroll
    for (int dd = 0; dd < 16; ++dd) { const int d = 16 * dg + dd;
#pragma unroll
        for (int t = 0; t < 4; ++t) po[t] += QD[t * 64 + d] * S[dd]; }
#pragma unroll
    for (int t = 0; t < 4; ++t) PART[(dg * 4 + t) * 128 + e] = po[t];
    { float* op = F.out + O_GLAS + ((size_t)(sb * 4 + h) * 64 + 16 * dg) * 128 + e;
#pragma unroll
      for (int dd = 0; dd < 16; ++dd) { const int d = 16 * dg + dd; float s = S[dd] * DEC[d];
#pragma unroll
          for (int j = 0; j < 4; ++j) s += KD[j * 64 + d] * V4[j * 128 + e];
          op[dd * 128] = s; } }
    __syncthreads();
    { const int t = tid >> 7; float o = PART[(0 * 4 + t) * 128 + e] + PART[(1 * 4 + t) * 128 + e] + PART[(2 * 4 + t) * 128 + e] + PART[(3 * 4 + t) * 128 + e];
#pragma unroll
      for (int j = 0; j < 4; ++j) o += ATT[t * 4 + j] * V4[j * 128 + e];
      OL[t * 132 + e] = o; }
    __syncthreads();
    gla_norm_gate_store(F, OL, row0, 4, h, g0, g1);
    __syncthreads();
}
constexpr int AT_KS = 208, AT_VS = 192;
constexpr int AT_K0 = 0, AT_KB = 64 * AT_KS, AT_V0 = 2 * AT_KB, AT_VB = 64 * AT_VS, AT_F = AT_V0 + 3 * AT_VB, AT_END = AT_F + 8 * 128;
static_assert(AT_END <= RING_BYTES, "attention LDS map");
__device__ __forceinline__ void attn_prompt_unit(Frame& F, ldsp L, int qrow0, int kvrow0, int qb, int h) {
    int tid = F.tid; asm volatile("" : "+v"(tid));
    const int lane = tid & 63, wave = F.wave, r32 = lane & 31, hi = lane >> 5;
    const bool metau = qb < 0; const int NT = metau ? 1 : 4 * qb + 5;
    const int qi = (metau ? 0 : 256 * qb) + 32 * wave + r32;
    const int ridx = metau ? qi : NMETA + qi;
    const int qi0w = (metau ? 0 : 256 * qb) + 32 * wave + 31;
    bf16x8 qf[6];
    { const bf16* qp = F.Q() + (size_t)(qrow0 + 32 * wave + r32) * QW + 96 * h + 8 * hi; v4u raw[6];
#pragma unroll
      for (int s = 0; s < 6; ++s) raw[s] = *(const GAS v4u*)(qp + 16 * s);
#pragma unroll
      for (int s = 0; s < 4; ++s) qf[s] = pack8(bflo(raw[s].x) * ATT_SC, bfhi(raw[s].x) * ATT_SC, bflo(raw[s].y) * ATT_SC, bfhi(raw[s].y) * ATT_SC, bflo(raw[s].z) * ATT_SC, bfhi(raw[s].z) * ATT_SC, bflo(raw[s].w) * ATT_SC, bfhi(raw[s].w) * ATT_SC);
      const float* rt_ = F.ROPE_T() + ridx * 32 + 8 * hi; const f32x4 c0 = *(const GAS f32x4*)rt_, c1 = *(const GAS f32x4*)(rt_ + 4), s0 = *(const GAS f32x4*)(rt_ + 16), s1 = *(const GAS f32x4*)(rt_ + 20);
      float x1[8], x2[8], cs[8], sn[8], y1[8], y2[8];
      x1[0] = bflo(raw[4].x); x1[1] = bfhi(raw[4].x); x1[2] = bflo(raw[4].y); x1[3] = bfhi(raw[4].y); x1[4] = bflo(raw[4].z); x1[5] = bfhi(raw[4].z); x1[6] = bflo(raw[4].w); x1[7] = bfhi(raw[4].w);
      x2[0] = bflo(raw[5].x); x2[1] = bfhi(raw[5].x); x2[2] = bflo(raw[5].y); x2[3] = bfhi(raw[5].y); x2[4] = bflo(raw[5].z); x2[5] = bfhi(raw[5].z); x2[6] = bflo(raw[5].w); x2[7] = bfhi(raw[5].w);
      cs[0] = c0.x; cs[1] = c0.y; cs[2] = c0.z; cs[3] = c0.w; cs[4] = c1.x; cs[5] = c1.y; cs[6] = c1.z; cs[7] = c1.w; sn[0] = s0.x; sn[1] = s0.y; sn[2] = s0.z; sn[3] = s0.w; sn[4] = s1.x; sn[5] = s1.y; sn[6] = s1.z; sn[7] = s1.w;
#pragma unroll
      for (int j = 0; j < 8; ++j) { y1[j] = (x1[j] * cs[j] - x2[j] * sn[j]) * ATT_SC; y2[j] = (x2[j] * cs[j] + x1[j] * sn[j]) * ATT_SC; }
      qf[4] = pack8(y1[0], y1[1], y1[2], y1[3], y1[4], y1[5], y1[6], y1[7]); qf[5] = pack8(y2[0], y2[1], y2[2], y2[3], y2[4], y2[5], y2[6], y2[7]); }
    const int srow = tid >> 3, sch = tid & 7, rrow = tid >> 2, rch = tid & 3;
    v4u knA, vvA, krA = (v4u){0u, 0u, 0u, 0u}, knB, vvB, krB = (v4u){0u, 0u, 0u, 0u};
#define AT_LOAD(S, t) do { const int tt_ = (t) < NT ? (t) : NT - 1; const size_t rb_ = (size_t)(tt_ == 0 ? R_META0 : kvrow0 + 64 * (tt_ - 1));     \
        kn##S = *(const GAS v4u*)(F.KV() + (rb_ + srow) * 1024 + 64 * h + 8 * sch); vv##S = *(const GAS v4u*)(F.KV() + (rb_ + srow) * 1024 + 512 + 64 * h + 8 * sch); \
        if (tid < 256) kr##S = *(const GAS v4u*)(F.KR() + (rb_ + rrow) * ROPE + 8 * rch); } while (0)
#define AT_STORE(S, kbuf, vboff) do { *(LAS v4u*)(L + AT_K0 + (kbuf) * AT_KB + srow * AT_KS + 16 * sch) = kn##S; *(LAS v4u*)(L + AT_V0 + (vboff) + srow * AT_VS + 16 * sch) = vv##S; \
        if (tid < 256) *(LAS v4u*)(L + AT_K0 + (kbuf) * AT_KB + rrow * AT_KS + 128 + 16 * rch) = kr##S; } while (0)
    LAS float* FS = (LAS float*)(L + AT_F + wave * 128);
    float m = 0.f, l = 0.f; f32x16 o0 = {}, o1 = {}, negm = {};
    const int qq = (lane & 15) >> 2, pp = lane & 3, blk = (lane >> 4) & 1;
    const int vlane = (4 * hi + qq) * AT_VS + (16 * blk + 4 * pp) * 2;
    const int klane = r32 * AT_KS + 16 * hi;
#define AT_SBAR() __builtin_amdgcn_sched_barrier(0)
#define AT_PIN(x) asm volatile("" : "+v"(x))
#define AT_KF(Kb_, i) (*(const LAS bf16x8*)((Kb_) + ((i) & 1) * 32 * AT_KS + 32 * ((i) >> 1)))
#define AT_VF(Vb_, j) cat4(tr_read((Vb_) + (32 * ((j) >> 2) + 16 * (((j) >> 1) & 1)) * AT_VS + 64 * ((j) & 1)), tr_read((Vb_) + (32 * ((j) >> 2) + 16 * (((j) >> 1) & 1) + 8) * AT_VS + 64 * ((j) & 1)))
#define AT_PV(P0, P1, i) ((i) < 16 ? P0[(i) & 15] : P1[(i) & 15])
#define AT_MASK(C0, C1, t) do { if ((t) == 0) { _Pragma("unroll") for (int r = 0; r < 16; ++r) { const int key = crow(r, hi); if (key >= NMETA || (metau && key > qi)) C0[r] = -INFINITY; C1[r] = -INFINITY; } } \
        else if ((t) >= NT - 4) { const int kb0 = 64 * ((t) - 1); _Pragma("unroll") for (int r = 0; r < 16; ++r) { const int key = kb0 + crow(r, hi); if (key > qi) C0[r] = -INFINITY; if (key + 32 > qi) C1[r] = -INFINITY; } } } while (0)
#define AT_ROWMAX(C0, C1, rm) do { float a_ = __builtin_fmaxf(__builtin_fmaxf(C0[0], C0[1]), C1[0]), b_ = __builtin_fmaxf(__builtin_fmaxf(C0[2], C0[3]), C1[1]); a_ = __builtin_fmaxf(__builtin_fmaxf(a_, C1[2]), C1[3]); \
        _Pragma("unroll") for (int r = 4; r < 16; r += 4) { a_ = __builtin_fmaxf(__builtin_fmaxf(a_, C0[r]), C0[r + 1]); b_ = __builtin_fmaxf(__builtin_fmaxf(b_, C0[r + 2]), C0[r + 3]); a_ = __builtin_fmaxf(__builtin_fmaxf(a_, C1[r]), C1[r + 1]); b_ = __builtin_fmaxf(__builtin_fmaxf(b_, C1[r + 2]), C1[r + 3]); } \
        rm = __builtin_fmaxf(a_, b_); { auto rr_ = __builtin_amdgcn_permlane32_swap(__float_as_uint(rm), __float_as_uint(rm), false, false); rm = __builtin_fmaxf(__uint_as_float(rr_[0]), __uint_as_float(rr_[1])); } } while (0)
    f32x16 pA0, pA1, pB0, pB1; v4u pw[4]; bool resc = false;
    int vprev = 0, vcur = 0, vnext = AT_VB;
#define AT_ROT() do { vprev = vcur; vcur = vnext; vnext = (vnext == 2 * AT_VB) ? 0 : vnext + AT_VB; } while (0)
    AT_LOAD(A, 0); AT_STORE(A, 0, 0); AT_LOAD(A, 1); AT_LOAD(B, 2); LDS_BARRIER();
    { const LAS unsigned char* Kb = L + AT_K0 + klane;
      pA0 = negm; pA1 = negm;
#pragma unroll
      for (int i = 0; i < 12; ++i) { if (i & 1) pA1 = __builtin_amdgcn_mfma_f32_32x32x16_bf16(AT_KF(Kb, i), qf[i >> 1], pA1, 0, 0, 0); else pA0 = __builtin_amdgcn_mfma_f32_32x32x16_bf16(AT_KF(Kb, i), qf[i >> 1], pA0, 0, 0, 0); }
      AT_MASK(pA0, pA1, 0);
      float rm; AT_ROWMAX(pA0, pA1, rm); m = rm;
#pragma unroll
      for (int r = 0; r < 16; ++r) { pA0[r] = __builtin_amdgcn_exp2f(pA0[r] - rm); pA1[r] = __builtin_amdgcn_exp2f(pA1[r] - rm); negm[r] = -m; }
      AT_STORE(A, 1, AT_VB); LDS_BARRIER(); AT_ROT(); }
#define AT_GAPA(i, C0, C1, P0, P1) do { \
        if ((i) & 1) C1 = __builtin_amdgcn_mfma_f32_32x32x16_bf16(kf[i], qf[(i) >> 1], (i) < 2 ? negm : C1, 0, 0, 0); else C0 = __builtin_amdgcn_mfma_f32_32x32x16_bf16(kf[i], qf[(i) >> 1], (i) < 2 ? negm : C0, 0, 0, 0); \
        if ((i) + 4 < 12) kf[((i) + 4) % 12] = AT_KF(Kb, (i) + 4); \
        if ((i) < 10) { sacc += AT_PV(P0, P1, 2 + 3 * (i)); sacc += AT_PV(P0, P1, 3 + 3 * (i)); sacc += AT_PV(P0, P1, 4 + 3 * (i)); AT_PIN(sacc); } \
        if ((i) < 8) { pw[(i) >> 1][2 * ((i) & 1)] = pkbf(AT_PV(P0, P1, 4 * (i)), AT_PV(P0, P1, 4 * (i) + 1)); pw[(i) >> 1][2 * ((i) & 1) + 1] = pkbf(AT_PV(P0, P1, 4 * (i) + 2), AT_PV(P0, P1, 4 * (i) + 3)); AT_PIN(pw[(i) >> 1]); } \
        AT_SBAR(); } while (0)
#define AT_GAPB(j, C0, C1) do { \
        if ((j) & 1) o1 = __builtin_amdgcn_mfma_f32_32x32x16_bf16(__builtin_bit_cast(bf16x8, pw[(j) >> 1]), vf[j], o1, 0, 0, 0); else o0 = __builtin_amdgcn_mfma_f32_32x32x16_bf16(__builtin_bit_cast(bf16x8, pw[(j) >> 1]), vf[j], o0, 0, 0, 0); \
        if ((j) + 2 < 8) vf[(j) + 2] = AT_VF(Vb, (j) + 2); \
        if ((j) < 4) { C0[4 * (j)] = __builtin_amdgcn_exp2f(C0[4 * (j)]); C0[4 * (j) + 1] = __builtin_amdgcn_exp2f(C0[4 * (j) + 1]); C0[4 * (j) + 2] = __builtin_amdgcn_exp2f(C0[4 * (j) + 2]); C0[4 * (j) + 3] = __builtin_amdgcn_exp2f(C0[4 * (j) + 3]); AT_PIN(C0); } \
        else { C1[4 * (j) - 16] = __builtin_amdgcn_exp2f(C1[4 * (j) - 16]); C1[4 * (j) - 15] = __builtin_amdgcn_exp2f(C1[4 * (j) - 15]); C1[4 * (j) - 14] = __builtin_amdgcn_exp2f(C1[4 * (j) - 14]); C1[4 * (j) - 13] = __builtin_amdgcn_exp2f(C1[4 * (j) - 13]); AT_PIN(C1); } \
        AT_SBAR(); } while (0)
#define AT_STEP(C0, C1, P0, P1, t, LS, SS) do { AT_LOAD(LS, (t) + 2); AT_SBAR(); \
        const LAS unsigned char* Kb = L + AT_K0 + ((t) & 1) * AT_KB + klane; const LAS unsigned char* Vb = L + AT_V0 + vprev + vlane; \
        bf16x8 kf[12], vf[8]; kf[0] = AT_KF(Kb, 0); kf[1] = AT_KF(Kb, 1); kf[2] = AT_KF(Kb, 2); kf[3] = AT_KF(Kb, 3); AT_SBAR(); \
        float sacc = P0[0] + P0[1]; \
        AT_GAPA(0, C0, C1, P0, P1); AT_GAPA(1, C0, C1, P0, P1); AT_GAPA(2, C0, C1, P0, P1); AT_GAPA(3, C0, C1, P0, P1); AT_GAPA(4, C0, C1, P0, P1); AT_GAPA(5, C0, C1, P0, P1); \
        AT_GAPA(6, C0, C1, P0, P1); AT_GAPA(7, C0, C1, P0, P1); AT_GAPA(8, C0, C1, P0, P1); AT_GAPA(9, C0, C1, P0, P1); \
        vf[0] = AT_VF(Vb, 0); vf[1] = AT_VF(Vb, 1); \
        AT_GAPA(10, C0, C1, P0, P1); AT_GAPA(11, C0, C1, P0, P1); \
        l += sacc; \
        AT_MASK(C0, C1, t); \
        { float rm; AT_ROWMAX(C0, C1, rm); resc = false; \
          if (__builtin_expect(__any(rm > 8.f), 0)) { const float dl = __builtin_fmaxf(rm, 0.f); m += dl; \
              _Pragma("unroll") for (int r = 0; r < 16; ++r) { C0[r] -= dl; C1[r] -= dl; negm[r] = -m; } \
              const float f_ = __builtin_amdgcn_exp2f(-dl); l *= f_; if (hi == 0) FS[r32] = f_; resc = true; } } \
        AT_SBAR(); \
        AT_GAPB(0, C0, C1); AT_GAPB(1, C0, C1); AT_GAPB(2, C0, C1); AT_GAPB(3, C0, C1); AT_GAPB(4, C0, C1); AT_GAPB(5, C0, C1); AT_GAPB(6, C0, C1); AT_GAPB(7, C0, C1); \
        AT_STORE(SS, ((t) + 1) & 1, vnext); LDS_BARRIER(); \
        if (resc) { _Pragma("unroll") for (int g = 0; g < 4; ++g) { const f32x4 f = *(const LAS f32x4*)(FS + 8 * g + 4 * hi); _Pragma("unroll") for (int j = 0; j < 4; ++j) { o0[4 * g + j] *= f[j]; o1[4 * g + j] *= f[j]; } } } \
        AT_ROT(); } while (0)
#pragma unroll 1
    for (int t = 1; t < NT; t += 2) { AT_STEP(pB0, pB1, pA0, pA1, t, A, B); AT_STEP(pA0, pA1, pB0, pB1, t + 1, B, A); }
    { float sacc = 0.f;
#pragma unroll
      for (int r = 0; r < 16; ++r) sacc += pA0[r] + pA1[r];
      l += sacc;
      const LAS unsigned char* Vb = L + AT_V0 + vprev + vlane;
      const bf16x8 pa0 = pack8(pA0[0], pA0[1], pA0[2], pA0[3], pA0[4], pA0[5], pA0[6], pA0[7]), pa1 = pack8(pA0[8], pA0[9], pA0[10], pA0[11], pA0[12], pA0[13], pA0[14], pA0[15]);
      const bf16x8 pa2 = pack8(pA1[0], pA1[1], pA1[2], pA1[3], pA1[4], pA1[5], pA1[6], pA1[7]), pa3 = pack8(pA1[8], pA1[9], pA1[10], pA1[11], pA1[12], pA1[13], pA1[14], pA1[15]);
      o0 = __builtin_amdgcn_mfma_f32_32x32x16_bf16(pa0, AT_VF(Vb, 0), o0, 0, 0, 0); o1 = __builtin_amdgcn_mfma_f32_32x32x16_bf16(pa0, AT_VF(Vb, 1), o1, 0, 0, 0);
      o0 = __builtin_amdgcn_mfma_f32_32x32x16_bf16(pa1, AT_VF(Vb, 2), o0, 0, 0, 0); o1 = __builtin_amdgcn_mfma_f32_32x32x16_bf16(pa1, AT_VF(Vb, 3), o1, 0, 0, 0);
      o0 = __builtin_amdgcn_mfma_f32_32x32x16_bf16(pa2, AT_VF(Vb, 4), o0, 0, 0, 0); o1 = __builtin_amdgcn_mfma_f32_32x32x16_bf16(pa2, AT_VF(Vb, 5), o1, 0, 0, 0);
      o0 = __builtin_amdgcn_mfma_f32_32x32x16_bf16(pa3, AT_VF(Vb, 6), o0, 0, 0, 0); o1 = __builtin_amdgcn_mfma_f32_32x32x16_bf16(pa3, AT_VF(Vb, 7), o1, 0, 0, 0); }
#undef AT_STEP
#undef AT_GAPA
#undef AT_GAPB
#undef AT_ROT
#undef AT_ROWMAX
#undef AT_MASK
#undef AT_PV
#undef AT_VF
#undef AT_KF
#undef AT_PIN
#undef AT_SBAR
#undef AT_LOAD
#undef AT_STORE
    { const float lt = l + __shfl_xor(l, 32); if (hi == 0) FS[r32] = 1.f / lt;
      bf16* op = F.AO() + (size_t)(qrow0 + 32 * wave) * DM + 512 + 64 * h + r32;
#pragma unroll
      for (int g = 0; g < 4; ++g) { const f32x4 f = *(const LAS f32x4*)(FS + 8 * g + 4 * hi);
#pragma unroll
          for (int j = 0; j < 4; ++j) { const int row = 8 * g + 4 * hi + j; op[(size_t)row * DM] = (bf16)f2bf(o0[4 * g + j] * f[j]); op[(size_t)row * DM + 32] = (bf16)f2bf(o1[4 * g + j] * f[j]); } } }
    __syncthreads();
}

constexpr int DC_QS = 592, DC_Q = 0, DC_IMG = 19456, DC_IMGB = 2 * 16384 + 64 * 80, DC_QN = DC_IMG + 2 * DC_IMGB  , DC_PX = WG_OFF, DC_PXB = 2304, DC_F = DC_PX + 4 * DC_PXB, DC_END = DC_F + 8 * 256;
constexpr int DC_OL = DC_IMG, DC_XO = DC_IMG + DC_IMGB, DC_XM = DC_XO + 32768;
static_assert(DC_IMG + 3 * DC_IMGB <= XTRA_OFF + XTRA_BYTES && DC_END <= LDS_BYTES && 32 * 260 * 4 <= DC_IMGB && 32768 + 2 * 2 * 32 * 4 <= DC_IMGB, "decode LDS map");
__device__ __forceinline__ int dc_off(int row, int ch) { return 256 * row + 16 * (ch ^ (((row & 3) << 2) | ((row >> 2) & 3))); }
__device__ __forceinline__ bf16x8 cvt8(f32x4 a, f32x4 b) { return pack8(a.x, a.y, a.z, a.w, b.x, b.y, b.z, b.w); }
__device__ __forceinline__ void dc_scores(const LAS unsigned char* Ib, const LAS unsigned char* Qimg, LAS unsigned char* PXw, int lane, int kb, bool first, bool newt, float& m, float& l) {
    asm volatile("" : "+v"(lane));
    const int r32 = lane & 31, hi = lane >> 5, krow = 32 * kb + r32;
    const LAS unsigned char* Qb = Qimg + r32 * DC_QS + 16 * hi;
    f32x16 p = {};
#define DC_KQ(kf_, qf_, s0_) do { _Pragma("unroll") for (int j = 0; j < 3; ++j) { const int s = (s0_) + j; \
            kf_[j] = (s < 16) ? *(const LAS bf16x8*)(Ib + (s >> 3) * 16384 + dc_off(krow, 2 * (s & 7) + hi)) : *(const LAS bf16x8*)(Ib + 32768 + krow * 80 + (2 * (s - 16) + hi) * 16); \
            qf_[j] = *(const LAS bf16x8*)(Qb + 32 * s); } } while (0)
#define DC_MM(kf_, qf_) do { _Pragma("unroll") for (int j = 0; j < 3; ++j) p = __builtin_amdgcn_mfma_f32_32x32x16_bf16(kf_[j], qf_[j], p, 0, 0, 0); } while (0)
    { bf16x8 kfa[3], qfa[3], kfb[3], qfb[3], kfc[3], qfc[3];
      DC_KQ(kfa, qfa, 0); DC_KQ(kfb, qfb, 3); __builtin_amdgcn_sched_barrier(0);
      DC_KQ(kfc, qfc, 6); DC_MM(kfa, qfa); __builtin_amdgcn_sched_barrier(0);
      DC_KQ(kfa, qfa, 9); DC_MM(kfb, qfb); __builtin_amdgcn_sched_barrier(0);
      DC_KQ(kfb, qfb, 12); DC_MM(kfc, qfc); __builtin_amdgcn_sched_barrier(0);
      DC_KQ(kfc, qfc, 15); DC_MM(kfa, qfa); __builtin_amdgcn_sched_barrier(0);
      DC_MM(kfb, qfb); DC_MM(kfc, qfc); __builtin_amdgcn_sched_barrier(0); }
#undef DC_KQ
#undef DC_MM
    if (newt) { const int tq = r32 >> 3;
#pragma unroll
        for (int r = 0; r < 16; ++r) { const int key = 32 * kb + crow(r, hi); if (key >= DS || key > tq) p[r] = -INFINITY; } }
    float mxa = __builtin_fmaxf(__builtin_fmaxf(p[0], p[1]), p[2]), mxb = __builtin_fmaxf(__builtin_fmaxf(p[3], p[4]), p[5]);
    mxa = __builtin_fmaxf(__builtin_fmaxf(mxa, p[6]), p[7]); mxb = __builtin_fmaxf(__builtin_fmaxf(mxb, p[8]), p[9]); mxa = __builtin_fmaxf(__builtin_fmaxf(mxa, p[10]), p[11]); mxb = __builtin_fmaxf(__builtin_fmaxf(mxb, p[12]), p[13]);
    float mx = __builtin_fmaxf(__builtin_fmaxf(mxa, mxb), __builtin_fmaxf(p[14], p[15]));
    { auto r_ = __builtin_amdgcn_permlane32_swap(__float_as_uint(mx), __float_as_uint(mx), false, false); mx = __builtin_fmaxf(__uint_as_float(r_[0]), __uint_as_float(r_[1])); }
    const float d = mx - m, dl = first ? d : (d > 8.f ? d : 0.f);
    float alpha = 1.f;
    if (first || __any(dl != 0.f)) { m += dl; alpha = first ? 1.f : __builtin_amdgcn_exp2f(-dl); }
    float ps = 0.f;
#pragma unroll
    for (int r = 0; r < 16; ++r) { p[r] = __builtin_amdgcn_exp2f(p[r] - m); ps += p[r]; }
    l = l * alpha + ps;
    *(LAS bf16x8*)(PXw + lane * 32) = pack8(p[0], p[1], p[2], p[3], p[4], p[5], p[6], p[7]); *(LAS bf16x8*)(PXw + lane * 32 + 16) = pack8(p[8], p[9], p[10], p[11], p[12], p[13], p[14], p[15]);
    if (hi == 0) ((LAS float*)(PXw + 2048))[r32] = alpha;
    { const bool anyr = __any(alpha != 1.f); if (lane == 0) ((LAS unsigned*)(PXw + 2048 + 128))[0] = anyr ? 1u : 0u; }
}
__device__ __forceinline__ void dc_pv(const LAS unsigned char* Ib, const LAS unsigned char* PXr, int lane, int kb, int cg, f32x16& o0, f32x16& o1) {
    asm volatile("" : "+v"(lane));
    const int hi = lane >> 5, qq = (lane & 15) >> 2, pp = lane & 3, blk = (lane >> 4) & 1;
    const LAS float* AL = (const LAS float*)(PXr + 2048);
    if (__builtin_amdgcn_readfirstlane(((const LAS unsigned*)(PXr + 2048 + 128))[0])) {
#pragma unroll
        for (int g = 0; g < 4; ++g) { const f32x4 f = *(const LAS f32x4*)(AL + 8 * g + 4 * hi);
#pragma unroll
            for (int j = 0; j < 4; ++j) { o0[4 * g + j] *= f[j]; o1[4 * g + j] *= f[j]; } } }
    const bf16x8 pa0 = *(const LAS bf16x8*)(PXr + lane * 32), pa1 = *(const LAS bf16x8*)(PXr + lane * 32 + 16);
#define DC_VADDR(s, tt, cc) (Ib + ((2 * cg + (cc)) >> 2) * 16384 + dc_off(32 * kb + 16 * (s) + 8 * (tt) + 4 * hi + qq, 4 * ((2 * cg + (cc)) & 3) + 2 * blk + (pp >> 1)) + 8 * (pp & 1))
#define DC_VF(s, cc) cat4(tr_read(DC_VADDR(s, 0, cc)), tr_read(DC_VADDR(s, 1, cc)))
    o0 = __builtin_amdgcn_mfma_f32_32x32x16_bf16(pa0, DC_VF(0, 0), o0, 0, 0, 0); o1 = __builtin_amdgcn_mfma_f32_32x32x16_bf16(pa0, DC_VF(0, 1), o1, 0, 0, 0);
    o0 = __builtin_amdgcn_mfma_f32_32x32x16_bf16(pa1, DC_VF(1, 0), o0, 0, 0, 0); o1 = __builtin_amdgcn_mfma_f32_32x32x16_bf16(pa1, DC_VF(1, 1), o1, 0, 0, 0);
#undef DC_VF
#undef DC_VADDR
}
__device__ __forceinline__ void attn_decode_unit(Frame& F, ldsp L, int sb) {
    int tid = F.tid; asm volatile("" : "+v"(tid));
    const int lane = tid & 63, wave = F.wave, r32 = lane & 31, hi = lane >> 5, kb = wave & 1, cg = wave >> 1;
    const int row0 = R_SAMPLE0 + 4 * sb;
    { { const int t = tid >> 7, hh = (tid >> 4) & 7, i = tid & 15; const bf16* qp = F.Q() + (size_t)(row0 + t) * QW + 96 * hh + 64;
        const float x1 = bf2f(qp[i]), x2 = bf2f(qp[16 + i]), c = F.ROPE_T()[(LTOT + t) * 32 + i], s = F.ROPE_T()[(LTOT + t) * 32 + 16 + i];
        LAS unsigned short* qd = (LAS unsigned short*)(L + DC_Q + (t * 8 + hh) * DC_QS + 512);
        qd[i] = (unsigned short)f2bf((x1 * c - x2 * s) * ATT_SC); qd[16 + i] = (unsigned short)f2bf((x2 * c + x1 * s) * ATT_SC); }
      { const int hh = wave; bf16x8 af[4];
#pragma unroll
        for (int s = 0; s < 4; ++s) { v4u ar = *(const GAS v4u*)(F.Q() + (size_t)(row0 + (r32 & 3)) * QW + 96 * hh + 16 * s + 8 * hi); if (r32 >= DS) ar = (v4u){0u, 0u, 0u, 0u}; af[s] = __builtin_bit_cast(bf16x8, ar); }
#pragma unroll 2
        for (int cb = 0; cb < 8; ++cb) { f32x16 acc = {}; const float* wp = F.w_uk() + (size_t)(32 * cb + r32) * 512 + 64 * hh + 8 * hi;
#pragma unroll
            for (int s = 0; s < 4; ++s) acc = __builtin_amdgcn_mfma_f32_32x32x16_bf16(af[s], cvt8(*(const GAS f32x4*)(wp + 16 * s), *(const GAS f32x4*)(wp + 16 * s + 4)), acc, 0, 0, 0);
            if (hi == 0) {
#pragma unroll
                for (int t = 0; t < DS; ++t) *(LAS unsigned short*)(L + DC_Q + (t * 8 + hh) * DC_QS + 2 * (32 * cb + r32)) = (unsigned short)f2bf(acc[t] * ATT_SC); } } }
      __syncthreads(); }
    float m = 0.f, l = 0.f; f32x16 o0 = {}, o1 = {};
    constexpr int NTILE = 2 * NPAGES;
    f32x4 ckA[8], ckrA, ckB[8], ckrB;
    const int ptv = ((const GAS int*)F.page_table())[sb * NPAGES + lane];
    const unsigned gvo = (unsigned)(((tid >> 5) * KVL + 8 * (tid & 31)) * 4), gro = (unsigned)(((tid >> 3) * ROPE + 4 * (tid & 7)) * 4);
    const int lro = 32768 + (tid >> 3) * 80 + 8 * (tid & 7);
    const unsigned gvc = (unsigned)((tid >> 6) * 1024 + (tid & 63) * 16);
    const int r0_ = tid >> 6, chh_ = (tid & 63) >> 1, hb_ = (chh_ >> 4) * 16384 + 256 * r0_ + 8 * (tid & 1);
    const int lsoE = hb_ + 16 * ((chh_ & 15) ^ (((r0_ & 3) << 2) | ((r0_ >> 2) & 3))), lsoO = hb_ + 2048 + 16 * ((chh_ & 15) ^ (((r0_ & 3) << 2) | (((r0_ >> 2) + 2) & 3)));
#define DC_LOAD(ck, ckr, tile) do { const int tl_ = (tile) < NTILE ? (tile) : NTILE - 1;     \
        const int pg_ = __builtin_amdgcn_readlane(ptv, tl_ >> 1); const GAS char* sc_ = (const GAS char*)(F.cache_ckv() + ((size_t)pg_ * PAGE + 64 * (tl_ & 1)) * KVL); const GAS char* sr_ = (const GAS char*)(F.cache_krope() + ((size_t)pg_ * PAGE + 64 * (tl_ & 1)) * ROPE); \
        _Pragma("unroll") for (int i_ = 0; i_ < 4; ++i_) { const GAS char* p_ = sc_ + 16384 * i_; ck[2 * i_] = __builtin_nontemporal_load((const GAS f32x4*)(p_ + gvc)); ck[2 * i_ + 1] = __builtin_nontemporal_load((const GAS f32x4*)(p_ + gvc + 8192)); } \
        ckr = __builtin_nontemporal_load((const GAS f32x4*)(sr_ + gro)); } while (0)
#define DC_STORE(ck, ckr, ib_) do { \
        _Pragma("unroll") for (int i_ = 0; i_ < 4; ++i_) { u32x2 e_, o_; e_.x = pkbf(ck[2 * i_].x, ck[2 * i_].y); e_.y = pkbf(ck[2 * i_].z, ck[2 * i_].w); o_.x = pkbf(ck[2 * i_ + 1].x, ck[2 * i_ + 1].y); o_.y = pkbf(ck[2 * i_ + 1].z, ck[2 * i_ + 1].w); \
            *(LAS u32x2*)((ib_) + lsoE + 4096 * i_) = e_; *(LAS u32x2*)((ib_) + lsoO + 4096 * i_) = o_; } \
        { u32x2 w_; w_.x = pkbf(ckr.x, ckr.y); w_.y = pkbf(ckr.z, ckr.w); *(LAS u32x2*)((ib_) + lro) = w_; } } while (0)
#define DC_NEWKEYS(ib) do { \
            _Pragma("unroll") for (int i = 0; i < 4; ++i) { const int ix = tid + 512 * i, row = ix >> 5, ch = ix & 31; v4u w = (v4u){0u, 0u, 0u, 0u}; if (row < DS) w = *(const GAS v4u*)(F.CKV() + (size_t)(row0 + row) * KVL + 8 * ch); \
                *(LAS v4u*)((ib) + (ch >> 4) * 16384 + dc_off(row, ch & 15)) = w; } \
            if (tid < 256) { const int row = tid >> 2; v4u w = (v4u){0u, 0u, 0u, 0u}; if (row < DS) w = *(const GAS v4u*)(F.KR() + (size_t)(row0 + row) * ROPE + 8 * (tid & 3)); *(LAS v4u*)((ib) + 32768 + row * 80 + 16 * (tid & 3)) = w; } } while (0)
#define DC_ITER(t, ck, ckr, nk, nkr) do { ldsp i0_ = L + DC_IMG + b0 * DC_IMGB, im_ = L + DC_IMG + (b0 == 0 ? 2 : b0 - 1) * DC_IMGB, ip_ = L + DC_IMG + (b0 == 2 ? 0 : b0 + 1) * DC_IMGB; const int pb_ = (t) & 1; \
        if (cg == 0) dc_scores(i0_, L + DC_Q, L + DC_PX + (2 * kb + pb_) * DC_PXB, lane, kb, (t) == 0, (t) == NTILE, m, l); \
        if ((t) > 0) dc_pv(im_, L + DC_PX + (2 * kb + (pb_ ^ 1)) * DC_PXB, lane, kb, cg, o0, o1); \
        if ((t) + 1 < NTILE) DC_STORE(ck, ckr, ip_); else if ((t) + 1 == NTILE) DC_NEWKEYS(ip_); \
        DC_LOAD(ck, ckr, (t) + 3);     \
        LDS_BARRIER(); b0 = (b0 == 2) ? 0 : b0 + 1; } while (0)
    int b0 = 0;
    DC_LOAD(ckA, ckrA, 0); DC_STORE(ckA, ckrA, L + DC_IMG); DC_LOAD(ckA, ckrA, 1); DC_LOAD(ckB, ckrB, 2); LDS_BARRIER();
    for (int t = 0; t <= NTILE; t += 2) { DC_ITER(t, ckA, ckrA, ckB, ckrB); if (t + 1 <= NTILE) DC_ITER(t + 1, ckB, ckrB, ckA, ckrA); }
#undef DC_ITER
#undef DC_NEWKEYS
#undef DC_LOAD
#undef DC_STORE
    dc_pv(L + DC_IMG + (NTILE % 3) * DC_IMGB, L + DC_PX + (2 * kb + (NTILE & 1)) * DC_PXB, lane, kb, cg, o0, o1);
    __syncthreads();
    { LAS float* XO = (LAS float*)(L + DC_XO) + cg * 2048; LAS float* XM = (LAS float*)(L + DC_XM); LAS float* FS = (LAS float*)(L + DC_F + wave * 256);
      if (cg == 0) { const float lt = l + __shfl_xor(l, 32); if (hi == 0) { XM[kb * 64 + r32] = m; XM[kb * 64 + 32 + r32] = lt; } }
      __syncthreads();
      { const float m0 = XM[r32], l0 = XM[32 + r32], m1 = XM[64 + r32], l1 = XM[96 + r32], M = fmaxf(m0, m1), e0 = __builtin_amdgcn_exp2f(m0 - M), e1 = __builtin_amdgcn_exp2f(m1 - M), inv = 1.f / (l0 * e0 + l1 * e1);
        if (hi == 0) FS[r32] = (kb == 0 ? e0 : e1) * inv; }
#pragma unroll
      for (int g = 0; g < 4; ++g) { const f32x4 f = *(const LAS f32x4*)(FS + 8 * g + 4 * hi);
#pragma unroll
          for (int j = 0; j < 4; ++j) { o0[4 * g + j] *= f[j]; o1[4 * g + j] *= f[j]; } }
      if (kb == 1) {
#pragma unroll
          for (int r = 0; r < 16; ++r) { XO[r * 64 + lane] = o0[r]; XO[(16 + r) * 64 + lane] = o1[r]; } }
      __syncthreads();
      if (kb == 0) { LAS float* OL = (LAS float*)(L + DC_OL);
#pragma unroll
          for (int r = 0; r < 16; ++r) { const int q = crow(r, hi); OL[q * 260 + 64 * cg + r32] = o0[r] + XO[r * 64 + lane]; OL[q * 260 + 64 * cg + 32 + r32] = o1[r] + XO[(16 + r) * 64 + lane]; } }
      __syncthreads(); }
    { const int hh = wave; const LAS float* ol = (const LAS float*)(L + DC_OL) + ((r32 & 3) * 8 + hh) * 260 + 8 * hi; const bf16* wp = F.Wkv_t() + (size_t)(512 + 64 * hh + r32) * KVL + 8 * hi;
      f32x16 a0 = {}, a1 = {};
#pragma unroll 4
      for (int s = 0; s < KVL / 16; ++s) { bf16x8 af = cvt8(*(const LAS f32x4*)(ol + 16 * s), *(const LAS f32x4*)(ol + 16 * s + 4)); if (r32 >= DS) af = (bf16x8){0, 0, 0, 0, 0, 0, 0, 0};
          a0 = __builtin_amdgcn_mfma_f32_32x32x16_bf16(af, *(const GAS bf16x8*)(wp + 16 * s), a0, 0, 0, 0);
          a1 = __builtin_amdgcn_mfma_f32_32x32x16_bf16(af, *(const GAS bf16x8*)(wp + (size_t)32 * KVL + 16 * s), a1, 0, 0, 0); }
      if (hi == 0) {
#pragma unroll
          for (int t = 0; t < DS; ++t) { bf16* op = F.AO() + (size_t)(row0 + t) * DM + 512 + 64 * hh + r32; op[0] = (bf16)f2bf(a0[t]); op[32] = (bf16)f2bf(a1[t]); } } }
    __syncthreads();
}
__device__ __forceinline__ void ln_load_bf16(const bf16* row, int lane, float (&v)[16]) {
    const v4u a = __builtin_nontemporal_load((const GAS v4u*)(row + 8 * lane)), b = __builtin_nontemporal_load((const GAS v4u*)(row + 512 + 8 * lane));
    v[0] = bflo(a.x); v[1] = bfhi(a.x); v[2] = bflo(a.y); v[3] = bfhi(a.y); v[4] = bflo(a.z); v[5] = bfhi(a.z); v[6] = bflo(a.w); v[7] = bfhi(a.w);
    v[8] = bflo(b.x); v[9] = bfhi(b.x); v[10] = bflo(b.y); v[11] = bfhi(b.y); v[12] = bflo(b.z); v[13] = bfhi(b.z); v[14] = bflo(b.w); v[15] = bfhi(b.w);
}
__device__ __forceinline__ void ln_load_slabs(const bf16* srow, size_t sst, int ns, const bf16* res, float alpha, int lane, float (&v)[16]) {
    ln_load_bf16(res, lane, v);
#pragma unroll
    for (int j = 0; j < 16; ++j) v[j] *= alpha;
#pragma unroll 1
    for (int s = 0; s < ns; ++s) { float t[16]; ln_load_bf16(srow + (size_t)s * sst, lane, t);
#pragma unroll
        for (int j = 0; j < 16; ++j) v[j] += t[j]; }
}
__device__ __forceinline__ void ln_norm(float (&v)[16], const float* g, const float* b, int lane) {
    float s = 0.f;
#pragma unroll
    for (int j = 0; j < 16; ++j) s += v[j];
    const float mean = wave_sum(s) * (1.f / DM); float s2 = 0.f;
#pragma unroll
    for (int j = 0; j < 16; ++j) { v[j] -= mean; s2 += v[j] * v[j]; }
    const float rstd = 1.f / sqrtf(wave_sum(s2) * (1.f / DM) + NORM_EPS);
    const f32x4 g0 = *(const GAS f32x4*)(g + 8 * lane), g1 = *(const GAS f32x4*)(g + 8 * lane + 4), g2 = *(const GAS f32x4*)(g + 512 + 8 * lane), g3 = *(const GAS f32x4*)(g + 512 + 8 * lane + 4);
    const f32x4 b0 = *(const GAS f32x4*)(b + 8 * lane), b1 = *(const GAS f32x4*)(b + 8 * lane + 4), b2 = *(const GAS f32x4*)(b + 512 + 8 * lane), b3 = *(const GAS f32x4*)(b + 512 + 8 * lane + 4);
#pragma unroll
    for (int j = 0; j < 4; ++j) { v[j] = v[j] * rstd * g0[j] + b0[j]; v[4 + j] = v[4 + j] * rstd * g1[j] + b1[j]; v[8 + j] = v[8 + j] * rstd * g2[j] + b2[j]; v[12 + j] = v[12 + j] * rstd * g3[j] + b3[j]; }
}
__device__ __forceinline__ void ln_norm4(float (&v)[4][16], const float* g, const float* b, int lane) {
    float s[4], s2[4], rstd[4];
#pragma unroll
    for (int r = 0; r < 4; ++r) { s[r] = 0.f;
#pragma unroll
        for (int j = 0; j < 16; ++j) s[r] += v[r][j]; }
#pragma unroll
    for (int o = 1; o < 64; o <<= 1) {
#pragma unroll
        for (int r = 0; r < 4; ++r) s[r] += __shfl_xor(s[r], o); }
#pragma unroll
    for (int r = 0; r < 4; ++r) { const float mean = s[r] * (1.f / DM); s2[r] = 0.f;
#pragma unroll
        for (int j = 0; j < 16; ++j) { v[r][j] -= mean; s2[r] += v[r][j] * v[r][j]; } }
#pragma unroll
    for (int o = 1; o < 64; o <<= 1) {
#pragma unroll
        for (int r = 0; r < 4; ++r) s2[r] += __shfl_xor(s2[r], o); }
#pragma unroll
    for (int r = 0; r < 4; ++r) rstd[r] = 1.f / sqrtf(s2[r] * (1.f / DM) + NORM_EPS);
    const f32x4 g0 = *(const GAS f32x4*)(g + 8 * lane), g1 = *(const GAS f32x4*)(g + 8 * lane + 4), g2 = *(const GAS f32x4*)(g + 512 + 8 * lane), g3 = *(const GAS f32x4*)(g + 512 + 8 * lane + 4);
    const f32x4 b0 = *(const GAS f32x4*)(b + 8 * lane), b1 = *(const GAS f32x4*)(b + 8 * lane + 4), b2 = *(const GAS f32x4*)(b + 512 + 8 * lane), b3 = *(const GAS f32x4*)(b + 512 + 8 * lane + 4);
#pragma unroll
    for (int r = 0; r < 4; ++r)
#pragma unroll
        for (int j = 0; j < 4; ++j) { v[r][j] = v[r][j] * rstd[r] * g0[j] + b0[j]; v[r][4 + j] = v[r][4 + j] * rstd[r] * g1[j] + b1[j]; v[r][8 + j] = v[r][8 + j] * rstd[r] * g2[j] + b2[j]; v[r][12 + j] = v[r][12 + j] * rstd[r] * g3[j] + b3[j]; }
}
__device__ __forceinline__ void ln_store_bf16(const float (&v)[16], bf16* orow, int lane) {
    v4u a, b; a.x = pk2(v[0], v[1]); a.y = pk2(v[2], v[3]); a.z = pk2(v[4], v[5]); a.w = pk2(v[6], v[7]); b.x = pk2(v[8], v[9]); b.y = pk2(v[10], v[11]); b.z = pk2(v[12], v[13]); b.w = pk2(v[14], v[15]);
    *(GAS v4u*)(orow + 8 * lane) = a; *(GAS v4u*)(orow + 512 + 8 * lane) = b;
}
__device__ __forceinline__ void ln_store_f32(const float (&v)[16], float* orow, int lane) {
    *(GAS f32x4*)(orow + 8 * lane) = (f32x4){v[0], v[1], v[2], v[3]}; *(GAS f32x4*)(orow + 8 * lane + 4) = (f32x4){v[4], v[5], v[6], v[7]};
    *(GAS f32x4*)(orow + 512 + 8 * lane) = (f32x4){v[8], v[9], v[10], v[11]}; *(GAS f32x4*)(orow + 512 + 8 * lane + 4) = (f32x4){v[12], v[13], v[14], v[15]};
}
__device__ __forceinline__ void halo_phase(Frame& F, int first) {
    const int lane = F.lane, gw = (F.bid - first) * NWAVES + F.wave, NGW = (F.G - first) * NWAVES, i16 = lane & 15, kq = lane >> 4;
    for (int j = gw; j < 16 * 176; j += NGW) { const int rt_ = j / 176, cgp = j % 176;
        const int pa = i16 >> 1, wh = i16 & 1, srow = (pa == 0) ? (R_META0 + 14 + wh) : (256 * (8 * rt_ + pa) - 2 + wh);
        const int ch = 16 * cgp + i16, brow = 256 * (ch >> 7) + (ch & 127);
        const bf16* ap = F.H1() + (size_t)srow * DM + 8 * kq; const bf16* bp = F.Wffn_t() + (size_t)brow * DM + 8 * kq;
        f32x4 acc = (f32x4){0.f, 0.f, 0.f, 0.f};
#pragma unroll 16
        for (int s = 0; s < 32; ++s) acc = __builtin_amdgcn_mfma_f32_16x16x32_bf16(*(const GAS bf16x8*)(ap + 32 * s), *(const GAS bf16x8*)(bp + 32 * s), acc, 0, 0, 0);
#pragma unroll
        for (int r = 0; r < 4; ++r) { const int i = 4 * kq + r; F.HALO()[((size_t)(8 * rt_ + (i >> 1)) * 2 + (i & 1)) * FF + ch] = acc[r]; }
    }
}

__device__ __forceinline__ void meta_kv(Frame& F) {
    const int lane = F.lane, i16 = lane & 15, kq = lane >> 4;
    for (int j = F.wave; j < 64; j += NWAVES) {
        const bf16* ap = F.CKV() + (size_t)(R_META0 + i16) * KVL + 8 * kq; const bf16* bp = F.Wkv_t() + (size_t)(16 * j + i16) * KVL + 8 * kq;
        f32x4 acc = (f32x4){0.f, 0.f, 0.f, 0.f};
#pragma unroll
        for (int s = 0; s < 8; ++s) acc = __builtin_amdgcn_mfma_f32_16x16x32_bf16(*(const GAS bf16x8*)(ap + 32 * s), *(const GAS bf16x8*)(bp + 32 * s), acc, 0, 0, 0);
#pragma unroll
        for (int r = 0; r < 4; ++r) F.KV()[(size_t)(R_META0 + 4 * kq + r) * 1024 + 16 * j + i16] = (bf16)f2bf(acc[r]);
    }
    for (int i = F.tid; i < 48 * 1024 / 8; i += NTHR) *(GAS v4u*)(F.KV() + (size_t)(R_META0 + 16) * 1024 + 8 * i) = (v4u){0u, 0u, 0u, 0u};
}

struct Args { const void* in[28]; float* out; unsigned char* ws; int ph_lo, ph_hi; };
__global__ void __launch_bounds__(NTHR, 2) hymba_fwd(Args args) {
    extern __shared__ __attribute__((aligned(16))) unsigned char lds[];
    Frame F;
    F.lds = (ldsp)lds; F.MISC = (volatile LAS unsigned*)(F.lds + MISC_OFF);
    F.tid = threadIdx.x; F.lane = F.tid & 63; F.wave = __builtin_amdgcn_readfirstlane(F.tid >> 6); F.G = gridDim.x; F.bid = blockIdx.x;
    unsigned char* ws = args.ws; F.ws = ws; F.out = args.out; F.ctl = (gu32*)(ws + WS_CTL);
    for (int u = F.tid; u < (LDSCTL_END - LDSCTL_OFF) / 4; u += NTHR) ((LAS unsigned*)(F.lds + LDSCTL_OFF))[u] = 0u;
    __syncthreads();
    XcdBarrier bar; bar.bar = (unsigned*)(F.ctl + CW_BAR); bar.x = 0; bar.st = nullptr;
    if (N_LAUNCHES == 1) bar = xcd_barrier_post((unsigned*)(F.ctl + CW_BAR), F.MISC + 8);
    const int lo = args.ph_lo, hi = args.ph_hi;
#ifndef P4_MASK
#define P4_MASK 15
#endif
#ifndef PHASE_MASK
#define PHASE_MASK 0x7ff
#endif
#define IN(k) ((((PHASE_MASK) >> (k)) & 1) && lo <= (k) && (k) < hi)
#define BOTH(k) (IN(k) && IN((k) + 1))
#define PHASE_BEGIN() do { int t_ = F.wave * 64 + (int)__builtin_amdgcn_mbcnt_hi(~0u, __builtin_amdgcn_mbcnt_lo(~0u, 0u)); asm volatile("" : "+v"(t_)); F.tid = t_; F.lane = t_ & 63; } while (0)
#define SEAM(k) do { if (BOTH(k)) xcd_barrier(bar); } while (0)
#ifndef PROBE_MASK
#define PROBE_MASK 0
#endif
#ifndef SUBPROBE
#define SUBPROBE 0
#endif
#define DUP(bit, ...) do { __VA_ARGS__; if ((SUBPROBE) & (bit)) { __VA_ARGS__; } } while (0)
#define REPS(k) for (int rep_ = 0; rep_ < ((((PROBE_MASK) >> (k)) & 1) ? 2 : 1); ++rep_)
#define RSEAM(k) do { if (rep_ == 0 && (((PROBE_MASK) >> (k)) & 1) && N_LAUNCHES == 1) xcd_barrier(bar); } while (0)
    const int gw = F.bid * NWAVES + F.wave, NGW = F.G * NWAVES;
    ldsp L = F.lds + RING_OFF;

    if (IN(0)) { PHASE_BEGIN(); REPS(0) { p0_prologue(F); RSEAM(0); } SEAM(0); }
    if (IN(1)) { PHASE_BEGIN(); REPS(1) { pg8::Gemm g{F.XN(), F.Win_t(), RTOT, ZC, DM}; pg8::StaticOrder S; S.init(RTOT, ZC, F.G, F.bid);
        pg8::EpiInProj E{F.Z(), F.CKV(), F.KR(), F.out, F.kv_norm_g(), F.ROPE_T(), (LAS float*)(F.lds + XTRA_OFF)};
        pg8::gemm_phase<pg8::EpiInProj, pg8::StaticOrder, true, true>(L, g, S, E, F.tid); RSEAM(1); }
        late_transposes(F, 0, (RTOT / 256 * (ZC / 256)) % F.G);
        SEAM(1); }
    if (IN(2)) { PHASE_BEGIN(); REPS(2) {
        DUP(1, for (int m = 8 * gw; m < RTOT; m += 8 * NGW) p2_rows8(F, m));
        gla_stage_wg(F); __syncthreads();
        DUP(2, { const int per = 2052 / F.G, rem = 2052 - per * F.G; gla_pass1_units(F, L, F.bid * per, per, F.bid < rem ? per * F.G + F.bid : -1); });
        DUP(4, for (int u = F.bid; u < DB * 4; u += F.G) gla_sample_unit(F, L, u));
        RSEAM(2); }
        SEAM(2); }
    if (IN(3)) { PHASE_BEGIN(); REPS(3) {
        DUP(8, gla_pass2(F));
        if (F.bid == F.G - 1) meta_kv(F);
        { pg8::Gemm g{F.CQN(), F.Wuq_t(), RTOT, QW, QL}; pg8::StaticOrder S; S.init(RTOT, QW, F.G, F.bid); pg8::EpiBf16<0> E{F.Q(), QW, nullptr, 0, 0, 1.f};
          pg8::gemm_phase<pg8::EpiBf16<0>, pg8::StaticOrder, true, true>(L, g, S, E, F.tid); }
        { pg8::Gemm g{F.CKV(), F.Wkv_t(), R_PROMPT, 1024, KVL}; pg8::StaticOrder S; S.init(R_PROMPT, 1024, F.G, F.bid); pg8::EpiBf16<0> E{F.KV(), 1024, nullptr, 0, 0, 1.f};
          pg8::gemm_phase<pg8::EpiBf16<0>, pg8::StaticOrder, true, true>(L, g, S, E, F.tid); }
        RSEAM(3); }
        SEAM(3); }
    if (IN(4)) { PHASE_BEGIN();
#define DEQ(word) ({ if (F.tid == 0) F.MISC[0] = __hip_atomic_fetch_add(F.ctl + CW_QUEUE + 64 * (word), 1u, RLX_AGENT); __syncthreads(); const int id_ = (int)F.MISC[0]; __syncthreads(); id_; })
#ifdef P4_DECODE_LAST
#define P4_BODY(QO, MSK) do { \
        if ((MSK) & 2) for (;;) { const int id = DEQ((QO) + 1); if (id >= NB * 64 + 8) break; \
            int qrow0, kvrow0, qb, h; \
            if (id < NB * 64) { const int bh = id & 127, b = bh >> 3; qb = 7 - (id >> 7); h = bh & 7; qrow0 = b * SEQ + 256 * qb; kvrow0 = b * SEQ; } else { qb = -1; h = id - NB * 64; qrow0 = R_META0; kvrow0 = 0; } \
            attn_prompt_unit(F, L, qrow0, kvrow0, qb, h); } \
        if ((MSK) & 8) for (;;) { const int id = DEQ((QO) + 2); if (id >= 513) break; \
            gla_pass3_units(F, L, 4 * id, 4 * id + 4 < 2052 ? 4 * id + 4 : 2052); } \
        if ((MSK) & 1) for (;;) { const int id = DEQ((QO) + 0); if (id >= DB) break; attn_decode_unit(F, L, id); } } while (0)
#else
#define P4_BODY(QO, MSK) do { \
        if ((MSK) & 1) for (;;) { const int id = DEQ((QO) + 0); if (id >= DB) break; attn_decode_unit(F, L, id); } \
        if ((MSK) & 2) for (;;) { const int id = DEQ((QO) + 1); if (id >= NB * 64 + 8) break; \
            int qrow0, kvrow0, qb, h; \
            if (id < NB * 64) { const int bh = id & 127, b = bh >> 3; qb = 7 - (id >> 7); h = bh & 7; qrow0 = b * SEQ + 256 * qb; kvrow0 = b * SEQ; } else { qb = -1; h = id - NB * 64; qrow0 = R_META0; kvrow0 = 0; } \
            attn_prompt_unit(F, L, qrow0, kvrow0, qb, h); } \
        if ((MSK) & 8) for (;;) { const int id = DEQ((QO) + 2); if (id >= 513) break; \
            gla_pass3_units(F, L, 4 * id, 4 * id + 4 < 2052 ? 4 * id + 4 : 2052); } } while (0)
#endif
        P4_BODY(0, P4_MASK);
#ifdef P4_DUP
        if (N_LAUNCHES == 1) xcd_barrier(bar);
        P4_BODY(3, P4_DUP);
#endif
#undef P4_BODY
#undef DEQ
        SEAM(4); }
    if (IN(5)) { PHASE_BEGIN(); REPS(5) {
        { pg8::Gemm g{F.AO(), F.Wo_t(), R_PROMPT, DM, DM}; pg8::StaticOrder S; S.init(R_PROMPT, DM, F.G, F.bid); pg8::EpiResBf16 E{F.Y1(), F.XN(), DM, DN_ALPHA};
          pg8::gemm_phase<pg8::EpiResBf16, pg8::StaticOrder, true, true>(L, g, S, E, F.tid); }
        { pg8::Gemm g{F.AO(), F.Wo_t(), RTOT, DM, DM, 256}; pg8::SplitOrder S{128, 3, 4, 4, 256, F.G, F.bid}; pg8::EpiSlabBf16 E{F.SL5(), DM, 128, 256, (size_t)768 * DM};
          pg8::gemm_phase<pg8::EpiSlabBf16, pg8::SplitOrder, true, true>(L, g, S, E, F.tid); }
        RSEAM(5); }
        late_transposes(F, 1, 48);
        SEAM(5); }
    if (IN(6)) { PHASE_BEGIN(); REPS(6) {
        for (int m = 4 * gw; m < R_PROMPT; m += 4 * NGW) { float v[4][16];
#pragma unroll
            for (int r = 0; r < 4; ++r) ln_load_bf16(F.Y1() + (size_t)(m + r) * DM, F.lane, v[r]);
            ln_norm4(v, F.ln1_g(), F.ln1_b(), F.lane);
#pragma unroll
            for (int r = 0; r < 4; ++r) ln_store_bf16(v[r], F.H1() + (size_t)(m + r) * DM, F.lane); }
        for (int m = R_PROMPT + gw; m < R_VALID; m += NGW) { float v[16];
            ln_load_slabs(F.SL5() + (size_t)(m - R_PROMPT) * DM, (size_t)768 * DM, 4, F.XN() + (size_t)m * DM, DN_ALPHA, F.lane, v);
            ln_norm(v, F.ln1_g(), F.ln1_b(), F.lane); ln_store_bf16(v, F.H1() + (size_t)m * DM, F.lane); }
        RSEAM(6); } SEAM(6); }
    if (IN(7)) { PHASE_BEGIN(); REPS(7) {
        constexpr int NSU = 2 * (2 * FF / 256);
        if (F.bid < NSU) { pg8::Gemm g{F.H1(), F.Wffn_t(), R_FFN, 2 * FF, DM}; pg8::SplitOrder S{R_PROMPT / 256, 2, 2 * FF / 256, 1, 0, NSU, F.bid};
            pg8::EpiFfn<true> E{F.Gb(), F.HALO(), F.conv_w(), F.conv_b(), F.state_conv(), F.out + O_CONVP, F.out + O_CONVS, (LAS float*)(F.lds + XTRA_OFF)};
            pg8::gemm_phase<pg8::EpiFfn<true>, pg8::SplitOrder, true, true>(L, g, S, E, F.tid); }
        else halo_phase(F, NSU);
        RSEAM(7); } SEAM(7); }
    if (IN(8)) { PHASE_BEGIN(); REPS(8) { pg8::Gemm g{F.H1(), F.Wffn_t(), R_PROMPT, 2 * FF, DM}; pg8::StaticOrder S; S.init(R_PROMPT, 2 * FF, F.G, F.bid);
        pg8::EpiFfn<false> E{F.Gb(), F.HALO(), F.conv_w(), F.conv_b(), F.state_conv(), F.out + O_CONVP, F.out + O_CONVS, (LAS float*)(F.lds + XTRA_OFF)};
        pg8::gemm_phase<pg8::EpiFfn<false>, pg8::StaticOrder, true, true>(L, g, S, E, F.tid); RSEAM(8); }
        SEAM(8); }
    if (IN(9)) { PHASE_BEGIN(); REPS(9) {
        { pg8::Gemm g{F.Gb(), F.Wdown_t(), R_PROMPT, DM, FF}; pg8::StaticOrder S; S.init(R_PROMPT, DM, F.G, F.bid); pg8::EpiResBf16 E{F.Y2(), F.H1(), DM, DN_ALPHA};
          pg8::gemm_phase<pg8::EpiResBf16, pg8::StaticOrder, true, true>(L, g, S, E, F.tid); }
        { pg8::Gemm g{F.Gb(), F.Wdown_t(), R_FFN, DM, FF, 256}; pg8::SplitOrder S{128, 2, 4, 11, 256, F.G, F.bid}; pg8::EpiSlabBf16 E{F.SL9(), DM, 128, 256, (size_t)512 * DM};
          pg8::gemm_phase<pg8::EpiSlabBf16, pg8::SplitOrder, true, true>(L, g, S, E, F.tid); }
        RSEAM(9); } SEAM(9); }
    if (IN(10)) { PHASE_BEGIN(); REPS(10) {
        for (int m = 4 * gw; m < R_PROMPT; m += 4 * NGW) { float v[4][16];
#pragma unroll
            for (int r = 0; r < 4; ++r) { const bf16* yr = F.Y2() + (size_t)(m + r) * DM + 4 * F.lane;
#pragma unroll
                for (int j = 0; j < 4; ++j) { const u32x2 w = __builtin_nontemporal_load((const GAS u32x2*)(yr + 256 * j)); v[r][4 * j] = bflo(w.x); v[r][4 * j + 1] = bfhi(w.x); v[r][4 * j + 2] = bflo(w.y); v[r][4 * j + 3] = bfhi(w.y); } }
            float s[4], s2[4];
#pragma unroll
            for (int r = 0; r < 4; ++r) { s[r] = 0.f;
#pragma unroll
                for (int j = 0; j < 16; ++j) s[r] += v[r][j]; }
#pragma unroll
            for (int o = 1; o < 64; o <<= 1) {
#pragma unroll
                for (int r = 0; r < 4; ++r) s[r] += __shfl_xor(s[r], o); }
#pragma unroll
            for (int r = 0; r < 4; ++r) { const float mean = s[r] * (1.f / DM); s2[r] = 0.f;
#pragma unroll
                for (int j = 0; j < 16; ++j) { v[r][j] -= mean; s2[r] += v[r][j] * v[r][j]; } }
#pragma unroll
            for (int o = 1; o < 64; o <<= 1) {
#pragma unroll
                for (int r = 0; r < 4; ++r) s2[r] += __shfl_xor(s2[r], o); }
#pragma unroll
            for (int j = 0; j < 4; ++j) { const f32x4 gg = *(const GAS f32x4*)(F.ln2_g() + 4 * F.lane + 256 * j), bb = *(const GAS f32x4*)(F.ln2_b() + 4 * F.lane + 256 * j);
#pragma unroll
                for (int r = 0; r < 4; ++r) { const float rstd = 1.f / sqrtf(s2[r] * (1.f / DM) + NORM_EPS);
                    __builtin_nontemporal_store((f32x4){v[r][4 * j] * rstd * gg.x + bb.x, v[r][4 * j + 1] * rstd * gg.y + bb.y, v[r][4 * j + 2] * rstd * gg.z + bb.z, v[r][4 * j + 3] * rstd * gg.w + bb.w}, (GAS f32x4*)(F.out + O_YP + (size_t)(m + r) * DM + 4 * F.lane + 256 * j)); } } }
        for (int m = R_PROMPT + gw; m < R_FFN; m += NGW) { float v[16];
            ln_load_slabs(F.SL9() + (size_t)(m - R_PROMPT) * DM, (size_t)512 * DM, 11, F.H1() + (size_t)m * DM, DN_ALPHA, F.lane, v);
            ln_norm(v, F.ln2_g(), F.ln2_b(), F.lane); ln_store_f32(v, F.out + O_YP + (size_t)m * DM, F.lane); }
        RSEAM(10); } }
#undef IN
#undef BOTH
#undef SEAM
}

extern "C" void kernel_launch(void* const* d_in, const int* in_sizes, int n_in, void* d_out, int out_size, void* d_ws, size_t ws_size, hipStream_t stream) {
    static int grid = 0;
    if (grid == 0) {
        if (n_in != 28 || out_size != (int)O_END || ws_size < WS_END) { fprintf(stderr, "kernel_launch: unexpected problem shape (n_in %d, out %d, ws %zu); nothing launched\n", n_in, out_size, ws_size); grid = -1; return; }
        int dev = 0, cus = 0, per_cu = 0;
        if (hipGetDevice(&dev) != hipSuccess || hipDeviceGetAttribute(&cus, hipDeviceAttributeMultiprocessorCount, dev) != hipSuccess) { grid = -1; return; }
        if (hipFuncSetAttribute((const void*)hymba_fwd, hipFuncAttributeMaxDynamicSharedMemorySize, LDS_BYTES) != hipSuccess) { fprintf(stderr, "kernel_launch: hipFuncSetAttribute failed\n"); grid = -1; return; }
        if (hipOccupancyMaxActiveBlocksPerMultiprocessor(&per_cu, (const void*)hymba_fwd, NTHR, LDS_BYTES) != hipSuccess || per_cu < 1) { fprintf(stderr, "kernel_launch: occupancy query reports %d workgroups per CU\n", per_cu); }
        (void)hipGetLastError();
        grid = cus;
    }
    if (grid < 0) return;
    if (hipMemsetAsync((char*)d_ws + WS_CTL, 0, CTL_ZERO_BYTES, stream) != hipSuccess) { fprintf(stderr, "kernel_launch: memset failed\n"); return; }
    Args a{};
    for (int i = 0; i < 28; ++i) a.in[i] = d_in[i];
    a.out = (float*)d_out; a.ws = (unsigned char*)d_ws;
    for (int li = 0; li < N_LAUNCHES; ++li) {
        a.ph_lo = (N_LAUNCHES == 1) ? 0 : li; a.ph_hi = (N_LAUNCHES == 1) ? NPH : li + 1;
        hipLaunchKernelGGL(hymba_fwd, dim3(grid), dim3(NTHR), LDS_BYTES, stream, a);
        const hipError_t le = hipPeekAtLastError();
        if (le != hipSuccess) { fprintf(stderr, "kernel_launch: launch %d failed: %s\n", li, hipGetErrorName(le)); break; }
    }
}
```
